# Optimizing an MI355X kernel written in HIP

```python
import math
import jax, jax.numpy as jnp
from jax import lax
import numpy as np

D_MODEL = 4096
BATCH = 8
SEQ = 2048
DEPTH = 2
DEC_BATCH = 4
DEC_SEQ = 4096
PAST_LEN = 128

MIX_WIDTH = D_MODEL
GROUP_WIDTH = MIX_WIDTH // 4
HEAD_DIM = 128
DA_HEADS = GROUP_WIDTH // HEAD_DIM
DA_PATTERNS = ((128, 1), (512, 4), (2048, 16))
DA_QBLK = 64
ROPE_THETA = 500000.0
ROPE_DIMS = HEAD_DIM // 4
GQA_HEADS = GROUP_WIDTH // HEAD_DIM
GQA_KV_HEADS = GQA_HEADS // 4
GQA_QBLK = 128
AXIAL_THETA = 10000.0
GRID_W = 64
HY_CH = GROUP_WIDTH
HY_ORDER = 2
HY_SHORT = 3
HY_EMB = 33
HY_BANDS = (HY_EMB - 1) // 2
HY_FILTER_W = 64
HY_MIN_DECAY = 3.07
HY_MAX_DECAY = 15.35
ML_HEADS = 4
ML_HEAD_DIM = GROUP_WIDTH // ML_HEADS
ML_CHUNK = 64
FF_DIM = -(-8 * D_MODEL // (3 * 256)) * 256
EPS = 1e-6
IN_SPLIT_SIZES = (GROUP_WIDTH, GROUP_WIDTH, GROUP_WIDTH,
                  GQA_HEADS * HEAD_DIM, GQA_KV_HEADS * HEAD_DIM, GQA_KV_HEADS * HEAD_DIM,
                  (HY_ORDER + 1) * HY_CH,
                  GROUP_WIDTH, GROUP_WIDTH, GROUP_WIDTH, GROUP_WIDTH, 4 * ML_HEADS)
N_IN = sum(IN_SPLIT_SIZES)

kernel_name = "hybrid_bidir_dilated_gqa_hyena_mlstm_encoder"

F32 = jnp.float32


def rmsnorm(x, g):
    xf = x.astype(F32)
    y = xf * lax.rsqrt(jnp.mean(xf * xf, axis=-1, keepdims=True) + EPS)
    return (y * g.astype(F32)).astype(x.dtype)


def rope_tables(pos, dims, theta):
    inv = jnp.float32(theta) ** (-jnp.arange(0, dims, 2, dtype=F32) / dims)
    ang = pos[:, None] * inv[None, :]
    return jnp.cos(ang), jnp.sin(ang)


def apply_rope(x, cos, sin):
    xf = x.astype(F32)
    x1, x2 = jnp.split(xf, 2, axis=-1)
    c = cos[:, None, :]
    s = sin[:, None, :]
    return jnp.concatenate([x1 * c - x2 * s, x2 * c + x1 * s], axis=-1).astype(x.dtype)


def partial_rope(x, cos, sin):
    return jnp.concatenate([apply_rope(x[..., :ROPE_DIMS], cos, sin), x[..., ROPE_DIMS:]], axis=-1)


def axial_rope(x, cos_r, sin_r, cos_c, sin_c):
    half = HEAD_DIM // 2
    return jnp.concatenate([apply_rope(x[..., :half], cos_r, sin_r),
                            apply_rope(x[..., half:], cos_c, sin_c)], axis=-1)


def dilated_window_attention(q, k, v):
    B, L, H, Dh = q.shape
    nblk = L // DA_QBLK
    scale = Dh ** -0.5
    q_blocks = jnp.moveaxis(q.reshape(B, nblk, DA_QBLK, H, Dh), 1, 0)

    def one_block(args):
        qb, bi = args
        tq = bi * DA_QBLK + jnp.arange(DA_QBLK)
        ms, dens, nums = [], [], []
        for window, dil in DA_PATTERNS:
            half = window // dil // 2
            offs = jnp.arange(-half, half + 1) * dil
            idx = tq[:, None] + offs[None, :]
            valid = (idx >= 0) & (idx < L)
            idx = jnp.clip(idx, 0, L - 1)
            kg = k[:, idx]
            vg = v[:, idx]
            s = jnp.einsum('bqhd,bqkhd->bhqk', qb, kg, preferred_element_type=F32) * scale
            s = jnp.where(valid[None, None], s, -jnp.inf)
            m = jnp.max(s, axis=-1)
            p = jnp.exp(s - m[..., None])
            ms.append(m)
            dens.append(jnp.sum(p, axis=-1))
            nums.append(jnp.einsum('bhqk,bqkhd->bhqd', p.astype(v.dtype), vg,
                                   preferred_element_type=F32))
        m_all = jnp.stack(ms)
        w = jnp.exp(m_all - jnp.max(m_all, axis=0))
        den = jnp.sum(w * jnp.stack(dens), axis=0)
        num = jnp.sum(w[..., None] * jnp.stack(nums), axis=0)
        return (num / den[..., None]).astype(q.dtype)

    out = lax.map(one_block, (q_blocks, jnp.arange(nblk)))
    return out.transpose(1, 0, 3, 2, 4).reshape(B, L, H * Dh)


def gqa_attention(q, k, v):
    B, L, Hq, Dh = q.shape
    Hkv = k.shape[2]
    G = Hq // Hkv
    nblk = L // GQA_QBLK
    scale = Dh ** -0.5
    q_blocks = jnp.moveaxis(q.reshape(B, nblk, GQA_QBLK, Hkv, G, Dh), 1, 0)

    def one_block(qb):
        s = jnp.einsum('bqhgd,bkhd->bhgqk', qb, k, preferred_element_type=F32) * scale
        p = jax.nn.softmax(s, axis=-1)
        return jnp.einsum('bhgqk,bkhd->bqhgd', p.astype(v.dtype), v).astype(q.dtype)

    out = lax.map(one_block, q_blocks)
    return jnp.moveaxis(out, 0, 1).reshape(B, L, Hq * Dh)


def short_conv(u, w, b):
    pad = HY_SHORT // 2
    L = u.shape[1]
    up = jnp.pad(u, ((0, 0), (pad, pad), (0, 0)))
    y = b
    for j in range(HY_SHORT):
        y = y + up[:, j:j + L] * w[j]
    return y


def hyena_filters(L, w1, b1, fr1, w2, b2, fr2, w3, decay):
    n = jnp.arange(L, dtype=F32)
    t = n / (L - 1)
    f = jnp.linspace(1e-4, HY_BANDS - 1, HY_BANDS, dtype=F32)
    ang = (2.0 * math.pi / L) * n[:, None] * f[None, :]
    z = jnp.concatenate([t[:, None], jnp.cos(ang), -jnp.sin(ang)], axis=-1)
    h = jnp.sin(fr1.astype(F32) * (z @ w1.astype(F32) + b1.astype(F32)))
    h = jnp.sin(fr2.astype(F32) * (h @ w2.astype(F32) + b2.astype(F32)))
    h = h @ w3.astype(F32)
    r = jnp.abs(n - L // 2) / (L // 2)
    h = h * jnp.exp(-r[:, None] * decay.astype(F32)[None, :])
    return h.reshape(L, HY_ORDER, HY_CH)


def centred_fftconv(u, h):
    L = u.shape[1]
    U = jnp.fft.rfft(u, n=2 * L, axis=1)
    Hf = jnp.fft.rfft(h, n=2 * L, axis=0)
    y = jnp.fft.irfft(U * Hf[None], n=2 * L, axis=1)
    return y[:, L // 2:L // 2 + L]


def hyena_mixer(u, conv_w, conv_b, w1, b1, fr1, w2, b2, fr2, w3, decay, skip):
    L = u.shape[1]
    uc = short_conv(u, conv_w, conv_b).astype(F32)
    v, x1, x2 = jnp.split(uc, 3, axis=-1)
    h = hyena_filters(L, w1, b1, fr1, w2, b2, fr2, w3, decay)
    sk = skip.astype(F32).reshape(HY_ORDER, HY_CH)
    z = v
    for o, gate in enumerate((x1, x2)):
        z = gate * (centred_fftconv(z, h[:, o]) + sk[o] * z)
    return z.astype(u.dtype)


def mlstm_chunkwise(q, k, v, log_i, log_f):
    B, H, L, d = q.shape
    nc = L // ML_CHUNK

    def chunks(a):
        return jnp.moveaxis(a.reshape((B, H, nc, ML_CHUNK) + a.shape[3:]), 2, 0)

    causal = jnp.tril(jnp.ones((ML_CHUNK, ML_CHUNK), dtype=bool))

    def step(carry, xs):
        C, n, m = carry
        qc, kc, vc, li, lf = xs
        b = jnp.cumsum(lf, axis=-1)
        Dm = b[..., :, None] - b[..., None, :] + li[..., None, :]
        Dm = jnp.where(causal, Dm, -jnp.inf)
        inter = b + m[..., None]
        m_t = jnp.maximum(inter, jnp.max(Dm, axis=-1))
        Wm = jnp.exp(Dm - m_t[..., None])
        a_inter = jnp.exp(inter - m_t)
        S = jnp.einsum('bhtd,bhsd->bhts', qc, kc) * Wm
        num = a_inter[..., None] * jnp.einsum('bhtd,bhde->bhte', qc, C) + jnp.einsum('bhts,bhse->bhte', S, vc)
        den = a_inter * jnp.einsum('bhtd,bhd->bht', qc, n) + jnp.sum(S, axis=-1)
        h = num / jnp.maximum(jnp.abs(den), jnp.exp(-m_t))[..., None]
        bL = b[..., -1]
        g = bL[..., None] - b + li
        m_new = jnp.maximum(bL + m, jnp.max(g, axis=-1))
        a_old = jnp.exp(bL + m - m_new)
        wk = jnp.exp(g - m_new[..., None])
        C_new = a_old[..., None, None] * C + jnp.einsum('bhsd,bhse->bhde', kc * wk[..., None], vc)
        n_new = a_old[..., None] * n + jnp.einsum('bhs,bhsd->bhd', wk, kc)
        return (C_new, n_new, m_new), h

    init = (jnp.zeros((B, H, d, d), F32), jnp.zeros((B, H, d), F32), jnp.zeros((B, H), F32))
    _, hs = lax.scan(step, init, (chunks(q), chunks(k), chunks(v), chunks(log_i), chunks(log_f)))
    return jnp.moveaxis(hs, 0, 2).reshape(B, H, L, d)


def mlstm_mixer(q, k, v, o, gates, gate_b, norm_g):
    B, L, _ = q.shape

    def heads(a):
        return a.reshape(B, L, ML_HEADS, ML_HEAD_DIM).transpose(0, 2, 1, 3).astype(F32)

    qh = heads(q)
    kh = heads(k) * (ML_HEAD_DIM ** -0.5)
    vh = heads(v)
    g = (gates.astype(F32).reshape(B, L, 4, ML_HEADS) + gate_b.astype(F32)).transpose(2, 0, 3, 1)
    h_fwd = mlstm_chunkwise(qh, kh, vh, g[0], jax.nn.log_sigmoid(g[1]))
    fl = lambda a: jnp.flip(a, axis=2)
    h_bwd = fl(mlstm_chunkwise(fl(qh), fl(kh), fl(vh), fl(g[2]), fl(jax.nn.log_sigmoid(g[3]))))
    hs = h_fwd + h_bwd
    hs = hs * lax.rsqrt(jnp.mean(hs * hs, axis=-1, keepdims=True) + EPS)
    hs = hs.transpose(0, 2, 1, 3).reshape(B, L, GROUP_WIDTH) * norm_g.astype(F32)
    return (hs * jax.nn.sigmoid(o.astype(F32))).astype(q.dtype)


def trunk(x, norm1_g, w_in, qk_norm_g, hy_conv_w, hy_conv_b, hy_w1, hy_b1, hy_freq1,
          hy_w2, hy_b2, hy_freq2, hy_w3, hy_decay, hy_skip, ml_gate_b, ml_norm_g,
          w_out, norm2_g, w_gate, w_up, w_down, final_g):
    B, L, _ = x.shape
    rows = L // GRID_W
    cos_t, sin_t = rope_tables(jnp.arange(L, dtype=F32), ROPE_DIMS, ROPE_THETA)
    row_pos = jnp.repeat(jnp.arange(rows, dtype=F32), GRID_W)
    col_pos = jnp.tile(jnp.arange(GRID_W, dtype=F32), rows)
    cos_r, sin_r = rope_tables(row_pos, HEAD_DIM // 2, AXIAL_THETA)
    cos_c, sin_c = rope_tables(col_pos, HEAD_DIM // 2, AXIAL_THETA)
    bounds = np.cumsum(IN_SPLIT_SIZES)[:-1].tolist()
    for l in range(DEPTH):
        h = rmsnorm(x, norm1_g[l])
        proj = h @ w_in[l]
        (a_q, a_k, a_v, b_q, b_k, b_v, c_u, d_q, d_k, d_v, d_o, d_g) = jnp.split(proj, bounds, axis=-1)
        a_q = partial_rope(a_q.reshape(B, L, DA_HEADS, HEAD_DIM), cos_t, sin_t)
        a_k = partial_rope(a_k.reshape(B, L, DA_HEADS, HEAD_DIM), cos_t, sin_t)
        y_a = dilated_window_attention(a_q, a_k, a_v.reshape(B, L, DA_HEADS, HEAD_DIM))
        b_q = axial_rope(rmsnorm(b_q.reshape(B, L, GQA_HEADS, HEAD_DIM), qk_norm_g[l, 0]), cos_r, sin_r, cos_c, sin_c)
        b_k = axial_rope(rmsnorm(b_k.reshape(B, L, GQA_KV_HEADS, HEAD_DIM), qk_norm_g[l, 1]), cos_r, sin_r, cos_c, sin_c)
        y_b = gqa_attention(b_q, b_k, b_v.reshape(B, L, GQA_KV_HEADS, HEAD_DIM))
        y_c = hyena_mixer(c_u, hy_conv_w[l], hy_conv_b[l], hy_w1[l], hy_b1[l], hy_freq1[l],
                          hy_w2[l], hy_b2[l], hy_freq2[l], hy_w3[l], hy_decay[l], hy_skip[l])
        y_d = mlstm_mixer(d_q, d_k, d_v, d_o, d_g, ml_gate_b[l], ml_norm_g[l])
        x = x + jnp.concatenate([y_a, y_b, y_c, y_d], axis=-1) @ w_out[l]
        h = rmsnorm(x, norm2_g[l])
        x = x + (jax.nn.silu(h @ w_gate[l]) * (h @ w_up[l])) @ w_down[l]
    return rmsnorm(x, final_g)


def setup_inputs(seed: int = 0) -> dict:
    key = jax.random.key(seed)
    ks = jax.random.split(key, 32)

    def nrm(k, shape, std):
        return std * jax.random.normal(k, shape, F32)

    x_prompt = jax.random.normal(ks[0], (BATCH, SEQ, D_MODEL), F32)
    x_sample = jax.random.normal(ks[1], (DEC_BATCH, DEC_SEQ, D_MODEL), F32)
    norm1_g = 1.0 + nrm(ks[2], (DEPTH, D_MODEL), 0.02)
    w_in = nrm(ks[3], (DEPTH, D_MODEL, N_IN), D_MODEL ** -0.5)
    qk_norm_g = 1.0 + nrm(ks[4], (DEPTH, 2, HEAD_DIM), 0.02)
    hy_conv_w = nrm(ks[5], (DEPTH, HY_SHORT, (HY_ORDER + 1) * HY_CH), HY_SHORT ** -0.5)
    hy_conv_b = nrm(ks[6], (DEPTH, (HY_ORDER + 1) * HY_CH), 0.02)
    hy_w1 = nrm(ks[7], (DEPTH, HY_EMB, HY_FILTER_W), HY_EMB ** -0.5)
    hy_b1 = nrm(ks[8], (DEPTH, HY_FILTER_W), 0.02)
    hy_freq1 = 1.0 + nrm(ks[9], (DEPTH, HY_FILTER_W), 0.1)
    hy_w2 = nrm(ks[10], (DEPTH, HY_FILTER_W, HY_FILTER_W), HY_FILTER_W ** -0.5)
    hy_b2 = nrm(ks[11], (DEPTH, HY_FILTER_W), 0.02)
    hy_freq2 = 1.0 + nrm(ks[12], (DEPTH, HY_FILTER_W), 0.1)
    hy_w3 = nrm(ks[13], (DEPTH, HY_FILTER_W, HY_ORDER * HY_CH), 0.01)
    hy_decay = jax.random.uniform(ks[14], (DEPTH, HY_ORDER * HY_CH), F32, HY_MIN_DECAY, HY_MAX_DECAY)
    hy_skip = nrm(ks[15], (DEPTH, HY_ORDER * HY_CH), 0.1)
    i_bias = nrm(ks[16], (DEPTH, 2, ML_HEADS), 0.1)
    f_bias = jnp.linspace(3.0, 6.0, ML_HEADS, dtype=F32) + nrm(ks[17], (DEPTH, 2, ML_HEADS), 0.1)
    ml_gate_b = jnp.stack([i_bias[:, 0], f_bias[:, 0], i_bias[:, 1], f_bias[:, 1]], axis=1)
    ml_norm_g = 1.0 + nrm(ks[18], (DEPTH, GROUP_WIDTH), 0.02)
    w_out = nrm(ks[19], (DEPTH, MIX_WIDTH, D_MODEL), MIX_WIDTH ** -0.5)
    norm2_g = 1.0 + nrm(ks[20], (DEPTH, D_MODEL), 0.02)
    w_gate = nrm(ks[21], (DEPTH, D_MODEL, FF_DIM), D_MODEL ** -0.5)
    w_up = nrm(ks[22], (DEPTH, D_MODEL, FF_DIM), D_MODEL ** -0.5)
    w_down = nrm(ks[23], (DEPTH, FF_DIM, D_MODEL), FF_DIM ** -0.5)
    final_g = 1.0 + nrm(ks[24], (D_MODEL,), 0.02)
    return {"x_prompt": x_prompt, "x_sample": x_sample, "norm1_g": norm1_g, "w_in": w_in,
            "qk_norm_g": qk_norm_g, "hy_conv_w": hy_conv_w, "hy_conv_b": hy_conv_b,
            "hy_w1": hy_w1, "hy_b1": hy_b1, "hy_freq1": hy_freq1, "hy_w2": hy_w2,
            "hy_b2": hy_b2, "hy_freq2": hy_freq2, "hy_w3": hy_w3, "hy_decay": hy_decay,
            "hy_skip": hy_skip, "ml_gate_b": ml_gate_b, "ml_norm_g": ml_norm_g,
            "w_out": w_out, "norm2_g": norm2_g, "w_gate": w_gate, "w_up": w_up,
            "w_down": w_down, "final_g": final_g}


def reference(x_prompt, x_sample, norm1_g, w_in, qk_norm_g, hy_conv_w, hy_conv_b, hy_w1,
              hy_b1, hy_freq1, hy_w2, hy_b2, hy_freq2, hy_w3, hy_decay, hy_skip, ml_gate_b,
              ml_norm_g, w_out, norm2_g, w_gate, w_up, w_down, final_g):
    weights = (norm1_g, w_in, qk_norm_g, hy_conv_w, hy_conv_b, hy_w1, hy_b1, hy_freq1,
               hy_w2, hy_b2, hy_freq2, hy_w3, hy_decay, hy_skip, ml_gate_b, ml_norm_g,
               w_out, norm2_g, w_gate, w_up, w_down, final_g)
    y_prompt = trunk(x_prompt, *weights)
    y_sample = trunk(x_sample, *weights)
    return (y_prompt, y_sample)
```

```cpp
#include <hip/hip_runtime.h>
#include <cstdio>
#include <cstdint>
#include <cmath>
namespace pg8 {
#define PG8_LAS __attribute__((address_space(3)))
typedef unsigned short bf16_t;
typedef short bf16x8 __attribute__((ext_vector_type(8)));
typedef float f32x4 __attribute__((ext_vector_type(4)));
typedef unsigned u32x4 __attribute__((ext_vector_type(4)));
constexpr int BM = 256, BK = 64, HALF = 128, HTB = HALF * BK * 2  , STAGE_BYTES = 8 * HTB, NXCD = 8, WGM = 8;

__host__ __device__ __forceinline__ int lds_byte(int r, int c) { const int st = (r >> 4) * 2 + (c >> 5), rr = r & 15, cc = c & 31, ob = rr * 64 + cc * 2; return st * 1024 + (ob ^ (((ob >> 9) & 1) << 5)); }
__host__ __device__ __forceinline__ void stage_rc(int b, int& R, int& C) { const int st = b / 1024, sb = b % 1024, swz = sb ^ (((sb >> 9) & 1) << 5); R = (st >> 1) * 16 + swz / 64; C = (st & 1) * 32 + (swz % 64) / 2; }
__host__ __device__ __forceinline__ int perm32(int rho) { const int n = rho >> 4, i = rho & 15; return 8 * (i >> 2) + 4 * n + (i & 3); }

struct Unit { int pm, pn; };
struct Gemm { const bf16_t* A; const bf16_t* Bt; int M, N, K; };

struct StaticOrder {
    int nM, nN, nwg, G, c;
    __host__ __device__ void init(int M, int N, int G_, int c_) { nM = M / BM; nN = N / BM; nwg = nM * nN; G = G_; c = c_; }
    __host__ __device__ bool next(int i, Unit& u) const {
        const long L = (long)i * G + c; if (L >= nwg) return false;
        int wgid = (int)L; { const int q = nwg / NXCD, r = nwg % NXCD, xcd = wgid % NXCD, off = wgid / NXCD; wgid = (xcd < r ? xcd * (q + 1) : r * (q + 1) + (xcd - r) * q) + off; }
        const int nig = WGM * nN, gid = wgid / nig, fm = gid * WGM, gsz = (nM - fm) < WGM ? (nM - fm) : WGM;
        u.pm = fm + ((wgid % nig) % gsz); u.pn = (wgid % nig) / gsz; return true;
    }
    __device__ __forceinline__ void a_ready(const Unit&) const {}
    __device__ __forceinline__ void done(const Unit&) const {}
};

__device__ __forceinline__ unsigned cvt_pk_bf16(float lo, float hi) { unsigned r; asm volatile("v_cvt_pk_bf16_f32 %0, %1, %2" : "=v"(r) : "v"(lo), "v"(hi)); return r; }
typedef float f32x2 __attribute__((ext_vector_type(2)));
struct EpiProj {
    static constexpr bool PERM = true, AFTER_DRAIN = false;
    bf16_t* O; int ldc; float* gates; int gate_pn;
    __device__ __forceinline__ void operator()(const f32x4 (&acc)[2][2][4][2], const Unit& u, int wr, int wc, int fr, int fq) const {
        const int row0 = u.pm * BM + wr * 64 + fr, col0 = u.pn * BM + wc * 32 + 8 * fq;
#pragma unroll
        for (int ai = 0; ai < 2; ++ai)
#pragma unroll
            for (int m = 0; m < 4; ++m) { bf16_t* rowp = O + (size_t)(row0 + ai * HALF + m * 16) * ldc + col0;
#pragma unroll
                for (int bj = 0; bj < 2; ++bj) { const f32x4 v0 = acc[ai][bj][m][0], v1 = acc[ai][bj][m][1];
                    u32x4 w; w.x = cvt_pk_bf16(v0[0], v0[1]); w.y = cvt_pk_bf16(v0[2], v0[3]); w.z = cvt_pk_bf16(v1[0], v1[1]); w.w = cvt_pk_bf16(v1[2], v1[3]);
                    *(u32x4*)(rowp + bj * HALF) = w; } }
        if (u.pn == gate_pn && wc == 0 && fq < 2) {
#pragma unroll
            for (int ai = 0; ai < 2; ++ai)
#pragma unroll
                for (int m = 0; m < 4; ++m) { float* gp = gates + (size_t)(row0 + ai * HALF + m * 16) * 16 + 8 * fq;
                    *(f32x4*)(gp) = acc[ai][0][m][0]; *(f32x4*)(gp + 4) = acc[ai][0][m][1]; }
        }
    }
};
struct EpiResid {
    static constexpr bool PERM = false, AFTER_DRAIN = false;
    const float* base_lo; const float* base_hi; int split; float* out; int ldc;
    __device__ __forceinline__ void operator()(const f32x4 (&acc)[2][2][4][2], const Unit& u, int wr, int wc, int fr, int fq) const {
        const int row0 = u.pm * BM + wr * 64 + fr, col0 = u.pn * BM + wc * 32 + 4 * fq;
#pragma unroll
        for (int ai = 0; ai < 2; ++ai)
#pragma unroll
            for (int m = 0; m < 4; ++m) { const int row = row0 + ai * HALF + m * 16;
                const float* bp = (row < split ? base_lo + (size_t)row * ldc : base_hi + (size_t)(row - split) * ldc) + col0; float* op = out + (size_t)row * ldc + col0;
#pragma unroll
                for (int bj = 0; bj < 2; ++bj)
#pragma unroll
                    for (int n = 0; n < 2; ++n) *(f32x4*)(op + bj * HALF + n * 16) = *(const f32x4*)(bp + bj * HALF + n * 16) + acc[ai][bj][m][n]; }
    }
};
__device__ __forceinline__ float silu_mul(float g, float u) { const float e = __builtin_amdgcn_exp2f(-1.4426950408889634f * g); return g * __builtin_amdgcn_rcpf(1.0f + e) * u; }
struct EpiGateUp {
    static constexpr bool PERM = true, AFTER_DRAIN = false;
    bf16_t* H; int ldc;
    __device__ __forceinline__ void operator()(const f32x4 (&acc)[2][2][4][2], const Unit& u, int wr, int wc, int fr, int fq) const {
        const int row0 = u.pm * BM + wr * 64 + fr, col0 = u.pn * HALF + wc * 32 + 8 * fq;
#pragma unroll
        for (int ai = 0; ai < 2; ++ai)
#pragma unroll
            for (int m = 0; m < 4; ++m) { bf16_t* rowp = H + (size_t)(row0 + ai * HALF + m * 16) * ldc + col0;
                const f32x4 g0 = acc[ai][0][m][0], g1 = acc[ai][0][m][1], u0 = acc[ai][1][m][0], u1 = acc[ai][1][m][1];
                u32x4 w; w.x = cvt_pk_bf16(silu_mul(g0[0], u0[0]), silu_mul(g0[1], u0[1])); w.y = cvt_pk_bf16(silu_mul(g0[2], u0[2]), silu_mul(g0[3], u0[3]));
                w.z = cvt_pk_bf16(silu_mul(g1[0], u1[0]), silu_mul(g1[1], u1[1])); w.w = cvt_pk_bf16(silu_mul(g1[2], u1[2]), silu_mul(g1[3], u1[3]));
                *(u32x4*)(rowp) = w; }
    }
};
template <class Epi, class Sched, bool ALIGN_EPI = false, bool SP2 = false>
__device__ __forceinline__ void gemm_phase(PG8_LAS unsigned char* lds, const Gemm g, const Sched& S, const Epi& E) {
    int tid_ = threadIdx.x; asm volatile("" : "+v"(tid_)); const int tid = tid_, wid = __builtin_amdgcn_readfirstlane(tid >> 6), lane = tid & 63, wr = wid >> 2, wc = wid & 3, fr = lane & 15, fq = lane >> 4;
    const int K = g.K, nt = K / BK;
    unsigned voffA[2], voffB[2];
#pragma unroll
    for (int i = 0; i < 2; ++i) { int R, C; stage_rc(tid * 16 + i * 8192, R, C); const int Rb = Epi::PERM ? ((R & ~31) + perm32(R & 31)) : R;
        voffA[i] = (unsigned)(R * K + C) * 2u; voffB[i] = (unsigned)(Rb * K + C) * 2u; }
    const size_t kstep = (size_t)(BK * 2);
    const size_t hstep = (size_t)HALF * K * 2;
    const size_t tstep = 2 * hstep;
    const unsigned ldsw = (unsigned)wid * 1024u;
    const int aoff = lds_byte(wr * 64 + fr, fq * 8), boff = lds_byte(wc * 32 + fr, fq * 8);
#define PG8_SA(b, h) (((b) * 2 + (h)) * HTB)
#define PG8_SB(b, h) ((4 + (b) * 2 + (h)) * HTB)
#define PG8_STAGE(bufoff, gbase, voff) do { _Pragma("unroll") for (int _i = 0; _i < 2; ++_i) \
        __builtin_amdgcn_global_load_lds((const unsigned*)((const char*)(gbase) + (voff)[_i]), (PG8_LAS unsigned*)(lds + (bufoff) + ldsw + _i * 8192), 16, 0, 0); } while (0)
#define PG8_LDA(dst, b, h) do { _Pragma("unroll") for (int m = 0; m < 4; ++m) _Pragma("unroll") for (int k = 0; k < 2; ++k) dst[m][k] = *(const PG8_LAS bf16x8*)(lds + PG8_SA(b, h) + aoff + m * 2048 + k * 1024); } while (0)
#define PG8_LDB(dst, b, h) do { _Pragma("unroll") for (int n = 0; n < 2; ++n) _Pragma("unroll") for (int k = 0; k < 2; ++k) dst[n][k] = *(const PG8_LAS bf16x8*)(lds + PG8_SB(b, h) + boff + n * 2048 + k * 1024); } while (0)
#define PG8_MMA(ai, bj, At, Bt) do { __builtin_amdgcn_s_setprio(1); _Pragma("unroll") for (int m = 0; m < 4; ++m) _Pragma("unroll") for (int n = 0; n < 2; ++n) _Pragma("unroll") for (int k = 0; k < 2; ++k) \
        acc[ai][bj][m][n] = __builtin_amdgcn_mfma_f32_16x16x32_bf16(Bt[n][k], At[m][k], acc[ai][bj][m][n], 0, 0, 0); __builtin_amdgcn_s_setprio(0); } while (0)
#define PG8_WAIT_V(n) asm volatile("s_waitcnt vmcnt(" #n ")" ::: "memory")
#define PG8_WAIT_L(n) asm volatile("s_waitcnt lgkmcnt(" #n ")" ::: "memory")
#define PG8_BAR __builtin_amdgcn_s_barrier()
#define PG8_SCHED __builtin_amdgcn_sched_barrier(0)
    Unit cur, nxt; int ui = 0;
    if (!S.next(0, cur)) return;
    f32x4 acc[2][2][4][2];
#pragma unroll
    for (int a = 0; a < 2; ++a)
#pragma unroll
        for (int b = 0; b < 2; ++b)
#pragma unroll
            for (int m = 0; m < 4; ++m)
#pragma unroll
                for (int n = 0; n < 2; ++n) acc[a][b][m][n] = (f32x4){0.f, 0.f, 0.f, 0.f};
    bf16x8 At[4][2], B0[2][2], B1[2][2];
    const char* cA = (const char*)g.A + (size_t)cur.pm * tstep; const char* cB = (const char*)g.Bt + (size_t)cur.pn * tstep;
    S.a_ready(cur);
    if constexpr (SP2) {
        PG8_STAGE(PG8_SB(0, 0), cB, voffB); PG8_STAGE(PG8_SB(0, 1), cB + hstep, voffB); PG8_STAGE(PG8_SA(0, 0), cA, voffA); PG8_STAGE(PG8_SA(0, 1), cA + hstep, voffA);
        if (wr == 1) PG8_BAR;
        PG8_WAIT_V(2); PG8_BAR;
        PG8_STAGE(PG8_SB(1, 0), cB + kstep, voffB); PG8_STAGE(PG8_SA(1, 0), cA + kstep, voffA); PG8_STAGE(PG8_SB(1, 1), cB + hstep + kstep, voffB);
        PG8_WAIT_V(6); PG8_BAR;
    } else {
        PG8_STAGE(PG8_SB(0, 0), cB, voffB); PG8_STAGE(PG8_SA(0, 0), cA, voffA); PG8_STAGE(PG8_SB(0, 1), cB + hstep, voffB); PG8_STAGE(PG8_SA(0, 1), cA + hstep, voffA);
        if (wr == 1) PG8_BAR;
        PG8_WAIT_V(4); PG8_BAR;
        PG8_STAGE(PG8_SB(1, 0), cB + kstep, voffB); PG8_STAGE(PG8_SA(1, 0), cA + kstep, voffA); PG8_STAGE(PG8_SB(1, 1), cB + hstep + kstep, voffB);
        PG8_WAIT_V(6); PG8_BAR;
    }
    for (;;) {
        const bool has_next = S.next(ui + 1, nxt);
        const char* nA = has_next ? (const char*)g.A + (size_t)nxt.pm * tstep : cA; const char* nB = has_next ? (const char*)g.Bt + (size_t)nxt.pn * tstep : cB;
        for (int t = 0; t < nt; t += 2) {
            const bool last = (t == nt - 2);
            const char* a1 = cA + (size_t)(t + 1) * kstep;
            const char* a2 = last ? nA : cA + (size_t)(t + 2) * kstep; const char* b2 = last ? nB : cB + (size_t)(t + 2) * kstep;
            const char* a3 = a2 + kstep; const char* b3 = b2 + kstep;
            if (last && has_next) S.a_ready(nxt);
            if constexpr (SP2) {
            PG8_LDB(B0, 0, 0); PG8_LDB(B1, 0, 1); PG8_SCHED; PG8_LDA(At, 0, 0); PG8_STAGE(PG8_SA(1, 1), a1 + hstep, voffA);
            PG8_WAIT_V(8); PG8_WAIT_L(0); PG8_BAR; PG8_MMA(0, 0, At, B0); PG8_MMA(0, 1, At, B1); PG8_BAR; PG8_SCHED;
            PG8_LDA(At, 0, 1); PG8_STAGE(PG8_SB(0, 0), b2, voffB); PG8_STAGE(PG8_SB(0, 1), b2 + hstep, voffB); PG8_STAGE(PG8_SA(0, 0), a2, voffA);
            PG8_WAIT_V(8); PG8_WAIT_L(0); PG8_BAR; PG8_MMA(1, 0, At, B0); PG8_MMA(1, 1, At, B1); PG8_BAR; PG8_SCHED;
            PG8_LDB(B0, 1, 0); PG8_LDB(B1, 1, 1); PG8_SCHED; PG8_LDA(At, 1, 0); PG8_STAGE(PG8_SA(0, 1), a2 + hstep, voffA);
            PG8_WAIT_V(8); PG8_WAIT_L(0); PG8_BAR; PG8_MMA(0, 0, At, B0); PG8_MMA(0, 1, At, B1); PG8_BAR; PG8_SCHED;
            PG8_LDA(At, 1, 1); PG8_STAGE(PG8_SB(1, 0), b3, voffB); PG8_STAGE(PG8_SB(1, 1), b3 + hstep, voffB); PG8_STAGE(PG8_SA(1, 0), a3, voffA);
            PG8_WAIT_V(8); PG8_WAIT_L(0); PG8_BAR; PG8_MMA(1, 0, At, B0); PG8_MMA(1, 1, At, B1); PG8_BAR; PG8_SCHED;
            } else {
            PG8_LDB(B0, 0, 0); PG8_SCHED; PG8_LDA(At, 0, 0); PG8_STAGE(PG8_SA(1, 1), a1 + hstep, voffA);
            PG8_WAIT_L(8); PG8_BAR; PG8_WAIT_L(0); PG8_MMA(0, 0, At, B0); PG8_BAR; PG8_SCHED;
            PG8_LDB(B1, 0, 1); PG8_STAGE(PG8_SB(0, 0), b2, voffB);
            PG8_BAR; PG8_WAIT_L(0); PG8_MMA(0, 1, At, B1); PG8_BAR;
            PG8_LDA(At, 0, 1); PG8_STAGE(PG8_SA(0, 0), a2, voffA);
            PG8_BAR; PG8_WAIT_L(0); PG8_MMA(1, 0, At, B0); PG8_BAR; PG8_SCHED;
            PG8_STAGE(PG8_SB(0, 1), b2 + hstep, voffB);
            PG8_WAIT_V(6); PG8_BAR; PG8_MMA(1, 1, At, B1); PG8_BAR;
            PG8_LDB(B0, 1, 0); PG8_SCHED; PG8_LDA(At, 1, 0); PG8_STAGE(PG8_SA(0, 1), a2 + hstep, voffA);
            PG8_WAIT_L(8); PG8_BAR; PG8_WAIT_L(0); PG8_MMA(0, 0, At, B0); PG8_BAR; PG8_SCHED;
            PG8_LDB(B1, 1, 1); PG8_STAGE(PG8_SB(1, 0), b3, voffB);
            PG8_BAR; PG8_WAIT_L(0); PG8_MMA(0, 1, At, B1); PG8_BAR;
            PG8_LDA(At, 1, 1); PG8_STAGE(PG8_SA(1, 0), a3, voffA);
            PG8_BAR; PG8_WAIT_L(0); PG8_MMA(1, 0, At, B0); PG8_BAR; PG8_SCHED;
            PG8_STAGE(PG8_SB(1, 1), b3 + hstep, voffB);
            PG8_WAIT_V(6); PG8_BAR; PG8_MMA(1, 1, At, B1); PG8_BAR;
            }
        }
        if constexpr (ALIGN_EPI) { if (wr == 0) PG8_BAR; }
        if constexpr (!Epi::AFTER_DRAIN) { E(acc, cur, wr, wc, fr, fq); S.done(cur); }
        if (!has_next) break;
#pragma unroll
        for (int a = 0; a < 2; ++a)
#pragma unroll
            for (int b = 0; b < 2; ++b)
#pragma unroll
                for (int m = 0; m < 4; ++m)
#pragma unroll
                    for (int n = 0; n < 2; ++n) acc[a][b][m][n] = (f32x4){0.f, 0.f, 0.f, 0.f};
        cur = nxt; cA = nA; cB = nB; ++ui;
        if constexpr (ALIGN_EPI) { if (wr == 1) PG8_BAR; }
    }
    PG8_WAIT_V(0);
    if constexpr (!ALIGN_EPI) { if (wr == 0) PG8_BAR; }
    PG8_BAR;
    if constexpr (Epi::AFTER_DRAIN) { E.fused(acc, cur, wr, wc, fr, fq, lds, wid, lane); S.done(cur); }
#undef PG8_SA
#undef PG8_SB
#undef PG8_STAGE
#undef PG8_LDA
#undef PG8_LDB
#undef PG8_MMA
#undef PG8_WAIT_V
#undef PG8_WAIT_L
#undef PG8_BAR
#undef PG8_SCHED
}
}
#ifndef PG8_SP2
#define PG8_SP2 true
#endif
#ifndef PG8_ALIGN
#define PG8_ALIGN true
#endif
constexpr int DM = 4096, NTOK = 32768, TOK_P = 16384, L_P = 2048, L_S = 4096, B_P = 8, B_S = 4;
constexpr int NPROJ = 12032, N_IN = 11792, FF = 11008, NGU = 2 * FF;
constexpr int C_AQ = 0, C_AK = 1024, C_AV = 2048, C_BQ = 3072, C_BK = 4096, C_BV = 4352, C_CU = 4608, C_DQ = 7680, C_DK = 8704, C_DV = 9728, C_DO = 10752, C_DG = 11776;
constexpr float EPS = 1e-6f;
constexpr int NWAVES = 8, NTHR = 512;
constexpr size_t al256(size_t x) { return (x + 255) / 256 * 256; }
constexpr size_t WS_CTL = 0, CTL_ZERO_BYTES = 1u << 20;
constexpr size_t WS_WIN = CTL_ZERO_BYTES;
constexpr size_t WS_WOUT = WS_WIN + (size_t)NPROJ * DM * 2;
constexpr size_t WS_WGU = WS_WOUT + (size_t)DM * DM * 2;
constexpr size_t WS_WDN = WS_WGU + (size_t)NGU * DM * 2;
constexpr size_t WS_HA = WS_WDN + (size_t)DM * FF * 2;
constexpr size_t WS_PROJ = WS_HA + (size_t)NTOK * DM * 2;
constexpr size_t WS_GATES = WS_PROJ + (size_t)NTOK * NPROJ * 2;
constexpr size_t WS_GCUM = WS_GATES + (size_t)NTOK * 16 * 4;
constexpr size_t WS_ROPE = WS_GCUM + (size_t)NTOK * 16 * 4;
constexpr size_t WS_HFIL = WS_ROPE + al256((size_t)(2 * 4096 * 16 + 2 * 64 * 32) * 4);
constexpr size_t WS_UCT = WS_HFIL + (size_t)2048 * (2048 + 4096) * 4;
constexpr size_t WS_DH = WS_UCT + (size_t)3072 * NTOK * 2;
constexpr size_t WS_CST = WS_DH + (size_t)2 * NTOK * 1024 * 2;
constexpr size_t WS_NST = WS_CST + (size_t)1024 * 65536 * 2;
constexpr size_t WS_HSP = WS_NST + (size_t)1024 * 256 * 4;
constexpr size_t WS_END = WS_HSP + (size_t)512 * 131072;
constexpr int CW_BAR = 4096;
constexpr int CW_QUEUE = 16384;

constexpr int RING_BYTES = 131072, LDS_BYTES = 147456, LDSCTL_OFF = LDS_BYTES - 1024, MISC_OFF = LDSCTL_OFF + 320;

#define LAS __attribute__((address_space(3)))
typedef unsigned short bf16;
typedef unsigned v4u __attribute__((ext_vector_type(4)));
typedef unsigned v2u __attribute__((ext_vector_type(2)));
typedef float f32x4 __attribute__((ext_vector_type(4)));
#define LDS_WAIT() asm volatile("s_waitcnt lgkmcnt(0)" ::: "memory")
__device__ __forceinline__ unsigned f2bf(float f) { unsigned u = __builtin_bit_cast(unsigned, f); return (u + 0x7fffu + ((u >> 16) & 1u)) >> 16; }
__device__ __forceinline__ unsigned pk2(float lo, float hi) { return f2bf(lo) | (f2bf(hi) << 16); }
__device__ __forceinline__ float bf2f(unsigned short b) { return __builtin_bit_cast(float, (unsigned)b << 16); }
__device__ __forceinline__ float bflo(unsigned w) { return __builtin_bit_cast(float, w << 16); }
__device__ __forceinline__ float bfhi(unsigned w) { return __builtin_bit_cast(float, w & 0xffff0000u); }
__device__ __forceinline__ float wave_sum(float v) {
#pragma unroll
    for (int o = 1; o < 64; o <<= 1) v += __shfl_xor(v, o);
    return v;
}
__device__ __forceinline__ void sincos_rev(double rev, float& s, float& c) { const float f = (float)(rev - rint(rev)); s = __builtin_amdgcn_sinf(f); c = __builtin_amdgcn_cosf(f); }
__device__ const double INV_ROPE[16] = {1.0, 0.44036660267178046, 0.19392274474868576, 0.08539710028576561, 0.03760603093086393, 0.016560440080994446, 0.007292664737217109, 0.003211445994752591, 0.001414213562373095, 0.000622772421914596, 0.0002742481756762073, 0.00012076973741146504, 5.318295896944988e-05, 2.341999896140934e-05, 1.031338537721246e-05, 4.5416704806078695e-06};
__device__ const double INV_AX[32] = {1.0, 0.7498942093324559, 0.5623413251903491, 0.4216965034285822, 0.31622776601683794, 0.23713737056616552, 0.1778279410038923, 0.1333521432163324, 0.1, 0.07498942093324558, 0.05623413251903491, 0.042169650342858224, 0.03162277660168379, 0.023713737056616554, 0.01778279410038923, 0.01333521432163324, 0.01, 0.007498942093324558, 0.005623413251903491, 0.004216965034285823, 0.0031622776601683794, 0.0023713737056616554, 0.0017782794100389228, 0.001333521432163324, 0.001, 0.0007498942093324559, 0.0005623413251903491, 0.00042169650342858224, 0.00031622776601683794, 0.00023713737056616554, 0.00017782794100389227, 0.0001333521432163324};
#define XB_TMO      128
#define XB_XCNT(j)  (256  + 64 * (j))
#define XB_XSUB(j)  (1280 + 64 * (j))
#define XB_XGEN(j)  (2304 + 64 * (j))
#define XB_TOP      3328
#define XB_TOPGEN   3392
#define XCD_BAR_WORDS 3456
#define XB_SPIN_CAP (1u << 22)

__device__ __forceinline__ unsigned xb_ld(unsigned* p)              { return __hip_atomic_load(p, __ATOMIC_RELAXED, __HIP_MEMORY_SCOPE_AGENT); }
__device__ __forceinline__ unsigned xb_add(unsigned* p, unsigned v) { return __hip_atomic_fetch_add(p, v, __ATOMIC_RELAXED, __HIP_MEMORY_SCOPE_AGENT); }
__device__ __forceinline__ unsigned xb_xcc_id() { return (unsigned)__builtin_amdgcn_s_getreg((3 << 11) | 20) & 0xFu; }
#define XB_SPIN(cond, bar) do { unsigned _sp = 0; while (cond) { __builtin_amdgcn_s_sleep(1); \
    if ((++_sp & 255u) == 0u) { if (xb_ld(&(bar)[XB_TMO])) break; if (_sp > XB_SPIN_CAP) { atomicAdd(&(bar)[XB_TMO], 1u); break; } } } } while (0)

struct XcdBarrier {
    unsigned* bar; unsigned x;
    volatile LAS unsigned* st;
};

__device__ __forceinline__ XcdBarrier xcd_barrier_post(unsigned* bar, volatile LAS unsigned* st) {
    XcdBarrier b; b.bar = bar; b.x = xb_xcc_id(); b.st = st;
    if (threadIdx.x == 0) (void)xb_add(&bar[XB_XCNT(b.x)], 1u);
    return b;
}
__device__ __forceinline__ void xcd_barrier_complete(unsigned* bar, unsigned x, unsigned& nloc, unsigned& nx) {
    const unsigned G = gridDim.x * gridDim.y * gridDim.z;
    asm volatile("" : "+s"(x));
    unsigned sum, cnt, mine, sp = 0u;
    for (;;) {
        sum = 0u; cnt = 0u; mine = 0u;
#pragma unroll
        for (unsigned j = 0; j < 16; ++j) { const unsigned c = xb_ld(&bar[XB_XCNT(j)]); sum += c; cnt += (c > 0u) ? 1u : 0u; mine = (j == x) ? c : mine; }
        if (sum == G) break;
        __builtin_amdgcn_s_sleep(1);
        if ((++sp & 255u) == 0u) { if (xb_ld(&bar[XB_TMO])) break; if (sp > XB_SPIN_CAP) { atomicAdd(&bar[XB_TMO], 1u); break; } }
    }
    nloc = mine > 0u ? mine : 1u; nx = cnt > 0u ? cnt : 1u;
}

__device__ __forceinline__ void xcd_barrier(const XcdBarrier& b) {
    asm volatile("s_waitcnt vmcnt(0)" ::: "memory");
    __syncthreads();
    if (threadIdx.x == 0) {
        unsigned* bar = b.bar; asm volatile("" : "+s"(bar));
        __builtin_amdgcn_s_waitcnt(0);
        unsigned nloc = b.st[0], nx = b.st[1];
        if (nloc == 0u) { xcd_barrier_complete(bar, b.x, nloc, nx); b.st[0] = nloc; b.st[1] = nx; }
        const unsigned old = xb_add(&bar[XB_XSUB(b.x)], 1u);
        const unsigned gen = old / nloc;
        if (old + 1u == (gen + 1u) * nloc) {
            __builtin_amdgcn_fence(__ATOMIC_RELEASE, "agent");
            asm volatile("s_waitcnt vmcnt(0)" ::: "memory");
            const unsigned og = xb_add(&bar[XB_TOP], 1u);
            const unsigned tg = og / nx;
            if (og + 1u == (tg + 1u) * nx) xb_add(&bar[XB_TOPGEN], 1u);
            else XB_SPIN(xb_ld(&bar[XB_TOPGEN]) == tg, bar);
            __builtin_amdgcn_fence(__ATOMIC_ACQUIRE, "agent");
            xb_add(&bar[XB_XGEN(b.x)], 1u);
            asm volatile("s_waitcnt vmcnt(0)" ::: "memory");
        } else {
            XB_SPIN(xb_ld(&bar[XB_XGEN(b.x)]) == gen, bar);
            __builtin_amdgcn_fence(__ATOMIC_ACQUIRE, "agent");
            asm volatile("s_waitcnt vmcnt(0)" ::: "memory");
        }
    }
    __syncthreads();
}
struct Args { const float* in[24]; float* out; unsigned char* ws; int ph_lo, ph_hi; };
enum { I_XP = 0, I_XS, I_N1G, I_WIN, I_QKG, I_HCW, I_HCB, I_HW1, I_HB1, I_HF1, I_HW2, I_HB2, I_HF2, I_HW3, I_HDEC, I_HSKIP, I_MLGB, I_MLNG, I_WOUT, I_N2G, I_WG, I_WU, I_WD, I_FG };

struct Ctx {
    LAS unsigned char* lds; int tid, lane, wave, gw, NGW, bid, G;
    unsigned char* ws; const __attribute__((address_space(4))) Args* a;
};
__device__ __forceinline__ int opaque_tid() { int t = threadIdx.x; asm volatile("" : "+v"(t)); return t; }
typedef const __attribute__((address_space(4))) Args CArgs;
__device__ __forceinline__ CArgs* ldargs() { CArgs* ap = (CArgs*)__builtin_amdgcn_kernarg_segment_ptr(); asm volatile("" : "+s"(ap)); return ap; }
__device__ __forceinline__ bool ph_in(int k) { CArgs* ap = ldargs(); return ap->ph_lo <= k && k < ap->ph_hi; }
__device__ __forceinline__ Ctx make_ctx(LAS unsigned char* lds) {
    CArgs* ap = ldargs();
    Ctx C; C.lds = lds; C.tid = opaque_tid(); C.lane = C.tid & 63; C.wave = __builtin_amdgcn_readfirstlane(C.tid >> 6);
    int bid = blockIdx.x, G = gridDim.x; asm volatile("" : "+s"(bid), "+s"(G)); C.bid = bid; C.G = G; C.gw = C.bid * NWAVES + C.wave; C.NGW = C.G * NWAVES; C.ws = ap->ws; C.a = ap;
    return C;
}
__device__ __forceinline__ int seq_pos(int row) { return row < TOK_P ? (row & (L_P - 1)) : ((row - TOK_P) & (L_S - 1)); }

__device__ __forceinline__ void tr_item(const float* W, int K, int N, bf16* WT, int dst_row0, int k0, int n0, LAS float* scr, int lane) {
    const int n = n0 + lane; const bool ok = n < N; const float* wp = W + (size_t)k0 * N + n;
    float v[64];
#pragma unroll
    for (int i = 0; i < 64; ++i) v[i] = ok ? __builtin_nontemporal_load(wp + (size_t)i * N) : 0.f;
#pragma unroll
    for (int i = 0; i < 64; ++i) scr[i * 65 + lane] = v[i];
    LDS_WAIT(); asm volatile("" ::: "memory");
    const int c = lane & 7;
#pragma unroll
    for (int j = 0; j < 8; ++j) { const int nn = (lane >> 3) + 8 * j; const LAS float* s = scr + (8 * c) * 65 + nn;
        v4u o; o.x = pk2(s[0 * 65], s[1 * 65]); o.y = pk2(s[2 * 65], s[3 * 65]); o.z = pk2(s[4 * 65], s[5 * 65]); o.w = pk2(s[6 * 65], s[7 * 65]);
        *(v4u*)(WT + (size_t)(dst_row0 + nn) * K + k0 + 8 * c) = o; }
    LDS_WAIT(); asm volatile("" ::: "memory");
}
constexpr int CV_KB = DM / 64, CV_IN = CV_KB * (NPROJ / 64), CV_OUT = CV_KB * (DM / 64), CV_G = CV_KB * (FF / 64), CV_D = (FF / 64) * (DM / 64), CV_ALL = CV_IN + CV_OUT + 2 * CV_G + CV_D;
__device__ __forceinline__ void convert_item(const Ctx& C, int l, int it, LAS float* scr) {
    const float* Win = C.a->in[I_WIN] + (size_t)l * DM * N_IN; const float* Wout = C.a->in[I_WOUT] + (size_t)l * DM * DM;
    const float* Wg = C.a->in[I_WG] + (size_t)l * DM * FF; const float* Wu = C.a->in[I_WU] + (size_t)l * DM * FF; const float* Wd = C.a->in[I_WD] + (size_t)l * FF * DM;
    bf16* WinT = (bf16*)(C.ws + WS_WIN); bf16* WoutT = (bf16*)(C.ws + WS_WOUT); bf16* WguT = (bf16*)(C.ws + WS_WGU); bf16* WdT = (bf16*)(C.ws + WS_WDN);
    int r = it;
    if (r < CV_IN) { const int nb = NPROJ / 64, kb = r / nb, n0 = 64 * (r % nb); tr_item(Win, DM, N_IN, WinT, n0, 64 * kb, n0, scr, C.lane); return; } r -= CV_IN;
    if (r < CV_OUT) { const int nb = DM / 64, kb = r / nb, n0 = 64 * (r % nb); tr_item(Wout, DM, DM, WoutT, n0, 64 * kb, n0, scr, C.lane); return; } r -= CV_OUT;
    if (r < CV_G) { const int nb = FF / 64, kb = r / nb, n0 = 64 * (r % nb); tr_item(Wg, DM, FF, WguT, 256 * (n0 >> 7) + (n0 & 127), 64 * kb, n0, scr, C.lane); return; } r -= CV_G;
    if (r < CV_G) { const int nb = FF / 64, kb = r / nb, n0 = 64 * (r % nb); tr_item(Wu, DM, FF, WguT, 256 * (n0 >> 7) + 128 + (n0 & 127), 64 * kb, n0, scr, C.lane); return; } r -= CV_G;
    { const int nb = DM / 64, kb = r / nb, n0 = 64 * (r % nb); tr_item(Wd, FF, DM, WdT, n0, 64 * kb, n0, scr, C.lane); }
}
__device__ __forceinline__ void phase_convert_weights(const Ctx& C, int l, int lo, int hi) {
    LAS float* scr = (LAS float*)(C.lds + C.wave * 16640);
    for (int it = lo + C.gw; it < hi; it += C.NGW) convert_item(C, l, it, scr);
}
__device__ __forceinline__ void convert_super_item(const Ctx& C, int l, int base) {
    LAS float* scr = (LAS float*)(C.lds + C.wave * 16640);
    for (int j = 0; j < 8; ++j) convert_item(C, l, base + 8 * j + C.wave, scr);
}
__device__ __forceinline__ void phase_rope_tables(const Ctx& C) {
    float* cosA = (float*)(C.ws + WS_ROPE); float* sinA = cosA + 4096 * 16; float* cosX = sinA + 4096 * 16; float* sinX = cosX + 64 * 32;
    const double inv2pi = 0.15915494309189533577;
    for (int i = C.bid * NTHR + C.tid; i < 4096 * 16 + 64 * 32; i += C.G * NTHR) {
        float s, c;
        if (i < 4096 * 16) { const int t = i >> 4, k = i & 15; sincos_rev((double)t * INV_ROPE[k] * inv2pi, s, c); cosA[i] = c; sinA[i] = s; }
        else { const int j = i - 4096 * 16, p = j >> 5, k = j & 31; sincos_rev((double)p * INV_AX[k] * inv2pi, s, c); cosX[j] = c; sinX[j] = s; }
    }
}
__device__ __forceinline__ void phase_hyena_filters(const Ctx& C, int l) {
    constexpr int PB = 24;
    LAS float* z = (LAS float*)C.lds;
    LAS float* h1 = z + PB * 36;
    LAS float* h2 = h1 + PB * 64;
    const float* w1 = C.a->in[I_HW1] + l * 33 * 64; const float* b1 = C.a->in[I_HB1] + l * 64; const float* fr1 = C.a->in[I_HF1] + l * 64;
    const float* w2 = C.a->in[I_HW2] + l * 64 * 64; const float* b2 = C.a->in[I_HB2] + l * 64; const float* fr2 = C.a->in[I_HF2] + l * 64;
    const float* w3 = C.a->in[I_HW3] + (size_t)l * 64 * 2048; const float* dec = C.a->in[I_HDEC] + l * 2048;
    float* hf = (float*)(C.ws + WS_HFIL);
    for (int it = C.bid; it < (L_P + L_S) / PB; it += C.G) {
        const int gp0 = it * PB;
        __syncthreads();
        for (int u = C.tid; u < PB * 33; u += NTHR) { const int p = u / 33, i = u % 33, gp = gp0 + p; const bool isS = gp >= L_P; const int n = isS ? gp - L_P : gp, L = isS ? L_S : L_P; float v;
            if (i == 0) v = (float)n / (float)(L - 1);
            else { const int j = (i - 1) & 15; const float f = 1e-4f + (float)j * ((15.0f - 1e-4f) / 15.0f); const float rev = (float)n * f / (float)L, fr = rev - rintf(rev); const float s = __builtin_amdgcn_sinf(fr), c = __builtin_amdgcn_cosf(fr); v = (i <= 16) ? c : -s; }
            z[p * 36 + i] = v; }
        __syncthreads();
        for (int u = C.tid; u < PB * 64; u += NTHR) { const int p = u >> 6, j = u & 63; float acc = b1[j];
            for (int i = 0; i < 33; ++i) acc += z[p * 36 + i] * w1[i * 64 + j];
            h1[p * 64 + j] = sinf(fr1[j] * acc); }
        __syncthreads();
        for (int u = C.tid; u < PB * 64; u += NTHR) { const int p = u >> 6, j = u & 63; float acc = b2[j];
            for (int i = 0; i < 64; ++i) acc += h1[p * 64 + i] * w2[i * 64 + j];
            h2[j * PB + p] = sinf(fr2[j] * acc); }
        __syncthreads();
        {
            float acc[4][PB];
#pragma unroll
            for (int q = 0; q < 4; ++q)
#pragma unroll
                for (int p = 0; p < PB; ++p) acc[q][p] = 0.f;
            for (int j = 0; j < 64; ++j) {
                float hv[PB];
#pragma unroll
                for (int k = 0; k < PB / 4; ++k) { const f32x4 t = *(const LAS f32x4*)(h2 + j * PB + 4 * k); hv[4 * k] = t.x; hv[4 * k + 1] = t.y; hv[4 * k + 2] = t.z; hv[4 * k + 3] = t.w; }
#pragma unroll
                for (int q = 0; q < 4; ++q) { const float w = w3[j * 2048 + C.tid + NTHR * q];
#pragma unroll
                    for (int p = 0; p < PB; ++p) acc[q][p] += hv[p] * w; }
            }
#pragma unroll
            for (int q = 0; q < 4; ++q) { const int col = C.tid + NTHR * q; const float d = dec[col];
#pragma unroll
                for (int p = 0; p < PB; ++p) { const int gp = gp0 + p; const bool isS = gp >= L_P; const int n = isS ? gp - L_P : gp, L = isS ? L_S : L_P;
                    const float r = fabsf((float)(n - L / 2)) / (float)(L / 2);
                    (isS ? hf + (size_t)2048 * L_P + (size_t)col * L_S : hf + (size_t)col * L_P)[n] = acc[q][p] * __expf(-r * d); } }
        }
    }
    __syncthreads();
}
template <bool TO_BF16>
__device__ __forceinline__ void phase_rmsnorm(const Ctx& C, const float* src_lo, const float* src_hi, const float* g, void* dst) {
    for (int row = C.gw; row < NTOK; row += C.NGW) {
        const float* xr = row < TOK_P ? src_lo + (size_t)row * DM : src_hi + (size_t)(row - TOK_P) * DM;
        f32x4 v[16]; float ss = 0.f;
#pragma unroll
        for (int j = 0; j < 16; ++j) { v[j] = __builtin_nontemporal_load((const f32x4*)xr + C.lane + 64 * j); ss += (v[j].x * v[j].x + v[j].y * v[j].y) + (v[j].z * v[j].z + v[j].w * v[j].w); }
        ss = wave_sum(ss);
        const float r = 1.0f / sqrtf(ss * (1.0f / DM) + EPS);
#pragma unroll
        for (int j = 0; j < 16; ++j) { const f32x4 gv = ((const f32x4*)g)[C.lane + 64 * j]; const f32x4 o = v[j] * r * gv;
            if (TO_BF16) { v2u w; w.x = pk2(o.x, o.y); w.y = pk2(o.z, o.w); ((v2u*)((bf16*)dst + (size_t)row * DM))[C.lane + 64 * j] = w; }
            else ((f32x4*)((float*)dst + (size_t)row * DM))[C.lane + 64 * j] = o; }
    }
}
template <bool TO_BF16>
__device__ __forceinline__ void rms_row(const float* xr, const float* g, void* drow, int lane) {
    f32x4 v[16]; float ss = 0.f;
#pragma unroll
    for (int j = 0; j < 16; ++j) { v[j] = __builtin_nontemporal_load((const f32x4*)xr + lane + 64 * j); ss += (v[j].x * v[j].x + v[j].y * v[j].y) + (v[j].z * v[j].z + v[j].w * v[j].w); }
    ss = wave_sum(ss);
    const float r = 1.0f / sqrtf(ss * (1.0f / DM) + EPS);
#pragma unroll
    for (int j = 0; j < 16; ++j) { const f32x4 gv = ((const f32x4*)g)[lane + 64 * j]; const f32x4 o = v[j] * r * gv;
        if constexpr (TO_BF16) { v2u w; w.x = pk2(o.x, o.y); w.y = pk2(o.z, o.w); ((v2u*)drow)[lane + 64 * j] = w; }
        else ((f32x4*)drow)[lane + 64 * j] = o; }
}
template <bool TO_BF16>
__device__ __forceinline__ void rms_row_lite(const float* xr, const float* g, void* drow, int lane) {
    float ss = 0.f;
#pragma nounroll
    for (int j0 = 0; j0 < 16; j0 += 4) { f32x4 v[4];
#pragma unroll
        for (int j = 0; j < 4; ++j) v[j] = ((const f32x4*)xr)[lane + 64 * (j0 + j)];
#pragma unroll
        for (int j = 0; j < 4; ++j) ss += (v[j].x * v[j].x + v[j].y * v[j].y) + (v[j].z * v[j].z + v[j].w * v[j].w); }
    ss = wave_sum(ss);
    const float r = 1.0f / sqrtf(ss * (1.0f / DM) + EPS);
#pragma nounroll
    for (int j0 = 0; j0 < 16; j0 += 4) { f32x4 v[4];
#pragma unroll
        for (int j = 0; j < 4; ++j) v[j] = __builtin_nontemporal_load((const f32x4*)xr + lane + 64 * (j0 + j));
#pragma unroll
        for (int j = 0; j < 4; ++j) { const f32x4 gv = ((const f32x4*)g)[lane + 64 * (j0 + j)]; const f32x4 o = v[j] * r * gv;
            if constexpr (TO_BF16) { v2u w; w.x = pk2(o.x, o.y); w.y = pk2(o.z, o.w); ((v2u*)drow)[lane + 64 * (j0 + j)] = w; }
            else ((f32x4*)drow)[lane + 64 * (j0 + j)] = o; } }
}
template <bool TO_BF16>
__device__ __forceinline__ void rms_row2(const float* xa, const float* xb, const float* g, void* da, void* db, int lane) {
    f32x4 va[16], vb[16]; float sa = 0.f, sb = 0.f;
#pragma unroll
    for (int j = 0; j < 16; ++j) va[j] = __builtin_nontemporal_load((const f32x4*)xa + lane + 64 * j);
#pragma unroll
    for (int j = 0; j < 16; ++j) vb[j] = __builtin_nontemporal_load((const f32x4*)xb + lane + 64 * j);
#pragma unroll
    for (int j = 0; j < 16; ++j) sa += (va[j].x * va[j].x + va[j].y * va[j].y) + (va[j].z * va[j].z + va[j].w * va[j].w);
#pragma unroll
    for (int j = 0; j < 16; ++j) sb += (vb[j].x * vb[j].x + vb[j].y * vb[j].y) + (vb[j].z * vb[j].z + vb[j].w * vb[j].w);
    sa = wave_sum(sa); sb = wave_sum(sb);
    const float ra = 1.0f / sqrtf(sa * (1.0f / DM) + EPS), rb = 1.0f / sqrtf(sb * (1.0f / DM) + EPS);
#pragma unroll
    for (int j = 0; j < 16; ++j) { const f32x4 gv = ((const f32x4*)g)[lane + 64 * j]; const f32x4 oa = va[j] * ra * gv, ob = vb[j] * rb * gv;
        if constexpr (TO_BF16) { v2u w; w.x = pk2(oa.x, oa.y); w.y = pk2(oa.z, oa.w); ((v2u*)da)[lane + 64 * j] = w; v2u u; u.x = pk2(ob.x, ob.y); u.y = pk2(ob.z, ob.w); ((v2u*)db)[lane + 64 * j] = u; }
        else { ((f32x4*)da)[lane + 64 * j] = oa; ((f32x4*)db)[lane + 64 * j] = ob; } }
}
template <bool TO_BF16>
__device__ __forceinline__ void phase_rmsnorm_half(const Ctx& C, const float* src, const float* g, void* dst, int nrows = TOK_P) {
    for (int row = C.gw; row < nrows; row += C.NGW) { void* drow; if constexpr (TO_BF16) drow = (bf16*)dst + (size_t)row * DM; else drow = (float*)dst + (size_t)row * DM; rms_row<TO_BF16>(src + (size_t)row * DM, g, drow, C.lane); }
}
template <bool TO_BF16, int RPS>
struct SlotNormOrder : pg8::StaticOrder {
    const float* src; const float* g; void* dst; int nrows, gw, ngw, lane; mutable int k;
    __device__ __forceinline__ void* drow_of(int row) const { if constexpr (TO_BF16) return (bf16*)dst + (size_t)row * DM; else return (float*)dst + (size_t)row * DM; }
    __device__ __forceinline__ void slot() const {
#pragma nounroll
        for (int q = 0; q < RPS; q += 2) { const int row = gw + ngw * (k * RPS + q), row2 = row + ngw; if (row >= nrows) break;
            int ln = lane; asm volatile("" : "+v"(ln));
            if (RPS > 1 && q + 1 < RPS && row2 < nrows) rms_row2<TO_BF16>(src + (size_t)row * DM, src + (size_t)row2 * DM, g, drow_of(row), drow_of(row2), ln);
            else rms_row<TO_BF16>(src + (size_t)row * DM, g, drow_of(row), ln); }
        ++k;
    }
    __device__ __forceinline__ void done(const pg8::Unit&) const { slot(); }
    __device__ __forceinline__ void flush() const { while (gw + ngw * (k * RPS) < nrows) slot(); }
};
__device__ __forceinline__ void phase_prep(const Ctx& C, int l) {
    bf16* proj = (bf16*)(C.ws + WS_PROJ);
    const float* cosA = (const float*)(C.ws + WS_ROPE); const float* sinA = cosA + 4096 * 16; const float* cosX = sinA + 4096 * 16; const float* sinX = cosX + 64 * 32;
    const float* qkg = C.a->in[I_QKG] + l * 256;
    {
        const int d1 = C.lane < 32 ? C.lane : C.lane + 32, d2 = d1 + 32; const float gq1 = qkg[d1], gq2 = qkg[d2], gk1 = qkg[128 + d1], gk2 = qkg[128 + d2];
        for (int row0 = C.gw; row0 < NTOK; row0 += 2 * C.NGW) {
            float a1[2][4], a2[2][4], ca[2][4], sa[2][4], b1[2][10], b2[2][10], cc[2], sn[2];
#pragma unroll
            for (int u = 0; u < 2; ++u) { const int row = row0 + u * C.NGW; if (row < NTOK) {
                const int t = seq_pos(row); const bf16* pr = proj + (size_t)row * NPROJ;
#pragma unroll
                for (int k = 0; k < 4; ++k) { const int idx = 64 * k + C.lane, hh = idx >> 4, i = idx & 15; const int col = (hh < 8 ? C_AQ + hh * 128 : C_AK + (hh - 8) * 128) + i;
                    a1[u][k] = bf2f(pr[col]); a2[u][k] = bf2f(pr[col + 16]); ca[u][k] = cosA[t * 16 + i]; sa[u][k] = sinA[t * 16 + i]; }
#pragma unroll
                for (int hh = 0; hh < 10; ++hh) { const int base = hh < 8 ? C_BQ + hh * 128 : C_BK + (hh - 8) * 128; b1[u][hh] = bf2f(pr[base + d1]); b2[u][hh] = bf2f(pr[base + d2]); }
                cc[u] = C.lane < 32 ? cosX[(t >> 6) * 32 + C.lane] : cosX[(t & 63) * 32 + C.lane - 32];
                sn[u] = C.lane < 32 ? sinX[(t >> 6) * 32 + C.lane] : sinX[(t & 63) * 32 + C.lane - 32]; } }
#pragma unroll
            for (int u = 0; u < 2; ++u) { const int row = row0 + u * C.NGW; if (row < NTOK) {
                bf16* pr = proj + (size_t)row * NPROJ; const float c = cc[u], s = sn[u];
#pragma unroll
                for (int k = 0; k < 4; ++k) { const int idx = 64 * k + C.lane, hh = idx >> 4, i = idx & 15; const int col = (hh < 8 ? C_AQ + hh * 128 : C_AK + (hh - 8) * 128) + i;
                    pr[col] = (bf16)f2bf(a1[u][k] * ca[u][k] - a2[u][k] * sa[u][k]); pr[col + 16] = (bf16)f2bf(a2[u][k] * ca[u][k] + a1[u][k] * sa[u][k]); }
#pragma unroll
                for (int hh = 0; hh < 10; ++hh) { const int base = hh < 8 ? C_BQ + hh * 128 : C_BK + (hh - 8) * 128;
                    const float ss = wave_sum(b1[u][hh] * b1[u][hh] + b2[u][hh] * b2[u][hh]); const float r = 1.0f / sqrtf(ss * (1.0f / 128.0f) + EPS);
                    const float x1 = b1[u][hh] * r * (hh < 8 ? gq1 : gk1), x2 = b2[u][hh] * r * (hh < 8 ? gq2 : gk2);
                    pr[base + d1] = (bf16)f2bf(x1 * c - x2 * s); pr[base + d2] = (bf16)f2bf(x2 * c + x1 * s); } } }
        }
    }
    {
        LAS float* tile = (LAS float*)C.lds + C.wave * (64 * 65);
        const float* cw = C.a->in[I_HCW] + l * 3 * 3072; const float* cb = C.a->in[I_HCB] + l * 3072; bf16* uct = (bf16*)(C.ws + WS_UCT);
        for (int it = C.gw; it < (NTOK / 64) * 48; it += C.NGW) {
            const int tb = it / 48, cbk = it % 48, cg = cbk * 64 + C.lane; const int row0 = tb * 64, t0 = seq_pos(row0), L = row0 < TOK_P ? L_P : L_S;
            const float w0 = cw[cg], w1 = cw[3072 + cg], w2 = cw[2 * 3072 + cg], bb = cb[cg];
            const bf16* p = proj + (size_t)row0 * NPROJ + C_CU + cg;
            unsigned short u[66];
#pragma unroll
            for (int j = 0; j < 64; ++j) u[j + 1] = p[(size_t)j * NPROJ];
            u[0] = t0 > 0 ? p[-(ptrdiff_t)NPROJ] : (unsigned short)0; u[65] = t0 + 64 < L ? p[(size_t)64 * NPROJ] : (unsigned short)0;
#pragma unroll
            for (int j = 0; j < 64; ++j) tile[C.lane * 65 + j] = bb + bf2f(u[j]) * w0 + bf2f(u[j + 1]) * w1 + bf2f(u[j + 2]) * w2;
            LDS_WAIT(); asm volatile("" ::: "memory");
#pragma unroll
            for (int k = 0; k < 8; ++k) { const int id = C.lane + 64 * k, ch = id >> 3, part = id & 7; const LAS float* s = tile + ch * 65 + part * 8;
                v4u o; o.x = pk2(s[0], s[1]); o.y = pk2(s[2], s[3]); o.z = pk2(s[4], s[5]); o.w = pk2(s[6], s[7]);
                *(v4u*)(uct + (size_t)(cbk * 64 + ch) * NTOK + row0 + part * 8) = o; }
            LDS_WAIT(); asm volatile("" ::: "memory");
        }
        __syncthreads();
    }
    {
        const float* gates = (const float*)(C.ws + WS_GATES); const float* gb = C.a->in[I_MLGB] + l * 16; float* gc = (float*)(C.ws + WS_GCUM);
        LAS float* tot = (LAS float*)C.lds;
        for (int it = C.bid; it < 12 * 4 * 2; it += C.G) {
            const int dir = it & 1, h = (it >> 1) & 3, sq = it >> 3; const int L = sq < B_P ? L_P : L_S; const int row0 = sq < B_P ? sq * L_P : TOK_P + (sq - B_P) * L_S;
            const float bi = gb[(2 * dir) * 4 + h], bf_ = gb[(2 * dir + 1) * 4 + h]; const int nch = L / 512;
            float xs[8], gis[8]; float carry = 0.f;
            __syncthreads();
#pragma unroll
            for (int c = 0; c < 8; ++c) if (c < nch) {
                const int sidx = (C.wave * nch + c) * 64 + C.lane; const int tl = dir == 0 ? sidx : L - 1 - sidx; const int row = row0 + tl;
                gis[c] = gates[(size_t)row * 16 + (2 * dir) * 4 + h] + bi; const float gf = gates[(size_t)row * 16 + (2 * dir + 1) * 4 + h] + bf_;
                float x = fminf(gf, 0.f) - log1pf(__expf(-fabsf(gf)));
#pragma unroll
                for (int o = 1; o < 64; o <<= 1) { const float y = __shfl_up(x, o); if (C.lane >= o) x += y; }
                x += carry; carry = __shfl(x, 63); xs[c] = x;
            }
            if (C.lane == 0) tot[C.wave] = carry;
            __syncthreads();
            float pre = 0.f;
            for (int w = 0; w < C.wave; ++w) pre += tot[w];
#pragma unroll
            for (int c = 0; c < 8; ++c) if (c < nch) {
                const int sidx = (C.wave * nch + c) * 64 + C.lane; const int tl = dir == 0 ? sidx : L - 1 - sidx; const int row = row0 + tl;
                gc[(size_t)((2 * dir) * 4 + h) * NTOK + row] = xs[c] + pre; gc[(size_t)((2 * dir + 1) * 4 + h) * NTOK + row] = gis[c];
            }
        }
        __syncthreads();
    }
}
namespace att {
using bf16x8 = __attribute__((ext_vector_type(8))) short;
using s16x4  = __attribute__((ext_vector_type(4))) short;
using f32x16 = __attribute__((ext_vector_type(16))) float;
using u32x4  = __attribute__((ext_vector_type(4))) unsigned;
constexpr int   D = 128, NW = 8, QBLK = 32, KVBLK = 64;
constexpr float SCALE = 0.088388347648318440f;
constexpr float THR = 8.f;
constexpr size_t SHM_V = KVBLK * D * 2, SHM_K = KVBLK * D * 2, SHM_ATTN = 2 * SHM_V + 2 * SHM_K + NW * 64 * 4;
#define KSWZ(row, colB) ((row) * 256 + ((colB) ^ (((row) & 7) << 4)))
#define SBAR() __builtin_amdgcn_sched_barrier(0)
__device__ __forceinline__ int crow(int r, int hi) { return (r & 3) + 8 * (r >> 2) + 4 * hi; }
__device__ __forceinline__ unsigned cvtpk(float lo, float hi) { unsigned r; asm volatile("v_cvt_pk_bf16_f32 %0, %1, %2" : "=v"(r) : "v"(lo), "v"(hi)); return r; }
__device__ __forceinline__ void partialSM(f32x16& p0, f32x16& p1, float& m_reg, float& mn, float& alpha) {
  constexpr float C = SCALE * 1.4426950408889634f;
  float pmax = p0[0]; for (int r = 1; r < 16; ++r) pmax = fmaxf(pmax, p0[r]); for (int r = 0; r < 16; ++r) pmax = fmaxf(pmax, p1[r]);
  { auto rr = __builtin_amdgcn_permlane32_swap(__float_as_uint(pmax), __float_as_uint(pmax), false, false);
    pmax = fmaxf(__uint_as_float(rr[0]), __uint_as_float(rr[1])); }
  if (__builtin_expect(__all(pmax - m_reg <= THR / SCALE), 1)) { mn = m_reg; alpha = 1.f; }
  else { mn = fmaxf(m_reg, pmax); alpha = __builtin_amdgcn_exp2f((m_reg - mn) * C); m_reg = mn; }
  float mnC = -mn * C;
  for (int r = 0; r < 16; ++r) p0[r] = fmaf(p0[r], C, mnC); for (int r = 0; r < 16; ++r) p1[r] = fmaf(p1[r], C, mnC);
  for (int r = 0; r < 16; ++r) p0[r] = __builtin_amdgcn_exp2f(p0[r]);
}
__device__ __forceinline__ void finishSM(f32x16& p0, f32x16& p1, float alpha, float& l_reg, bf16x8& pa0, bf16x8& pa1, bf16x8& pa2, bf16x8& pa3) {
  for (int r = 0; r < 16; ++r) p1[r] = __builtin_amdgcn_exp2f(p1[r]);
  float ps = 0; for (int r = 0; r < 16; ++r) ps += p0[r]; for (int r = 0; r < 16; ++r) ps += p1[r];
  { auto rr = __builtin_amdgcn_permlane32_swap(__float_as_uint(ps), __float_as_uint(ps), false, false);
    ps = __uint_as_float(rr[0]) + __uint_as_float(rr[1]); }
  l_reg = l_reg * alpha + ps;
#define PK4(P, BASE, OUT) do { unsigned a0 = cvtpk(P[BASE + 0], P[BASE + 1]), a1 = cvtpk(P[BASE + 2], P[BASE + 3]);   \
    unsigned b0 = cvtpk(P[BASE + 4], P[BASE + 5]), b1 = cvtpk(P[BASE + 6], P[BASE + 7]);                              \
    auto r0 = __builtin_amdgcn_permlane32_swap(a0, b0, false, false); auto r1 = __builtin_amdgcn_permlane32_swap(a1, b1, false, false); \
    u32x4 w = {r0[0], r1[0], r0[1], r1[1]}; OUT = *reinterpret_cast<bf16x8*>(&w); } while (0)
  PK4(p0, 0, pa0); PK4(p0, 8, pa1); PK4(p1, 0, pa2); PK4(p1, 8, pa3);
#undef PK4
}
__device__ __forceinline__ void qkt(f32x16& p0, f32x16& p1, const unsigned short* Ks, const bf16x8* qr, int r32, int hi) {
  p0 = f32x16{}; p1 = f32x16{};
  for (int d0 = 0; d0 < 8; ++d0) { int cb = (d0 * 16 + hi * 8) * 2;
    bf16x8 b0 = *reinterpret_cast<const bf16x8*>((const char*)Ks + KSWZ(r32, cb));
    bf16x8 b1 = *reinterpret_cast<const bf16x8*>((const char*)Ks + KSWZ(32 + r32, cb));
    p0 = __builtin_amdgcn_mfma_f32_32x32x16_bf16(b0, qr[d0], p0, 0, 0, 0);
    p1 = __builtin_amdgcn_mfma_f32_32x32x16_bf16(b1, qr[d0], p1, 0, 0, 0); }
}
__device__ __forceinline__ int v_st(int k, int c) { const int kk = (k & ~0xC) | ((k & 4) << 1) | ((k & 8) >> 1); return ((kk >> 3) * 4 + (c >> 5)) * 512 + ((kk & 7) * 32 + (c & 31)) * 2; }
__device__ __forceinline__ int v_rd_base(int lane) { return ((lane & 3) << 3) | (((lane >> 2) & 3) << 6) | (((lane >> 4) & 1) << 5) | (((lane >> 5) & 1) << 8); }
constexpr int v_rd_off(int d0, int ks, int half) { return d0 * 512 + ks * 4096 + half * 2048; }
template <int OFF> __device__ __forceinline__ s16x4 tr_read(int vb) {
  s16x4 r; asm volatile("ds_read_b64_tr_b16 %0, %1 offset:%2" : "=&v"(r) : "v"(vb), "i"(OFF) : "memory"); return r;
}
template <int D0> __device__ __forceinline__ void pv_one(f32x16& od, int vb, bf16x8 pa0, bf16x8 pa1, bf16x8 pa2, bf16x8 pa3) {
  const s16x4 l0 = tr_read<v_rd_off(D0, 0, 0)>(vb), h0 = tr_read<v_rd_off(D0, 0, 1)>(vb), l1 = tr_read<v_rd_off(D0, 1, 0)>(vb), h1 = tr_read<v_rd_off(D0, 1, 1)>(vb);
  const s16x4 l2 = tr_read<v_rd_off(D0, 2, 0)>(vb), h2 = tr_read<v_rd_off(D0, 2, 1)>(vb), l3 = tr_read<v_rd_off(D0, 3, 0)>(vb), h3 = tr_read<v_rd_off(D0, 3, 1)>(vb);
  asm volatile("s_waitcnt lgkmcnt(0)" ::: "memory"); SBAR();
#define PK(L, H) (bf16x8){L[0], L[1], L[2], L[3], H[0], H[1], H[2], H[3]}
  od = __builtin_amdgcn_mfma_f32_32x32x16_bf16(pa0, PK(l0, h0), od, 0, 0, 0);
  od = __builtin_amdgcn_mfma_f32_32x32x16_bf16(pa1, PK(l1, h1), od, 0, 0, 0);
  od = __builtin_amdgcn_mfma_f32_32x32x16_bf16(pa2, PK(l2, h2), od, 0, 0, 0);
  od = __builtin_amdgcn_mfma_f32_32x32x16_bf16(pa3, PK(l3, h3), od, 0, 0, 0);
#undef PK
}
__device__ __forceinline__ void pv_d0(f32x16* o, int vb, bf16x8 pa0, bf16x8 pa1, bf16x8 pa2, bf16x8 pa3) {
  pv_one<0>(o[0], vb, pa0, pa1, pa2, pa3); pv_one<1>(o[1], vb, pa0, pa1, pa2, pa3); pv_one<2>(o[2], vb, pa0, pa1, pa2, pa3); pv_one<3>(o[3], vb, pa0, pa1, pa2, pa3);
}
__device__ __forceinline__ void dil_bias(f32x16& p0, f32x16& p1, int dbase, int hi) {
  constexpr float IC = 1.0f / (SCALE * 1.4426950408889634f);
  const int d0 = dbase + 4 * hi;
#pragma unroll
  for (int r = 0; r < 16; ++r) {
#pragma unroll
    for (int half = 0; half < 2; ++half) {
      const int dl = d0 + (r & 3) + 8 * (r >> 2) + 32 * half; const int ad = dl < 0 ? -dl : dl;
      const float f1 = ad <= 64 ? 1.f : 0.f, f2 = (((dl & 3) == 0) & (ad <= 256)) ? 1.f : 0.f, f3 = (((dl & 15) == 0) & (ad <= 1024)) ? 1.f : 0.f;
      const float b = IC * __builtin_amdgcn_logf(f1 + f2 + f3);
      if (half == 0) p0[r] += b; else p1[r] += b;
    }
  }
}
template <int DK> __device__ __forceinline__ void qkt_dk(f32x16& p0, f32x16& p1, const char* Ks, const bf16x8* qr, int r32, int hi) {
  p0 = f32x16{}; p1 = f32x16{};
#pragma unroll
  for (int d0 = 0; d0 < DK / 16; ++d0) { const int cb = (d0 * 16 + hi * 8) * 2;
    bf16x8 b0 = *reinterpret_cast<const bf16x8*>(Ks + r32 * (DK * 2) + (cb ^ ((r32 & 7) << 4)));
    bf16x8 b1 = *reinterpret_cast<const bf16x8*>(Ks + (32 + r32) * (DK * 2) + (cb ^ ((r32 & 7) << 4)));
    p0 = __builtin_amdgcn_mfma_f32_32x32x16_bf16(b0, qr[d0], p0, 0, 0, 0);
    p1 = __builtin_amdgcn_mfma_f32_32x32x16_bf16(b1, qr[d0], p1, 0, 0, 0); }
}
__device__ __forceinline__ float pack_p(const f32x16& p0, const f32x16& p1, bf16x8& pa0, bf16x8& pa1, bf16x8& pa2, bf16x8& pa3) {
  float ps = 0; for (int r = 0; r < 16; ++r) ps += p0[r]; for (int r = 0; r < 16; ++r) ps += p1[r];
  { auto rr = __builtin_amdgcn_permlane32_swap(__float_as_uint(ps), __float_as_uint(ps), false, false);
    ps = __uint_as_float(rr[0]) + __uint_as_float(rr[1]); }
#define PK4(P, BASE, OUT) do { unsigned a0 = cvtpk(P[BASE + 0], P[BASE + 1]), a1 = cvtpk(P[BASE + 2], P[BASE + 3]);   \
    unsigned b0 = cvtpk(P[BASE + 4], P[BASE + 5]), b1 = cvtpk(P[BASE + 6], P[BASE + 7]);                              \
    auto r0 = __builtin_amdgcn_permlane32_swap(a0, b0, false, false); auto r1 = __builtin_amdgcn_permlane32_swap(a1, b1, false, false); \
    u32x4 w = {r0[0], r1[0], r0[1], r1[1]}; OUT = *reinterpret_cast<bf16x8*>(&w); } while (0)
  PK4(p0, 0, pa0); PK4(p0, 8, pa1); PK4(p1, 0, pa2); PK4(p1, 8, pa3);
#undef PK4
  return ps;
}
__device__ __forceinline__ void store_o_tile(const f32x16* o, const float* rli, unsigned short* Ow, int LDO, __attribute__((address_space(3))) unsigned char* ldsl, int wid, int lane) {
  typedef __attribute__((address_space(3))) unsigned short LUS; typedef __attribute__((address_space(3))) u32x4 LU4;
  constexpr int RP = 272;
  const int r32 = lane & 31, hi = lane >> 5;
  unsigned wb = (unsigned)(uintptr_t)ldsl + (unsigned)(wid * (32 * RP) + 4 * hi * RP + r32 * 2), rb = (unsigned)(uintptr_t)ldsl + (unsigned)(wid * (32 * RP) + (lane >> 4) * RP + (lane & 15) * 16);
  asm volatile("" : "+v"(wb), "+v"(rb));
#pragma unroll
  for (int r = 0; r < 16; ++r)
#pragma unroll
    for (int d0 = 0; d0 < 4; ++d0) *(LUS*)(uintptr_t)(wb + (unsigned)(((r & 3) + 8 * (r >> 2)) * RP + d0 * 64)) = (unsigned short)f2bf(o[d0][r] * rli[r]);
  asm volatile("s_waitcnt lgkmcnt(0)" ::: "memory");
  unsigned short* gp = Ow + (long)(lane >> 4) * LDO + (lane & 15) * 8;
#pragma unroll
  for (int k = 0; k < 8; ++k) { const u32x4 w = *(const LU4*)(uintptr_t)(rb + (unsigned)(4 * k * RP)); *reinterpret_cast<u32x4*>(gp + (long)(4 * k) * LDO) = w; }
}
#define WAITBAR(n) do { asm volatile("s_waitcnt vmcnt(" #n ") lgkmcnt(0)" ::: "memory"); __builtin_amdgcn_s_barrier(); asm volatile("" ::: "memory"); } while (0)
template <int MODE, int DK, int LDQ, int LDK, int LDV>
__device__ __forceinline__ void flash_body(const unsigned short* __restrict__ Qb, const unsigned short* __restrict__ Kh, const unsigned short* __restrict__ Vh, int NT, int dk0,
                                           const float* gq, const float* gkc, const float* gkl, int dir, const unsigned short* CT, const float* nst, float gref, unsigned short* Ob, int LDO, __attribute__((address_space(3))) unsigned char* ldsl, int tid) {
  typedef __attribute__((address_space(3))) unsigned LU;
  constexpr int SHM_KD = KVBLK * DK * 2, CPR = DK / 8, KROWS = 512 / CPR, KP = 64 / KROWS, NVB = DK == 128 ? 3 : 2;
  char* lds = (char*)ldsl;
  const int wid = __builtin_amdgcn_readfirstlane(tid >> 6), lane = tid & 63, r32 = lane & 31, hi = lane >> 5;
  char* K_lds = lds + NVB * SHM_V;
  float* ws = (float*)(lds + NVB * SHM_V + 3 * SHM_KD) + wid * 64; float* li_l = ws; float* al_l = ws + 32;
  float* cs_l = (float*)(lds + NVB * SHM_V + 3 * SHM_KD + NW * 256);
  float m_reg = -1e30f, l_reg = 0; f32x16 o[4] = {}; bf16x8 qr[DK / 16];
  const unsigned short* Qw = Qb + (long)(wid * QBLK + r32) * LDQ + hi * 8;
#pragma unroll
  for (int d0 = 0; d0 < DK / 16; ++d0) qr[d0] = *reinterpret_cast<const bf16x8*>(Qw + d0 * 16);
  const int vb0 = (int)(uintptr_t)ldsl + v_rd_base(lane);
  const int dbase0 = dk0 - (wid * QBLK + r32);
  const int krow = tid / CPR, kch = (tid % CPR) ^ (krow & 7);
  const unsigned voffk = (unsigned)(krow * LDK) * 2u + (unsigned)kch * 16u;
  const int vkk = (tid >> 7) * 8 + ((tid >> 2) & 7), vk = (vkk & ~0xC) | ((vkk & 4) << 1) | ((vkk & 8) >> 1), vc = ((tid >> 5) & 3) * 32 + (tid & 3) * 8;
  const unsigned voffv = (unsigned)(vk * LDV + vc) * 2u;
  const float gql = (MODE == 1) ? gq[wid * QBLK + r32] : 0.f;
  const char* kp = (const char*)Kh; const char* vp = (const char*)Vh;
  int ks = 0, vs = 0;
  LU* const kl0 = (LU*)(ldsl + NVB * SHM_V + wid * 1024); LU* const vl0 = (LU*)(ldsl + wid * 1024);
#define STAGE_K() do { _Pragma("unroll") for (int i_ = 0; i_ < KP; ++i_) __builtin_amdgcn_global_load_lds((const unsigned*)(kp + voffk + (unsigned)(i_ * KROWS) * (LDK * 2u)), kl0 + (ks * SHM_KD + i_ * 8192) / 4, 16, 0, 0); \
    kp += KVBLK * LDK * 2; ks = ks == 2 ? 0 : ks + 1; } while (0)
#define STAGE_V() do { _Pragma("unroll") for (int i_ = 0; i_ < 2; ++i_) __builtin_amdgcn_global_load_lds((const unsigned*)(vp + voffv + (unsigned)(i_ * 32) * (LDV * 2u)), vl0 + (vs * SHM_V + i_ * 8192) / 4, 16, 0, 0); \
    vp += KVBLK * LDV * 2; vs = vs == NVB - 1 ? 0 : vs + 1; } while (0)
  bf16x8 pa0, pa1, pa2, pa3; f32x16 p0, p1; float cst = 0.f;
  float b16[8];
#pragma unroll
  for (int i = 0; i < 8; ++i) b16[i] = (MODE == 2 && ((dbase0 + 4 * hi + (i & 3) + 8 * (i >> 2)) & 15) == 0) ? 0.f : -__builtin_inff();
  if (MODE == 1 && tid < 64) cs_l[tid] = gkc[tid] - gkl[tid];
  STAGE_V(); STAGE_K();
  if (MODE == 1 && CT != nullptr) {
    const float sc = __builtin_amdgcn_exp2f((gql - gref) * 1.4426950408889634f); float dn = 0.f;
    const unsigned ctoff = (unsigned)(r32 * 256 + hi * 8) * 2u, noff = (unsigned)hi * 32u; const char* ctb = (const char*)CT; const char* nb = (const char*)nst;
    asm volatile("" : "+s"(ctb), "+s"(nb));
#pragma unroll
    for (int d0 = 0; d0 < DK / 16; ++d0) {
      const u32x4 qw = *reinterpret_cast<const u32x4*>(&qr[d0]); const unsigned qa[4] = {qw.x, qw.y, qw.z, qw.w};
      const f32x4 n0 = *(const f32x4*)(nb + noff + d0 * 64), n1 = *(const f32x4*)(nb + noff + d0 * 64 + 16); const float nn[8] = {n0.x, n0.y, n0.z, n0.w, n1.x, n1.y, n1.z, n1.w};
      unsigned qo[4];
#pragma unroll
      for (int k = 0; k < 4; ++k) { const float a = __builtin_bit_cast(float, qa[k] << 16) * sc, b = __builtin_bit_cast(float, qa[k] & 0xffff0000u) * sc; dn += a * nn[2 * k] + b * nn[2 * k + 1]; qo[k] = cvtpk(a, b); }
      const u32x4 qsw = {qo[0], qo[1], qo[2], qo[3]}; const bf16x8 qs = *reinterpret_cast<const bf16x8*>(&qsw);
#pragma unroll
      for (int eb = 0; eb < 4; ++eb) { const bf16x8 cb = *reinterpret_cast<const bf16x8*>(ctb + ctoff + (eb * 32 * 256 + d0 * 16) * 2);
        o[eb] = __builtin_amdgcn_mfma_f32_32x32x16_bf16(qs, cb, o[eb], 0, 0, 0); }
    }
    { auto rr = __builtin_amdgcn_permlane32_swap(__float_as_uint(dn), __float_as_uint(dn), false, false); dn = __uint_as_float(rr[0]) + __uint_as_float(rr[1]); }
    l_reg += dn;
  }
  if (NVB == 3) { STAGE_V(); STAGE_K(); if (KP == 2) WAITBAR(4); else WAITBAR(6); }
  else { STAGE_K(); if (KP == 2) WAITBAR(2); else WAITBAR(4); }
  int kc = 0, vcur = 0;
#pragma nounroll
  for (int j = 0; j < NT; ++j) {
    if (MODE == 1 && tid < 64 && j + 1 < NT) cst = gkc[(j + 1) * KVBLK + tid] - gkl[(j + 1) * KVBLK + tid];
    const bool more = j + 2 < NT;
    if (NVB == 3) { if (more) { STAGE_V(); STAGE_K(); } }
    else { if (j + 1 < NT) STAGE_V(); if (more) STAGE_K(); }
    SBAR(); qkt_dk<DK>(p0, p1, K_lds + kc * SHM_KD, qr, r32, hi);
    if (MODE == 1) {
      const int b = j & 1;
      const int dbase = dbase0 + 64 * j;
      const int wmin = dk0 + 64 * j - wid * QBLK - 31, wmax = dk0 + 64 * j + 63 - wid * QBLK;
      const bool need_mask = dir == 0 ? (wmax > 0) : (wmin < 0);
      const float* cs = cs_l + b * 64 + 4 * hi;
#pragma unroll
      for (int g = 0; g < 4; ++g) { const f32x4 c0 = *(const f32x4*)(cs + 8 * g), c1 = *(const f32x4*)(cs + 32 + 8 * g);
#pragma unroll
        for (int i = 0; i < 4; ++i) { const int r = 4 * g + i;
          p0[r] *= __builtin_amdgcn_exp2f((gql - c0[i]) * 1.4426950408889634f - 4.0f); p1[r] *= __builtin_amdgcn_exp2f((gql - c1[i]) * 1.4426950408889634f - 4.0f); } }
      if (need_mask) {
#pragma unroll
        for (int r = 0; r < 16; ++r) { const int d0_ = dbase + (r & 3) + 8 * (r >> 2) + 4 * hi, d1_ = d0_ + 32;
          const bool ok0 = dir == 0 ? (d0_ <= 0) : (d0_ >= 0), ok1 = dir == 0 ? (d1_ <= 0) : (d1_ >= 0);
          p0[r] = ok0 ? p0[r] : 0.f; p1[r] = ok1 ? p1[r] : 0.f; }
      }
      l_reg += pack_p(p0, p1, pa0, pa1, pa2, pa3);
    } else {
      if (MODE == 2) {
        const int wmin = dk0 + 64 * j - wid * QBLK - 31, wmax = dk0 + 64 * j + 63 - wid * QBLK;
        if ((wmin > 256 && wmax <= 1024) || (wmax < -256 && wmin >= -1024)) {
#pragma unroll
          for (int r = 0; r < 16; ++r) { const float b = b16[(r & 3) + 4 * ((r >> 2) & 1)]; p0[r] += b; p1[r] += b; }
        } else dil_bias(p0, p1, dbase0 + 64 * j, hi);
      }
      float mn, alpha; partialSM(p0, p1, m_reg, mn, alpha);
      if (__any(alpha < 1.f)) { if (hi == 0) al_l[r32] = alpha; asm volatile("s_waitcnt lgkmcnt(0)" ::: "memory");
        for (int d = 0; d < 4; ++d) for (int r = 0; r < 16; ++r) o[d][r] *= al_l[crow(r, hi)]; }
      finishSM(p0, p1, alpha, l_reg, pa0, pa1, pa2, pa3);
    }
    SBAR();
    pv_d0(o, vb0 + vcur * (int)SHM_V, pa0, pa1, pa2, pa3);
    kc = kc == 2 ? 0 : kc + 1; vcur = vcur == NVB - 1 ? 0 : vcur + 1;
    if (MODE == 1) { if (more) { if (KP == 2) asm volatile("s_waitcnt vmcnt(2)" ::: "memory"); else asm volatile("s_waitcnt vmcnt(4)" ::: "memory"); } else asm volatile("s_waitcnt vmcnt(0)" ::: "memory");
      if (tid < 64 && j + 1 < NT) cs_l[((j + 1) & 1) * 64 + tid] = cst; }
    if (more) { if (NVB == 3) { if (KP == 2) WAITBAR(4); else WAITBAR(6); } else { if (KP == 2) WAITBAR(2); else WAITBAR(4); } }
    else WAITBAR(0);
  }
  if (hi == 0) li_l[r32] = l_reg; asm volatile("s_waitcnt lgkmcnt(0)" ::: "memory");
  float rli[16];
#pragma unroll
  for (int r = 0; r < 16; ++r) { const float lv = li_l[crow(r, hi)]; rli[r] = (MODE == 1) ? 1.0f / fmaxf(fabsf(lv), 1.0f) : __builtin_amdgcn_rcpf(lv); }
  store_o_tile(o, rli, Ob + (long)(wid * QBLK) * LDO, LDO, ldsl, wid, lane);
  __syncthreads();
#undef STAGE_K
#undef STAGE_V
}
template <int MODE, int LDQ, int LDK, int LDV>
__device__ __forceinline__ void flash_body2(const unsigned short* __restrict__ Qb, const unsigned short* __restrict__ Kh, const unsigned short* __restrict__ Vh, int NT, int dk0,
                                            unsigned short* Ob, int LDO, __attribute__((address_space(3))) unsigned char* ldsl, int tid) {
  typedef __attribute__((address_space(3))) unsigned LU;
  constexpr int DK = 128, SHM_KD = KVBLK * DK * 2, CPR = DK / 8;
  char* lds = (char*)ldsl;
  const int wid = __builtin_amdgcn_readfirstlane(tid >> 6), lane = tid & 63, r32 = lane & 31, hi = lane >> 5;
  char* K_lds = lds + 3 * SHM_V;
  float* ws = (float*)(lds + 3 * SHM_V + 3 * SHM_KD) + wid * 64; float* li_l = ws; float* al_l = ws + 32;
  float m_reg = -1e30f, l_reg = 0; f32x16 o[4] = {}; bf16x8 qr[8];
  const unsigned short* Qw = Qb + (long)(wid * QBLK + r32) * LDQ + hi * 8;
#pragma unroll
  for (int d0 = 0; d0 < 8; ++d0) qr[d0] = *reinterpret_cast<const bf16x8*>(Qw + d0 * 16);
  const int vb0 = (int)(uintptr_t)ldsl + v_rd_base(lane);
  const int dbase0 = dk0 - (wid * QBLK + r32);
  const int krow = tid / CPR, kch = (tid % CPR) ^ (krow & 7);
  const unsigned voffk = (unsigned)(krow * LDK) * 2u + (unsigned)kch * 16u;
  const int vkk = (tid >> 7) * 8 + ((tid >> 2) & 7), vk = (vkk & ~0xC) | ((vkk & 4) << 1) | ((vkk & 8) >> 1), vc = ((tid >> 5) & 3) * 32 + (tid & 3) * 8;
  const unsigned voffv = (unsigned)(vk * LDV + vc) * 2u;
  const char* kp = (const char*)Kh; const char* vp = (const char*)Vh; int ks = 0, vs = 0;
  LU* const kl0 = (LU*)(ldsl + 3 * SHM_V + wid * 1024); LU* const vl0 = (LU*)(ldsl + wid * 1024);
#define STAGE_K() do { _Pragma("unroll") for (int i_ = 0; i_ < 2; ++i_) __builtin_amdgcn_global_load_lds((const unsigned*)(kp + voffk + (unsigned)(i_ * 32) * (LDK * 2u)), kl0 + (ks * SHM_KD + i_ * 8192) / 4, 16, 0, 0); \
    kp += KVBLK * LDK * 2; ks = ks == 2 ? 0 : ks + 1; } while (0)
#define STAGE_V() do { _Pragma("unroll") for (int i_ = 0; i_ < 2; ++i_) __builtin_amdgcn_global_load_lds((const unsigned*)(vp + voffv + (unsigned)(i_ * 32) * (LDV * 2u)), vl0 + (vs * SHM_V + i_ * 8192) / 4, 16, 0, 0); \
    vp += KVBLK * LDV * 2; vs = vs == 2 ? 0 : vs + 1; } while (0)
#define RESC(a) do { if (__any((a) < 1.f)) { if (hi == 0) al_l[r32] = (a); asm volatile("s_waitcnt lgkmcnt(0)" ::: "memory"); \
    for (int d = 0; d < 4; ++d) for (int r = 0; r < 16; ++r) o[d][r] *= al_l[crow(r, hi)]; } } while (0)
#define BIAS(P0, P1, t) do { if (MODE == 2) dil_bias(P0, P1, dbase0 + 64 * (t), hi); } while (0)
  f32x16 pA0, pA1, pB0, pB1; float mnA, mnB, alA, alB; bf16x8 pa0, pa1, pa2, pa3;
  STAGE_K(); STAGE_V(); STAGE_K(); STAGE_K(); STAGE_V();
  WAITBAR(4);
  qkt_dk<DK>(pA0, pA1, K_lds, qr, r32, hi); BIAS(pA0, pA1, 0); partialSM(pA0, pA1, m_reg, mnA, alA);
  asm volatile("s_waitcnt lgkmcnt(0)" ::: "memory"); __builtin_amdgcn_s_barrier(); asm volatile("" ::: "memory");
  int kn = 1, vcur = 0;
  for (int j = 0; j < NT; j += 2) {
    const bool m3 = j + 3 < NT, m2 = j + 2 < NT;
    if (m3) STAGE_K(); if (m2) STAGE_V();
    SBAR(); qkt_dk<DK>(pB0, pB1, K_lds + kn * SHM_KD, qr, r32, hi); kn = kn == 2 ? 0 : kn + 1;
    finishSM(pA0, pA1, alA, l_reg, pa0, pa1, pa2, pa3); SBAR();
    pv_d0(o, vb0 + vcur * (int)SHM_V, pa0, pa1, pa2, pa3); vcur = vcur == 2 ? 0 : vcur + 1;
    BIAS(pB0, pB1, j + 1); partialSM(pB0, pB1, m_reg, mnB, alB); RESC(alB);
    if (m3) WAITBAR(4); else if (m2) WAITBAR(2); else WAITBAR(0);
    const bool n3 = j + 4 < NT, n2 = j + 3 < NT;
    if (n3) STAGE_K(); if (n2) STAGE_V();
    SBAR(); if (m2) { qkt_dk<DK>(pA0, pA1, K_lds + kn * SHM_KD, qr, r32, hi); kn = kn == 2 ? 0 : kn + 1; }
    finishSM(pB0, pB1, alB, l_reg, pa0, pa1, pa2, pa3); SBAR();
    pv_d0(o, vb0 + vcur * (int)SHM_V, pa0, pa1, pa2, pa3); vcur = vcur == 2 ? 0 : vcur + 1;
    if (m2) { BIAS(pA0, pA1, j + 2); partialSM(pA0, pA1, m_reg, mnA, alA); RESC(alA); }
    if (n3) WAITBAR(4); else if (n2) WAITBAR(2); else WAITBAR(0);
  }
  if (hi == 0) li_l[r32] = l_reg; asm volatile("s_waitcnt lgkmcnt(0)" ::: "memory");
  float rli[16];
#pragma unroll
  for (int r = 0; r < 16; ++r) rli[r] = __builtin_amdgcn_rcpf(li_l[crow(r, hi)]);
  store_o_tile(o, rli, Ob + (long)(wid * QBLK) * LDO, LDO, ldsl, wid, lane);
  __syncthreads();
#undef STAGE_K
#undef STAGE_V
#undef RESC
#undef BIAS
}
#undef WAITBAR
#undef KSWZ
#undef SBAR
}
__device__ __forceinline__ int ml_state_index(int sq, int h, int dir, int c) { return sq < B_P ? ((sq * 4 + h) * 2 + dir) * 8 + c : 512 + (((sq - B_P) * 4 + h) * 2 + dir) * 16 + c; }
__device__ __forceinline__ void prep_mlstm_states(const Ctx& C, int l) {
    using att::bf16x8; using att::s16x4; using att::f32x16;
    const bf16* proj = (const bf16*)(C.ws + WS_PROJ); const float* gates = (const float*)(C.ws + WS_GATES); const float* gb = C.a->in[I_MLGB] + l * 16;
    bf16* cst = (bf16*)(C.ws + WS_CST); float* nstb = (float*)(C.ws + WS_NST);
    char* ldsg = (char*)C.lds; LAS float* wts = (LAS float*)(C.lds + 49152); LAS float* tot = wts + 256;
    const int wid = C.wave, lane = C.lane, r32 = lane & 31, hi = lane >> 5;
    const int vbK = (int)(uintptr_t)C.lds + (wid >> 2) * 16384 + (wid & 3) * 512 + att::v_rd_base(lane);
    const int vbV = (int)(uintptr_t)C.lds + 32768 + att::v_rd_base(lane);
    for (int it = C.bid; it < 192; it += C.G) {
        const int eh = it & 1, dir = (it >> 1) & 1, h = (it >> 2) & 3, sq = it >> 4;
        const int L = sq < B_P ? L_P : L_S, row0 = sq < B_P ? sq * L_P : TOK_P + (sq - B_P) * L_S, nc = L / 256;
        const float bi = gb[(2 * dir) * 4 + h], bf_ = gb[(2 * dir + 1) * 4 + h];
        f32x16 acc[4] = {}; f32x16 nacc = {};
        for (int ci = 0; ci < nc; ++ci) {
            const int c = dir == 0 ? ci : nc - 1 - ci; const int st = ml_state_index(sq, h, dir, c);
            { bf16* ct = cst + (size_t)st * 65536 + (size_t)(eh * 128) * 256;
#pragma unroll
              for (int eb = 0; eb < 4; ++eb)
#pragma unroll
                for (int g = 0; g < 4; ++g) { v2u w; w.x = pk2(acc[eb][4 * g], acc[eb][4 * g + 1]); w.y = pk2(acc[eb][4 * g + 2], acc[eb][4 * g + 3]);
                    *(v2u*)(ct + (size_t)(eb * 32 + r32) * 256 + wid * 32 + 8 * g + 4 * hi) = w; }
              if (eh == 0 && r32 == 0) { float* np = nstb + (size_t)st * 256 + wid * 32;
#pragma unroll
                for (int r = 0; r < 16; ++r) np[(r & 3) + 8 * (r >> 2) + 4 * hi] = nacc[r]; } }
            if (ci == nc - 1) break;
            __syncthreads();
            float T;
            { float x = 0.f, gi = 0.f;
              if (C.tid < 256) { const int tl = dir == 0 ? C.tid : 255 - C.tid; const size_t row = (size_t)row0 + 256 * c + tl;
                  gi = gates[row * 16 + (2 * dir) * 4 + h] + bi; const float gf = gates[row * 16 + (2 * dir + 1) * 4 + h] + bf_;
                  x = fminf(gf, 0.f) - log1pf(__expf(-fabsf(gf))); }
              const float lf = x;
#pragma unroll
              for (int o = 1; o < 64; o <<= 1) { const float y = __shfl_up(x, o); if (lane >= o) x += y; }
              if (C.tid < 256 && lane == 63) tot[wid] = x;
              __syncthreads();
              float pre = 0.f; for (int w = 0; w < 4; ++w) { const float tw = tot[w]; if (w < wid) pre += tw; }
              T = tot[0] + tot[1] + tot[2] + tot[3];
              if (C.tid < 256) { const float incl = x + pre; const int tl = dir == 0 ? C.tid : 255 - C.tid;
                  wts[tl] = __expf(T - incl + gi) * 0.0625f; (void)lf; }
            }
            __syncthreads();
            { const float aT = __expf(T);
#pragma unroll
              for (int eb = 0; eb < 4; ++eb) acc[eb] = acc[eb] * aT;
              nacc = nacc * aT; }
            const bf16* kb = proj + (size_t)(row0 + 256 * c) * NPROJ + C_DK + h * 256; const bf16* vb = proj + (size_t)(row0 + 256 * c) * NPROJ + C_DV + h * 256 + eh * 128;
            v4u kreg[4], vreg[2];
#define ST_LOAD(kt_) do { _Pragma("unroll") for (int i = 0; i < 4; ++i) { const int id = C.tid + 512 * i, row = id >> 5, c16 = id & 31; kreg[i] = *(const v4u*)(kb + (size_t)(64 * (kt_) + row) * NPROJ + c16 * 8); } \
    _Pragma("unroll") for (int i = 0; i < 2; ++i) { const int id = C.tid + 512 * i, row = id >> 4, c16 = id & 15; vreg[i] = *(const v4u*)(vb + (size_t)(64 * (kt_) + row) * NPROJ + c16 * 8); } } while (0)
            ST_LOAD(0);
            for (int kt = 0; kt < 4; ++kt) {
#pragma unroll
                for (int i = 0; i < 4; ++i) { const int id = C.tid + 512 * i, row = id >> 5, c16 = id & 31; const float w = wts[64 * kt + row]; const unsigned kw[4] = {kreg[i].x, kreg[i].y, kreg[i].z, kreg[i].w}; v4u o;
                    o.x = pk2(bflo(kw[0]) * w, bfhi(kw[0]) * w); o.y = pk2(bflo(kw[1]) * w, bfhi(kw[1]) * w); o.z = pk2(bflo(kw[2]) * w, bfhi(kw[2]) * w); o.w = pk2(bflo(kw[3]) * w, bfhi(kw[3]) * w);
                    *(v4u*)(ldsg + (c16 >> 4) * 16384 + att::v_st(row, (c16 & 15) * 8)) = o; }
#pragma unroll
                for (int i = 0; i < 2; ++i) { const int id = C.tid + 512 * i, row = id >> 4, c16 = id & 15; *(v4u*)(ldsg + 32768 + att::v_st(row, c16 * 8)) = vreg[i]; }
                if (kt + 1 < 4) ST_LOAD(kt + 1);
                __syncthreads();
#pragma unroll
                for (int ks = 0; ks < 4; ++ks) {
                    s16x4 al, ah;
                    if (ks == 0) { al = att::tr_read<att::v_rd_off(0, 0, 0)>(vbK); ah = att::tr_read<att::v_rd_off(0, 0, 1)>(vbK); }
                    else if (ks == 1) { al = att::tr_read<att::v_rd_off(0, 1, 0)>(vbK); ah = att::tr_read<att::v_rd_off(0, 1, 1)>(vbK); }
                    else if (ks == 2) { al = att::tr_read<att::v_rd_off(0, 2, 0)>(vbK); ah = att::tr_read<att::v_rd_off(0, 2, 1)>(vbK); }
                    else { al = att::tr_read<att::v_rd_off(0, 3, 0)>(vbK); ah = att::tr_read<att::v_rd_off(0, 3, 1)>(vbK); }
                    s16x4 bl[4], bh[4];
#define RDB(EB) do { if (ks == 0) { bl[EB] = att::tr_read<att::v_rd_off(EB, 0, 0)>(vbV); bh[EB] = att::tr_read<att::v_rd_off(EB, 0, 1)>(vbV); } \
                     else if (ks == 1) { bl[EB] = att::tr_read<att::v_rd_off(EB, 1, 0)>(vbV); bh[EB] = att::tr_read<att::v_rd_off(EB, 1, 1)>(vbV); } \
                     else if (ks == 2) { bl[EB] = att::tr_read<att::v_rd_off(EB, 2, 0)>(vbV); bh[EB] = att::tr_read<att::v_rd_off(EB, 2, 1)>(vbV); } \
                     else { bl[EB] = att::tr_read<att::v_rd_off(EB, 3, 0)>(vbV); bh[EB] = att::tr_read<att::v_rd_off(EB, 3, 1)>(vbV); } } while (0)
                    RDB(0); RDB(1); RDB(2); RDB(3);
#undef RDB
                    asm volatile("s_waitcnt lgkmcnt(0)" ::: "memory"); __builtin_amdgcn_sched_barrier(0);
                    const bf16x8 a = (bf16x8){al[0], al[1], al[2], al[3], ah[0], ah[1], ah[2], ah[3]};
                    const bf16x8 ones = (bf16x8){0x3f80, 0x3f80, 0x3f80, 0x3f80, 0x3f80, 0x3f80, 0x3f80, 0x3f80};
#pragma unroll
                    for (int eb = 0; eb < 4; ++eb) { const bf16x8 b = (bf16x8){bl[eb][0], bl[eb][1], bl[eb][2], bl[eb][3], bh[eb][0], bh[eb][1], bh[eb][2], bh[eb][3]};
                        acc[eb] = __builtin_amdgcn_mfma_f32_32x32x16_bf16(a, b, acc[eb], 0, 0, 0); }
                    nacc = __builtin_amdgcn_mfma_f32_32x32x16_bf16(a, ones, nacc, 0, 0, 0);
                }
                __syncthreads();
            }
#undef ST_LOAD
        }
    }
    __syncthreads();
}
namespace hy {
typedef float f32x2 __attribute__((ext_vector_type(2)));
typedef __attribute__((address_space(3))) f32x2 LF2;
__device__ __forceinline__ int phys(int i) { return i + (i >> 4); }
__device__ constexpr float ROT_C[8] = {1.0f, 0.9238795325112867f, 0.7071067811865476f, 0.3826834323650898f, 0.0f, -0.3826834323650898f, -0.7071067811865476f, -0.9238795325112867f};
__device__ constexpr float ROT_S[8] = {0.0f, 0.3826834323650898f, 0.7071067811865476f, 0.9238795325112867f, 1.0f, 0.9238795325112867f, 0.7071067811865476f, 0.3826834323650898f};
template <int K, bool INV> __device__ __forceinline__ void fft_pass(LF2* X, int logN, int s, int tid) {
    constexpr int R = 1 << K; const int lq = logN - s - K, q = 1 << lq; const float rms = 1.0f / (float)(q << K);
    for (int g = tid; g < (1 << (logN - K)); g += NTHR) {
        const int p = g & (q - 1), i0 = ((g >> lq) << (lq + K)) + p;
        f32x2 v[R];
#pragma unroll
        for (int e = 0; e < R; ++e) v[e] = X[phys(i0 + e * q)];
        float wc[K], wsn[K];
        { const float f = (float)p * rms; wc[0] = __builtin_amdgcn_cosf(f); wsn[0] = __builtin_amdgcn_sinf(f);
#pragma unroll
          for (int j = 1; j < K; ++j) { wc[j] = wc[j - 1] * wc[j - 1] - wsn[j - 1] * wsn[j - 1]; wsn[j] = 2.0f * wc[j - 1] * wsn[j - 1]; } }
#pragma unroll
        for (int jj = 0; jj < K; ++jj) { const int j = INV ? K - 1 - jj : jj; const int dist = R >> (j + 1);
#pragma unroll
            for (int e = 0; e < R; ++e) if (((e / dist) & 1) == 0) { const int a = e, b = e + dist; const int t8 = (a % dist) * (8 / dist);
                const float cr = ROT_C[t8], sr = ROT_S[t8]; const float c = wc[j] * cr - wsn[j] * sr, sn = wsn[j] * cr + wc[j] * sr;
                if (!INV) { const f32x2 t = v[a] - v[b]; v[a] = v[a] + v[b]; v[b] = (f32x2){t.x * c + t.y * sn, t.y * c - t.x * sn}; }
                else { const f32x2 t = (f32x2){v[b].x * c - v[b].y * sn, v[b].y * c + v[b].x * sn}; v[b] = v[a] - t; v[a] = v[a] + t; } }
        }
#pragma unroll
        for (int e = 0; e < R; ++e) X[phys(i0 + e * q)] = v[e];
    }
}
__device__ __forceinline__ void fft_fwd(LF2* X, int logN, int tid) {
    int s; if (logN == 13) { fft_pass<4, false>(X, logN, 0, tid); s = 4; } else { fft_pass<3, false>(X, logN, 0, tid); s = 3; }
    __syncthreads();
    for (; s < logN; s += 3) { fft_pass<3, false>(X, logN, s, tid); __syncthreads(); }
}
__device__ __forceinline__ void fft_inv(LF2* X, int logN, int tid) {
    const int s0 = logN == 13 ? 4 : 3;
    for (int s = logN - 3; s >= s0; s -= 3) { fft_pass<3, true>(X, logN, s, tid); __syncthreads(); }
    if (logN == 13) fft_pass<4, true>(X, logN, 0, tid); else fft_pass<3, true>(X, logN, 0, tid);
    __syncthreads();
}
template <int LOGN>
__device__ __forceinline__ void hyena_fft_unit_t(const Ctx& C, int l, int c) {
    constexpr int N = 1 << LOGN, L = N / 2, NB = LOGN == 13 ? B_S : B_P, row0 = LOGN == 13 ? TOK_P : 0, XB = (N + N / 16) * 8, NH = N / NTHR;
    LF2* X0 = (LF2*)C.lds; LF2* X1 = (LF2*)(C.lds + XB);
    bf16* uct = (bf16*)(C.ws + WS_UCT); const float* hfil = (const float*)(C.ws + WS_HFIL) + (LOGN == 13 ? (size_t)2048 * L_P : 0); const float* skip = C.a->in[I_HSKIP] + l * 2048;
    const float rn = 1.0f / (float)N;
    f32x2* hsp = (f32x2*)(C.ws + WS_HSP + (size_t)C.bid * 131072);
    { const float* h0 = hfil + (size_t)c * L; const float* h1 = hfil + (size_t)(1024 + c) * L;
      __syncthreads();
      for (int n = C.tid; n < N; n += NTHR) X0[phys(n)] = n < L ? (f32x2){h0[n], h1[n]} : (f32x2){0.f, 0.f};
      __syncthreads();
      fft_fwd(X0, LOGN, C.tid);
      const float hr = 0.5f * rn;
#pragma unroll 2
      for (int p = C.tid; p < N; p += NTHR) { const int kn = (int)(__builtin_bitreverse32((unsigned)p) >> (32 - LOGN)), p2 = (int)(__builtin_bitreverse32((unsigned)((N - kn) & (N - 1))) >> (32 - LOGN));
          const f32x2 z1 = X0[phys(p)], z2 = X0[phys(p2)];
          hsp[p] = (f32x2){(z1.x + z2.x) * hr, (z1.y - z2.y) * hr}; hsp[8192 + p] = (f32x2){(z1.y + z2.y) * hr, (z2.x - z1.x) * hr}; } }
    for (int o = 0; o < 2; ++o) {
        const float sk = skip[o * 1024 + c];
        f32x2 hf[NH];
#pragma unroll
        for (int k = 0; k < NH; ++k) hf[k] = hsp[o * 8192 + C.tid + NTHR * k];
        bf16* src = uct + (size_t)c * NTOK + row0; const bf16* gate = uct + (size_t)((o + 1) * 1024 + c) * NTOK + row0; bf16* dst = o == 0 ? src : uct + (size_t)(1024 + c) * NTOK + row0;
        for (int pp = 0; pp < NB / 4; ++pp) {
            __syncthreads();
            const int n0 = 8 * C.tid; const bool act = n0 < L;
            v4u sa[2], sb[2], qa[2], qb[2];
#pragma unroll
            for (int w = 0; w < 2; ++w) { const int t1 = (4 * pp + 2 * w) * L, t2 = t1 + L; if (act) { sa[w] = *(const v4u*)(src + t1 + n0); sb[w] = *(const v4u*)(src + t2 + n0); } }
#pragma unroll
            for (int w = 0; w < 2; ++w) { const int t1 = (4 * pp + 2 * w) * L, t2 = t1 + L; if (act) { qa[w] = *(const v4u*)(gate + t1 + n0); qb[w] = *(const v4u*)(gate + t2 + n0); } }
#pragma unroll
            for (int w = 0; w < 2; ++w) { LF2* X = w ? X1 : X0;
                for (int n8 = C.tid; n8 < N / 8; n8 += NTHR) { const int n = 8 * n8;
                    if (n < L) { const unsigned aw[4] = {sa[w].x, sa[w].y, sa[w].z, sa[w].w}, bw[4] = {sb[w].x, sb[w].y, sb[w].z, sb[w].w};
#pragma unroll
                        for (int k = 0; k < 4; ++k) { X[phys(n + 2 * k)] = (f32x2){bflo(aw[k]), bflo(bw[k])}; X[phys(n + 2 * k + 1)] = (f32x2){bfhi(aw[k]), bfhi(bw[k])}; } }
                    else {
#pragma unroll
                        for (int k = 0; k < 8; ++k) X[phys(n + k)] = (f32x2){0.f, 0.f}; } } }
            __syncthreads();
            { int s; if (LOGN == 13) { fft_pass<4, false>(X0, LOGN, 0, C.tid); fft_pass<4, false>(X1, LOGN, 0, C.tid); s = 4; } else { fft_pass<3, false>(X0, LOGN, 0, C.tid); fft_pass<3, false>(X1, LOGN, 0, C.tid); s = 3; }
              __syncthreads();
              for (; s < LOGN; s += 3) { fft_pass<3, false>(X0, LOGN, s, C.tid); fft_pass<3, false>(X1, LOGN, s, C.tid); __syncthreads(); } }
#pragma unroll
            for (int k = 0; k < NH; ++k) { const int i = phys(C.tid + NTHR * k); const f32x2 b = hf[k]; const f32x2 a0 = X0[i], a1 = X1[i];
                X0[i] = (f32x2){a0.x * b.x - a0.y * b.y, a0.x * b.y + a0.y * b.x}; X1[i] = (f32x2){a1.x * b.x - a1.y * b.y, a1.x * b.y + a1.y * b.x}; }
            __syncthreads();
            { const int s0 = LOGN == 13 ? 4 : 3;
              for (int s = LOGN - 3; s >= s0; s -= 3) { fft_pass<3, true>(X0, LOGN, s, C.tid); fft_pass<3, true>(X1, LOGN, s, C.tid); __syncthreads(); }
              if (LOGN == 13) { fft_pass<4, true>(X0, LOGN, 0, C.tid); fft_pass<4, true>(X1, LOGN, 0, C.tid); } else { fft_pass<3, true>(X0, LOGN, 0, C.tid); fft_pass<3, true>(X1, LOGN, 0, C.tid); }
              __syncthreads(); }
#pragma unroll
            for (int w = 0; w < 2; ++w) { const LF2* X = w ? X1 : X0; const int t1 = (4 * pp + 2 * w) * L, t2 = t1 + L;
                if (act) { const int t = n0;
                    const v4u ua = sa[w], ub = sb[w], ga = qa[w], gb = qb[w];
                    const unsigned uaw[4] = {ua.x, ua.y, ua.z, ua.w}, ubw[4] = {ub.x, ub.y, ub.z, ub.w}, gaw[4] = {ga.x, ga.y, ga.z, ga.w}, gbw[4] = {gb.x, gb.y, gb.z, gb.w}; unsigned ra[4], rb[4];
#pragma unroll
                    for (int k = 0; k < 4; ++k) { const f32x2 y0 = X[phys(t + L / 2 + 2 * k)], y1 = X[phys(t + L / 2 + 2 * k + 1)];
                        ra[k] = pk2(bflo(gaw[k]) * (y0.x + sk * bflo(uaw[k])), bfhi(gaw[k]) * (y1.x + sk * bfhi(uaw[k])));
                        rb[k] = pk2(bflo(gbw[k]) * (y0.y + sk * bflo(ubw[k])), bfhi(gbw[k]) * (y1.y + sk * bfhi(ubw[k]))); }
                    *(v4u*)(dst + t1 + t) = (v4u){ra[0], ra[1], ra[2], ra[3]}; *(v4u*)(dst + t2 + t) = (v4u){rb[0], rb[1], rb[2], rb[3]}; } }
        }
    }
    __syncthreads();
}
__device__ __forceinline__ void hyena_fft_unit(const Ctx& C, int l, int c, int grp) { if (grp) hyena_fft_unit_t<13>(C, l, c); else hyena_fft_unit_t<12>(C, l, c); }
}
template <int DK, int DV, int KT, int MODE>
__device__ __forceinline__ void valu_attn_item(const Ctx& C, const bf16* Qp, int ldq, const bf16* Kp, int ldk, const bf16* Vp, int ldv, int q0, int kt_lo, int kt_hi, float qscale,
                                               const float* gcum, const float* gli, int dir, bf16* outb, float* outf, int ldo) {
    constexpr int QD = DK / 4, VD = DV / 4;
    LAS float* Ks = (LAS float*)C.lds; LAS float* Vs = Ks + KT * DK; LAS float* Gs = Vs + KT * DV;
    const int qi = C.tid >> 2, part = C.tid & 3, tq = q0 + qi;
    float q[QD], o[VD];
    { const bf16* qp = Qp + (size_t)tq * ldq + part * QD;
#pragma unroll
      for (int j = 0; j < QD; j += 8) { const v4u w = *(const v4u*)(qp + j);
          q[j] = bflo(w.x) * qscale; q[j + 1] = bfhi(w.x) * qscale; q[j + 2] = bflo(w.y) * qscale; q[j + 3] = bfhi(w.y) * qscale; q[j + 4] = bflo(w.z) * qscale; q[j + 5] = bfhi(w.z) * qscale; q[j + 6] = bflo(w.w) * qscale; q[j + 7] = bfhi(w.w) * qscale; } }
#pragma unroll
    for (int j = 0; j < VD; ++j) o[j] = 0.f;
    float m = -1e30f, lsum = 0.f; const float gq = (MODE == 1) ? gcum[tq] : 0.f;
    for (int kt = kt_lo; kt < kt_hi; ++kt) {
        __syncthreads();
        for (int idx = C.tid; idx < KT * DK / 8; idx += NTHR) { const int s = idx / (DK / 8), c8 = idx % (DK / 8); const v4u w = *(const v4u*)(Kp + (size_t)(kt * KT + s) * ldk + c8 * 8);
            LAS f32x4* d = (LAS f32x4*)(Ks + s * DK + c8 * 8); d[0] = (f32x4){bflo(w.x), bfhi(w.x), bflo(w.y), bfhi(w.y)}; d[1] = (f32x4){bflo(w.z), bfhi(w.z), bflo(w.w), bfhi(w.w)}; }
        for (int idx = C.tid; idx < KT * DV / 8; idx += NTHR) { const int s = idx / (DV / 8), c8 = idx % (DV / 8); const v4u w = *(const v4u*)(Vp + (size_t)(kt * KT + s) * ldv + c8 * 8);
            LAS f32x4* d = (LAS f32x4*)(Vs + s * DV + c8 * 8); d[0] = (f32x4){bflo(w.x), bfhi(w.x), bflo(w.y), bfhi(w.y)}; d[1] = (f32x4){bflo(w.z), bfhi(w.z), bflo(w.w), bfhi(w.w)}; }
        if (MODE == 1 && C.tid < KT) { Gs[2 * C.tid] = gcum[kt * KT + C.tid]; Gs[2 * C.tid + 1] = gli[kt * KT + C.tid]; }
        __syncthreads();
        for (int s = 0; s < KT; ++s) {
            const LAS f32x4* kr = (const LAS f32x4*)(Ks + s * DK + part * QD); float dot = 0.f;
#pragma unroll
            for (int j = 0; j < QD / 4; ++j) { const f32x4 kv = kr[j]; dot += (q[4 * j] * kv.x + q[4 * j + 1] * kv.y) + (q[4 * j + 2] * kv.z + q[4 * j + 3] * kv.w); }
            dot += __shfl_xor(dot, 1); dot += __shfl_xor(dot, 2);
            const int ks = kt * KT + s; float p;
            if (MODE == 1) { const bool ok = dir == 0 ? (ks <= tq) : (ks >= tq); p = ok ? dot * __expf(gq - Gs[2 * s] + Gs[2 * s + 1]) : 0.f; lsum += p; }
            else {
                float mult = 1.f;
                if (MODE == 2) { const int dl = ks - tq, ad = dl < 0 ? -dl : dl; mult = (ad <= 64 ? 1.f : 0.f) + (((dl & 3) == 0 && ad <= 256) ? 1.f : 0.f) + (((dl & 15) == 0 && ad <= 1024) ? 1.f : 0.f); }
                if (mult > 0.f) {
                    if (dot > m) { const float al = __expf(m - dot); lsum *= al;
#pragma unroll
                        for (int j = 0; j < VD; ++j) o[j] *= al;
                        m = dot; }
                    p = mult * __expf(dot - m); lsum += p;
                } else p = 0.f;
            }
            const LAS f32x4* vr = (const LAS f32x4*)(Vs + s * DV + part * VD);
#pragma unroll
            for (int j = 0; j < VD / 4; ++j) { const f32x4 vv = vr[j]; o[4 * j] += p * vv.x; o[4 * j + 1] += p * vv.y; o[4 * j + 2] += p * vv.z; o[4 * j + 3] += p * vv.w; }
        }
    }
    const float inv = (MODE == 1) ? 1.0f / fmaxf(fabsf(lsum), 1.0f) : 1.0f / lsum;
    if (MODE == 1) { float* op = outf + (size_t)tq * ldo + part * VD;
#pragma unroll
        for (int j = 0; j < VD; j += 4) *(f32x4*)(op + j) = (f32x4){o[j] * inv, o[j + 1] * inv, o[j + 2] * inv, o[j + 3] * inv}; }
    else { bf16* op = outb + (size_t)tq * ldo + part * VD;
#pragma unroll
        for (int j = 0; j < VD; j += 8) { v4u w; w.x = pk2(o[j] * inv, o[j + 1] * inv); w.y = pk2(o[j + 2] * inv, o[j + 3] * inv); w.z = pk2(o[j + 4] * inv, o[j + 5] * inv); w.w = pk2(o[j + 6] * inv, o[j + 7] * inv); *(v4u*)(op + j) = w; } }
}
__device__ __forceinline__ void hyena_direct_item(const Ctx& C, int l, int c, int row0, int L) {
    LAS float* su = (LAS float*)C.lds;
    LAS float* sz = su + 4096;
    LAS float* sh = sz + 4096;
    const bf16* uct = (const bf16*)(C.ws + WS_UCT); const float* hf = (const float*)(C.ws + WS_HFIL) + (L == L_S ? (size_t)2048 * L_P : 0);
    const float* skip = C.a->in[I_HSKIP] + l * 2048; bf16* y = (bf16*)(C.ws + WS_HA);
    const bf16* vch = uct + (size_t)c * NTOK + row0; const bf16* x1ch = uct + (size_t)(1024 + c) * NTOK + row0; const bf16* x2ch = uct + (size_t)(2048 + c) * NTOK + row0;
    __syncthreads();
    for (int t = C.tid; t < L; t += NTHR) su[t] = bf2f(vch[t]);
    for (int o = 0; o < 2; ++o) {
        const float* h = hf + (size_t)(o * 1024 + c) * L; const float sk = skip[o * 1024 + c];
        for (int i = C.tid; i < 2 * L; i += NTHR) { const int n = i - L / 2; sh[i] = (n >= 0 && n < L) ? h[n] : 0.f; }
        __syncthreads();
        const LAS float* in = o == 0 ? su : sz;
        if (C.tid < L / 8) {
            const int t0 = 8 * C.tid; float acc[8];
#pragma unroll
            for (int j = 0; j < 8; ++j) acc[j] = 0.f;
            for (int s8 = 0; s8 < L; s8 += 8) {
                const f32x4 ua = *(const LAS f32x4*)(in + s8), ub = *(const LAS f32x4*)(in + s8 + 4); const float uu[8] = {ua.x, ua.y, ua.z, ua.w, ub.x, ub.y, ub.z, ub.w};
                const LAS f32x4* hp = (const LAS f32x4*)(sh + (t0 - s8 + L - 8)); const f32x4 h0 = hp[0], h1 = hp[1], h2 = hp[2], h3 = hp[3];
                const float hh[16] = {h0.x, h0.y, h0.z, h0.w, h1.x, h1.y, h1.z, h1.w, h2.x, h2.y, h2.z, h2.w, h3.x, h3.y, h3.z, h3.w};
#pragma unroll
                for (int j = 0; j < 8; ++j)
#pragma unroll
                    for (int jj = 0; jj < 8; ++jj) acc[j] += uu[jj] * hh[8 + j - jj];
            }
            if (o == 0) {
#pragma unroll
                for (int j = 0; j < 8; ++j) { const int t = t0 + j; sz[t] = bf2f(x1ch[t]) * (acc[j] + sk * su[t]); }
            } else {
#pragma unroll
                for (int j = 0; j < 8; ++j) { const int t = t0 + j; y[(size_t)(row0 + t) * DM + 2048 + c] = (bf16)f2bf(bf2f(x2ch[t]) * (acc[j] + sk * sz[t])); }
            }
        }
        __syncthreads();
    }
}
__device__ __forceinline__ void c_transpose_chunk(const Ctx& C, int k) {
    LAS unsigned short* tile = (LAS unsigned short*)C.lds + C.wave * (64 * 72);
    const bf16* uct = (const bf16*)(C.ws + WS_UCT) + (size_t)1024 * NTOK; bf16* yy = (bf16*)(C.ws + WS_HA);
    { const int it = C.gw + k * C.NGW; if (it >= (NTOK / 64) * 16) return;
        const int tb = it >> 4, cbk = it & 15;
#pragma unroll
        for (int k = 0; k < 8; ++k) { const int id = C.lane + 64 * k, chw = id >> 3, part = id & 7; const v4u w = *(const v4u*)(uct + (size_t)(cbk * 64 + chw) * NTOK + tb * 64 + part * 8);
            *(LAS v4u*)(tile + chw * 72 + part * 8) = w; }
        LDS_WAIT(); asm volatile("" ::: "memory");
#pragma unroll
        for (int k = 0; k < 8; ++k) { const int id = C.lane + 64 * k, tok = id >> 3, cp = id & 7; unsigned short e[8];
#pragma unroll
            for (int j = 0; j < 8; ++j) e[j] = tile[(cp * 8 + j) * 72 + tok];
            v4u w; w.x = e[0] | ((unsigned)e[1] << 16); w.y = e[2] | ((unsigned)e[3] << 16); w.z = e[4] | ((unsigned)e[5] << 16); w.w = e[6] | ((unsigned)e[7] << 16);
            *(v4u*)(yy + (size_t)(tb * 64 + tok) * DM + 2048 + cbk * 64 + cp * 8) = w; }
        LDS_WAIT(); asm volatile("" ::: "memory");
    }
}
__device__ __forceinline__ void post_head(const Ctx& C, int l, int rb, int h) {
    const bf16* proj = (const bf16*)(C.ws + WS_PROJ); bf16* y = (bf16*)(C.ws + WS_HA); const bf16* dh = (const bf16*)(C.ws + WS_DH);
    const int col = h * 256 + 4 * C.lane; const f32x4 gv = *(const f32x4*)(C.a->in[I_MLNG] + l * 1024 + col);
#pragma nounroll
    for (int i = 0; i < 32; i += 8) {
        v2u a[8], b[8], o[8];
#pragma unroll
        for (int u = 0; u < 8; ++u) { const size_t row = (size_t)(rb + C.wave + 8 * (i + u));
            a[u] = *(const v2u*)(dh + row * 1024 + col); b[u] = *(const v2u*)(dh + (size_t)NTOK * 1024 + row * 1024 + col); o[u] = *(const v2u*)(proj + row * NPROJ + C_DO + col); }
#pragma unroll
        for (int u = 0; u < 8; ++u) { const size_t row = (size_t)(rb + C.wave + 8 * (i + u));
            const float h0 = bflo(a[u].x) + bflo(b[u].x), h1 = bfhi(a[u].x) + bfhi(b[u].x), h2 = bflo(a[u].y) + bflo(b[u].y), h3 = bfhi(a[u].y) + bfhi(b[u].y);
            const float ss = wave_sum((h0 * h0 + h1 * h1) + (h2 * h2 + h3 * h3));
            const float r = 1.0f / sqrtf(ss * (1.0f / 256.0f) + EPS);
            const float y0 = h0 * r * gv.x / (1.0f + __expf(-bflo(o[u].x))), y1 = h1 * r * gv.y / (1.0f + __expf(-bfhi(o[u].x))), y2 = h2 * r * gv.z / (1.0f + __expf(-bflo(o[u].y))), y3 = h3 * r * gv.w / (1.0f + __expf(-bfhi(o[u].y)));
            v2u w; w.x = pk2(y0, y1); w.y = pk2(y2, y3); *(v2u*)(y + row * DM + 3072 + col) = w; }
    }
}
__device__ __forceinline__ void phase_mix_d(const Ctx& C, int l) {
    const bf16* proj = (const bf16*)(C.ws + WS_PROJ); const float* gc = (const float*)(C.ws + WS_GCUM); bf16* dh = (bf16*)(C.ws + WS_DH);
    const bf16* cst = (const bf16*)(C.ws + WS_CST); const float* nstb = (const float*)(C.ws + WS_NST);
    LAS unsigned char* ldsg = C.lds;
    const int vcu = (C.G & 7) == 0 ? (C.bid & 7) * (C.G >> 3) + (C.bid >> 3) : C.bid;
    const int NI = ((NTOK / 64) * 16 + C.NGW - 1) / C.NGW; int kt = 0;
    for (int it2 = vcu; it2 < 512; it2 += C.G) {
        int sq, h, qb;
        { const int it = 2 * it2; if (it < 512) { sq = B_P + (it >> 7); h = (it >> 5) & 3; qb = (it >> 1) & 15; } else { const int r = it - 512; sq = r >> 6; h = (r >> 4) & 3; qb = (r >> 1) & 7; } }
        const int L = sq < B_P ? L_P : L_S, row0 = sq < B_P ? sq * L_P : TOK_P + (sq - B_P) * L_S, nc = L / 256; const bf16* base = proj + (size_t)row0 * NPROJ; const int q0 = qb * 256;
        for (int eh = 0; eh < 2; ++eh) {
            const bf16* Qb = base + (size_t)q0 * NPROJ + C_DQ + h * 256; const bf16* Kb = base + (size_t)q0 * NPROJ + C_DK + h * 256; const bf16* Vb = base + (size_t)q0 * NPROJ + C_DV + h * 256 + eh * 128;
            bf16* of = dh + (size_t)(row0 + q0) * 1024 + h * 256 + eh * 128;
            for (int dir = 0; dir < 2; ++dir) {
                const float* gcs = gc + (size_t)((2 * dir) * 4 + h) * NTOK + row0; const float* gls = gc + (size_t)((2 * dir + 1) * 4 + h) * NTOK + row0;
                const bool inter = dir == 0 ? (qb > 0) : (qb < nc - 1); const float gref = inter ? (dir == 0 ? gcs[q0 - 1] : gcs[q0 + 256]) : 0.f;
                const int st = ml_state_index(sq, h, dir, qb);
                att::flash_body<1, 256, NPROJ, NPROJ, NPROJ>(Qb, Kb, Vb, 4, 0, gcs + q0, gcs + q0, gls + q0, dir, inter ? cst + (size_t)st * 65536 + (size_t)(eh * 128) * 256 : nullptr, nstb + (size_t)st * 256, gref,
                                                             of + (size_t)dir * NTOK * 1024, 1024, ldsg, opaque_tid());
            }
            if (kt < NI) { const Ctx C2 = make_ctx(C.lds); c_transpose_chunk(C2, kt); ++kt; __syncthreads(); }
        }
        { const Ctx C2 = make_ctx(C.lds); post_head(C2, l, row0 + q0, h); }
    }
    for (; kt < NI; ++kt) { const Ctx C2 = make_ctx(C.lds); c_transpose_chunk(C2, kt); }
}
__device__ __forceinline__ void unit_decode(int u, int& sq, int& h, int& qb) { if (u < 512) { const int r = u; sq = B_P + (r >> 7); h = (r >> 4) & 7; qb = r & 15; } else { const int r = u - 512; sq = r >> 6; h = (r >> 3) & 7; qb = r & 7; } }
__device__ __forceinline__ void phase_mix_b(const Ctx& C, int l) {
    const bf16* proj = (const bf16*)(C.ws + WS_PROJ); bf16* y = (bf16*)(C.ws + WS_HA); LAS unsigned char* ldsg = C.lds;
    const int vcu = (C.G & 7) == 0 ? (C.bid & 7) * (C.G >> 3) + (C.bid >> 3) : C.bid;
    for (int it = vcu; it < 1024; it += C.G) {
        int sq, h, qb; unit_decode(it, sq, h, qb);
        const int L = sq < B_P ? L_P : L_S, row0 = sq < B_P ? sq * L_P : TOK_P + (sq - B_P) * L_S; const bf16* base = proj + (size_t)row0 * NPROJ; const int q0 = qb * 256;
        att::flash_body2<0, NPROJ, NPROJ, NPROJ>(base + (size_t)q0 * NPROJ + C_BQ + h * 128, base + C_BK + (h >> 2) * 128, base + C_BV + (h >> 2) * 128, L / 64, 0, y + (size_t)(row0 + q0) * DM + 1024 + h * 128, DM, ldsg, C.tid);
    }
}
__device__ __forceinline__ void phase_mix_a(const Ctx& C, int l) {
    const bf16* proj = (const bf16*)(C.ws + WS_PROJ); bf16* y = (bf16*)(C.ws + WS_HA); LAS unsigned char* ldsg = C.lds;
    const int vcu = (C.G & 7) == 0 ? (C.bid & 7) * (C.G >> 3) + (C.bid >> 3) : C.bid;
    for (int it = vcu; it < 1024; it += C.G) {
        int sq, h, qb; unit_decode(it, sq, h, qb);
        const int L = sq < B_P ? L_P : L_S, row0 = sq < B_P ? sq * L_P : TOK_P + (sq - B_P) * L_S; const bf16* base = proj + (size_t)row0 * NPROJ; const int q0 = qb * 256;
        const int klo = q0 - 1024 < 0 ? 0 : q0 - 1024, khi = q0 + 256 + 1024 > L ? L : q0 + 256 + 1024;
        att::flash_body<2, 128, NPROJ, NPROJ, NPROJ>(base + (size_t)q0 * NPROJ + C_AQ + h * 128, base + (size_t)klo * NPROJ + C_AK + h * 128, base + (size_t)klo * NPROJ + C_AV + h * 128, (khi - klo) / 64, klo - q0, nullptr, nullptr, nullptr, 0,
                                                     nullptr, nullptr, 0.f, y + (size_t)(row0 + q0) * DM + h * 128, DM, ldsg, C.tid);
    }
}
__device__ __forceinline__ void phase_mix_c(const Ctx& C, int l) {
    unsigned* ctr = (unsigned*)(C.ws + WS_CTL) + CW_QUEUE + 64 * l; volatile LAS unsigned* slot = (volatile LAS unsigned*)(C.lds + LDSCTL_OFF + 64);
    for (;;) {
        __syncthreads();
        if (C.tid == 0) *slot = __hip_atomic_fetch_add(ctr, 1u, __ATOMIC_RELAXED, __HIP_MEMORY_SCOPE_AGENT);
        __syncthreads();
        const int it = (int)*slot;
        constexpr int NS_REST = (CV_ALL - CV_IN) / 64, NS_IN = CV_IN / 64;
        const int NC = NS_REST + (l == 0 ? NS_IN : 0), NT = 2048 + NC;
        if (it >= NT) break;
        const int cb = (it * NC) / NT, ca = ((it + 1) * NC) / NT, fi = it - cb;
        if (ca == cb) { const Ctx C2 = make_ctx(C.lds); hy::hyena_fft_unit(C2, l, fi & 1023, fi < 1024 ? 1 : 0); }
        else if (cb < NS_REST) { const Ctx C2 = make_ctx(C.lds); convert_super_item(C2, l, CV_IN + 64 * cb); }
        else { const Ctx C2 = make_ctx(C.lds); convert_super_item(C2, 1, 64 * (cb - NS_REST)); }
    }
    __syncthreads();
}
constexpr int NPH = 9, NPHASES = 2 * NPH + 1;
constexpr int R3 = 24576, R1 = NTOK - R3;
#define IN(k) ph_in(k)
#define SEAM(k) do { if (IN(k) && IN((k) + 1)) { XcdBarrier b_; b_.bar = (unsigned*)(ldargs()->ws + WS_CTL) + CW_BAR; b_.x = xb_xcc_id(); b_.st = MISC + 8; xcd_barrier(b_); } } while (0)
template <int l> __device__ __forceinline__ void layer_body(LAS unsigned char* lds, volatile LAS unsigned* MISC) {
        const int pb = l * NPH;
        if (IN(pb + 0)) {
            const Ctx C = make_ctx(lds); CArgs& args = *C.a; bf16* hA = (bf16*)(C.ws + WS_HA); float* out = args.out;
            if (l == 0) phase_convert_weights(C, 0, 0, CV_IN);
            if (l == 0) phase_rope_tables(C);
            phase_hyena_filters(C, l);
            if (l == 0) phase_rmsnorm_half<true>(C, args.in[I_XP], args.in[I_N1G], hA);
            (void)out;
        }
        SEAM(pb + 0);
        if (IN(pb + 1)) {
            const Ctx C = make_ctx(lds);
            {
                CArgs& args = *C.a; const float* nsrc = l == 0 ? args.in[I_XS] : args.out + (size_t)R3 * DM;
                pg8::Gemm g{(const bf16*)(C.ws + WS_HA), (const bf16*)(C.ws + WS_WIN), TOK_P, NPROJ, DM};
                SlotNormOrder<true, 2> S; S.init(TOK_P, NPROJ, C.G, C.bid); S.src = nsrc; S.g = args.in[I_N1G] + l * DM; S.dst = (bf16*)(C.ws + WS_HA) + (size_t)(l == 0 ? TOK_P : R3) * DM; S.nrows = l == 0 ? TOK_P : R1; S.gw = C.gw; S.ngw = C.NGW; S.lane = C.lane; S.k = 0;
                pg8::EpiProj E{(bf16*)(C.ws + WS_PROJ), NPROJ, (float*)(C.ws + WS_GATES), C_DG / 256};
                pg8::gemm_phase<pg8::EpiProj, SlotNormOrder<true, 2>, PG8_ALIGN, PG8_SP2>(lds, g, S, E);
                S.flush();
            }
            { XcdBarrier b_; b_.bar = (unsigned*)(ldargs()->ws + WS_CTL) + CW_BAR; b_.x = xb_xcc_id(); b_.st = MISC + 8; xcd_barrier(b_); }
            {   const Ctx C1 = make_ctx(lds); const size_t r0 = (size_t)TOK_P;
                pg8::Gemm g{(const bf16*)(C1.ws + WS_HA) + r0 * DM, (const bf16*)(C1.ws + WS_WIN), TOK_P, NPROJ, DM}; pg8::StaticOrder S; S.init(TOK_P, NPROJ, C1.G, C1.bid);
                pg8::EpiProj E{(bf16*)(C1.ws + WS_PROJ) + r0 * NPROJ, NPROJ, (float*)(C1.ws + WS_GATES) + r0 * 16, C_DG / 256};
                pg8::gemm_phase<pg8::EpiProj, pg8::StaticOrder, PG8_ALIGN, PG8_SP2>(lds, g, S, E);
            }
        }
        SEAM(pb + 1);
        if (IN(pb + 2)) { const Ctx C = make_ctx(lds); phase_prep(C, l); }
        SEAM(pb + 2);
        if (IN(pb + 3)) {
            { const Ctx C = make_ctx(lds); prep_mlstm_states(C, l); } { const Ctx C = make_ctx(lds); phase_mix_b(C, l); } { const Ctx C = make_ctx(lds); phase_mix_a(C, l); } { const Ctx C = make_ctx(lds); phase_mix_c(C, l); }
            { XcdBarrier b_; b_.bar = (unsigned*)(ldargs()->ws + WS_CTL) + CW_BAR; b_.x = xb_xcc_id(); b_.st = MISC + 8; xcd_barrier(b_); }
            { const Ctx C = make_ctx(lds); phase_mix_d(C, l); }
        }
        SEAM(pb + 3);
        if (IN(pb + 5)) {
            {   const Ctx C = make_ctx(lds); CArgs& args = *C.a; float* out = args.out;
                pg8::Gemm g{(const bf16*)(C.ws + WS_HA), (const bf16*)(C.ws + WS_WOUT), R3, DM, DM}; pg8::StaticOrder S; S.init(R3, DM, C.G, C.bid);
                pg8::EpiResid E{l == 0 ? args.in[I_XP] : out, l == 0 ? args.in[I_XS] : out + (size_t)TOK_P * DM, TOK_P, out, DM};
                pg8::gemm_phase<pg8::EpiResid, pg8::StaticOrder, PG8_ALIGN, PG8_SP2>(lds, g, S, E);
            }
            { XcdBarrier b_; b_.bar = (unsigned*)(ldargs()->ws + WS_CTL) + CW_BAR; b_.x = xb_xcc_id(); b_.st = MISC + 8; xcd_barrier(b_); }
            {
                const Ctx C = make_ctx(lds); CArgs& args = *C.a; float* out = args.out; const size_t r0 = (size_t)R3;
                pg8::Gemm g{(const bf16*)(C.ws + WS_HA) + r0 * DM, (const bf16*)(C.ws + WS_WOUT), R1, DM, DM};
                SlotNormOrder<true, 6> S; S.init(R1, DM, C.G, C.bid); S.src = out; S.g = args.in[I_N2G] + l * DM; S.dst = (bf16*)(C.ws + WS_HA); S.nrows = R3; S.gw = C.gw; S.ngw = C.NGW; S.lane = C.lane; S.k = 0;
                const float* base = l == 0 ? args.in[I_XS] + (size_t)(R3 - TOK_P) * DM : out + r0 * DM;
                pg8::EpiResid E{base, base, R1, out + r0 * DM, DM};
                pg8::gemm_phase<pg8::EpiResid, SlotNormOrder<true, 6>, PG8_ALIGN, PG8_SP2>(lds, g, S, E);
                S.flush();
            }
        }
        SEAM(pb + 5);
        if (IN(pb + 6)) { const Ctx C = make_ctx(lds); CArgs& args = *C.a; float* out = args.out;
            phase_rmsnorm_half<true>(C, out + (size_t)R3 * DM, args.in[I_N2G] + l * DM, (bf16*)(C.ws + WS_HA) + (size_t)R3 * DM, R1); }
        SEAM(pb + 6);
        if (IN(pb + 7)) {
            const Ctx C = make_ctx(lds);
            pg8::Gemm g{(const bf16*)(C.ws + WS_HA), (const bf16*)(C.ws + WS_WGU), NTOK, NGU, DM}; pg8::StaticOrder S; S.init(NTOK, NGU, C.G, C.bid);
            pg8::EpiGateUp E{(bf16*)(C.ws + WS_PROJ), FF};
            pg8::gemm_phase<pg8::EpiGateUp, pg8::StaticOrder, PG8_ALIGN, PG8_SP2>(lds, g, S, E);
        }
        SEAM(pb + 7);
        if (IN(pb + 8)) {
            {   const Ctx C = make_ctx(lds); float* out = C.a->out;
                pg8::Gemm g{(const bf16*)(C.ws + WS_PROJ), (const bf16*)(C.ws + WS_WDN), R3, DM, FF}; pg8::StaticOrder S; S.init(R3, DM, C.G, C.bid);
                pg8::EpiResid E{out, out, R3, out, DM};
                pg8::gemm_phase<pg8::EpiResid, pg8::StaticOrder, PG8_ALIGN, PG8_SP2>(lds, g, S, E);
            }
            { XcdBarrier b_; b_.bar = (unsigned*)(ldargs()->ws + WS_CTL) + CW_BAR; b_.x = xb_xcc_id(); b_.st = MISC + 8; xcd_barrier(b_); }
            {
                const Ctx C = make_ctx(lds); CArgs& args = *C.a; float* out = args.out; const size_t r0 = (size_t)R3;
                pg8::Gemm g{(const bf16*)(C.ws + WS_PROJ) + r0 * FF, (const bf16*)(C.ws + WS_WDN), R1, DM, FF};
                pg8::EpiResid E{out + r0 * DM, out + r0 * DM, R1, out + r0 * DM, DM};
                SlotNormOrder<l == 0, 6> S; S.init(R1, DM, C.G, C.bid); S.src = out; S.g = l == 0 ? args.in[I_N1G] + DM : args.in[I_FG]; S.dst = l == 0 ? (void*)(C.ws + WS_HA) : (void*)out; S.nrows = R3; S.gw = C.gw; S.ngw = C.NGW; S.lane = C.lane; S.k = 0;
                pg8::gemm_phase<pg8::EpiResid, SlotNormOrder<l == 0, 6>, PG8_ALIGN, PG8_SP2>(lds, g, S, E); S.flush();
            }
        }
        SEAM(pb + 8);
    }
__global__ void __launch_bounds__(NTHR, 2) fwd_kernel(Args args_by_value) {
    extern __shared__ __attribute__((aligned(16))) unsigned char lds_raw[];
    LAS unsigned char* lds = (LAS unsigned char*)lds_raw;
    for (int u = threadIdx.x; u < (LDS_BYTES - LDSCTL_OFF) / 4; u += NTHR) ((LAS unsigned*)(lds + LDSCTL_OFF))[u] = 0u;
    __syncthreads();
    volatile LAS unsigned* MISC = (volatile LAS unsigned*)(lds + MISC_OFF);
    (void)xcd_barrier_post((unsigned*)(ldargs()->ws + WS_CTL) + CW_BAR, MISC + 8);
    layer_body<0>(lds, MISC);
    layer_body<1>(lds, MISC);
    if (IN(2 * NPH)) { const Ctx C = make_ctx(lds); float* out = C.a->out + (size_t)R3 * DM; phase_rmsnorm_half<false>(C, out, C.a->in[I_FG], out, R1); }
#undef IN
#undef SEAM
}

#ifndef MK_PER_PHASE
#define MK_PER_PHASE 0
#endif
extern "C" void kernel_launch(void* const* d_in, const int* in_sizes, int n_in, void* d_out, int out_size, void* d_ws, size_t ws_size, hipStream_t stream) {
    static int grid = 0;
    if (grid == 0) {
        if (n_in != 24 || out_size != NTOK * DM || ws_size < WS_END) { fprintf(stderr, "kernel_launch: unexpected shapes: n_in %d out %d ws %zu (need %zu)\n", n_in, out_size, ws_size, (size_t)WS_END); grid = -1; return; }
        int dev = 0, cus = 0, per_cu = 0;
        if (hipGetDevice(&dev) != hipSuccess || hipDeviceGetAttribute(&cus, hipDeviceAttributeMultiprocessorCount, dev) != hipSuccess) { grid = -1; return; }
        if (hipFuncSetAttribute((const void*)fwd_kernel, hipFuncAttributeMaxDynamicSharedMemorySize, LDS_BYTES) != hipSuccess) { fprintf(stderr, "kernel_launch: hipFuncSetAttribute failed\n"); grid = -1; return; }
        if (hipOccupancyMaxActiveBlocksPerMultiprocessor(&per_cu, (const void*)fwd_kernel, NTHR, LDS_BYTES) != hipSuccess || per_cu < 1) fprintf(stderr, "kernel_launch: occupancy query reports %d\n", per_cu);
        (void)hipGetLastError();
        grid = cus;
    }
    if (grid < 0) return;
    (void)hipMemsetAsync((char*)d_ws + WS_CTL, 0, CTL_ZERO_BYTES, stream);
    Args a{};
    for (int i = 0; i < 24; ++i) a.in[i] = (const float*)d_in[i];
    a.out = (float*)d_out; a.ws = (unsigned char*)d_ws;
#if MK_PER_PHASE
    for (int k = 0; k < NPHASES; ++k) { a.ph_lo = k; a.ph_hi = k + 1; hipLaunchKernelGGL(fwd_kernel, dim3(grid), dim3(NTHR), LDS_BYTES, stream, a); }
#else
    a.ph_lo = 0; a.ph_hi = NPHASES;
    hipLaunchKernelGGL(fwd_kernel, dim3(grid), dim3(NTHR), LDS_BYTES, stream, a);
#endif
    const hipError_t le = hipPeekAtLastError();
    if (le != hipSuccess) fprintf(stderr, "kernel_launch: launch failed: %s\n", hipGetErrorName(le));
}
```

```cpp
#include <hip/hip_runtime.h>
#include <cstdio>
#include <cstdint>
#include <cmath>
namespace pg8 {
#define PG8_LAS __attribute__((address_space(3)))
typedef unsigned short bf16_t;
typedef short bf16x8 __attribute__((ext_vector_type(8)));
typedef float f32x4 __attribute__((ext_vector_type(4)));
typedef unsigned u32x4 __attribute__((ext_vector_type(4)));
constexpr int BM = 256, BK = 64, HALF = 128, HTB = HALF * BK * 2  , STAGE_BYTES = 8 * HTB, NXCD = 8, WGM = 8;

__host__ __device__ __forceinline__ int lds_byte(int r, int c) { const int st = (r >> 4) * 2 + (c >> 5), rr = r & 15, cc = c & 31, ob = rr * 64 + cc * 2; return st * 1024 + (ob ^ (((ob >> 9) & 1) << 5)); }
__host__ __device__ __forceinline__ void stage_rc(int b, int& R, int& C) { const int st = b / 1024, sb = b % 1024, swz = sb ^ (((sb >> 9) & 1) << 5); R = (st >> 1) * 16 + swz / 64; C = (st & 1) * 32 + (swz % 64) / 2; }
__host__ __device__ __forceinline__ int perm32(int rho) { const int n = rho >> 4, i = rho & 15; return 8 * (i >> 2) + 4 * n + (i & 3); }

struct Unit { int pm, pn; };
struct Gemm { const bf16_t* A; const bf16_t* Bt; int M, N, K; };

struct StaticOrder {
    int nM, nN, nwg, G, c;
    __host__ __device__ void init(int M, int N, int G_, int c_) { nM = M / BM; nN = N / BM; nwg = nM * nN; G = G_; c = c_; }
    __host__ __device__ bool next(int i, Unit& u) const {
        const long L = (long)i * G + c; if (L >= nwg) return false;
        int wgid = (int)L; { const int q = nwg / NXCD, r = nwg % NXCD, xcd = wgid % NXCD, off = wgid / NXCD; wgid = (xcd < r ? xcd * (q + 1) : r * (q + 1) + (xcd - r) * q) + off; }
        const int nig = WGM * nN, gid = wgid / nig, fm = gid * WGM, gsz = (nM - fm) < WGM ? (nM - fm) : WGM;
        u.pm = fm + ((wgid % nig) % gsz); u.pn = (wgid % nig) / gsz; return true;
    }
    __device__ __forceinline__ void a_ready(const Unit&) const {}
    __device__ __forceinline__ void done(const Unit&) const {}
};

__device__ __forceinline__ unsigned cvt_pk_bf16(float lo, float hi) { unsigned r; asm volatile("v_cvt_pk_bf16_f32 %0, %1, %2" : "=v"(r) : "v"(lo), "v"(hi)); return r; }
typedef float f32x2 __attribute__((ext_vector_type(2)));
struct EpiProj {
    static constexpr bool PERM = true, AFTER_DRAIN = false;
    bf16_t* O; int ldc; float* gates; int gate_pn;
    __device__ __forceinline__ void operator()(const f32x4 (&acc)[2][2][4][2], const Unit& u, int wr, int wc, int fr, int fq) const {
        const int row0 = u.pm * BM + wr * 64 + fr, col0 = u.pn * BM + wc * 32 + 8 * fq;
#pragma unroll
        for (int ai = 0; ai < 2; ++ai)
#pragma unroll
            for (int m = 0; m < 4; ++m) { bf16_t* rowp = O + (size_t)(row0 + ai * HALF + m * 16) * ldc + col0;
#pragma unroll
                for (int bj = 0; bj < 2; ++bj) { const f32x4 v0 = acc[ai][bj][m][0], v1 = acc[ai][bj][m][1];
                    u32x4 w; w.x = cvt_pk_bf16(v0[0], v0[1]); w.y = cvt_pk_bf16(v0[2], v0[3]); w.z = cvt_pk_bf16(v1[0], v1[1]); w.w = cvt_pk_bf16(v1[2], v1[3]);
                    *(u32x4*)(rowp + bj * HALF) = w; } }
        if (u.pn == gate_pn && wc == 0 && fq < 2) {
#pragma unroll
            for (int ai = 0; ai < 2; ++ai)
#pragma unroll
                for (int m = 0; m < 4; ++m) { float* gp = gates + (size_t)(row0 + ai * HALF + m * 16) * 16 + 8 * fq;
                    *(f32x4*)(gp) = acc[ai][0][m][0]; *(f32x4*)(gp + 4) = acc[ai][0][m][1]; }
        }
    }
};
struct EpiResid {
    static constexpr bool PERM = false, AFTER_DRAIN = false;
    const float* base_lo; const float* base_hi; int split; float* out; int ldc;
    __device__ __forceinline__ void operator()(const f32x4 (&acc)[2][2][4][2], const Unit& u, int wr, int wc, int fr, int fq) const {
        const int row0 = u.pm * BM + wr * 64 + fr, col0 = u.pn * BM + wc * 32 + 4 * fq;
#pragma unroll
        for (int ai = 0; ai < 2; ++ai)
#pragma unroll
            for (int m = 0; m < 4; ++m) { const int row = row0 + ai * HALF + m * 16;
                const float* bp = (row < split ? base_lo + (size_t)row * ldc : base_hi + (size_t)(row - split) * ldc) + col0; float* op = out + (size_t)row * ldc + col0;
#pragma unroll
                for (int bj = 0; bj < 2; ++bj)
#pragma unroll
                    for (int n = 0; n < 2; ++n) *(f32x4*)(op + bj * HALF + n * 16) = *(const f32x4*)(bp + bj * HALF + n * 16) + acc[ai][bj][m][n]; }
    }
};
__device__ __forceinline__ float silu_mul(float g, float u) { const float e = __builtin_amdgcn_exp2f(-1.4426950408889634f * g); return g * __builtin_amdgcn_rcpf(1.0f + e) * u; }
struct EpiGateUp {
    static constexpr bool PERM = true, AFTER_DRAIN = false;
    bf16_t* H; int ldc;
    __device__ __forceinline__ void operator()(const f32x4 (&acc)[2][2][4][2], const Unit& u, int wr, int wc, int fr, int fq) const {
        const int row0 = u.pm * BM + wr * 64 + fr, col0 = u.pn * HALF + wc * 32 + 8 * fq;
#pragma unroll
        for (int ai = 0; ai < 2; ++ai)
#pragma unroll
            for (int m = 0; m < 4; ++m) { bf16_t* rowp = H + (size_t)(row0 + ai * HALF + m * 16) * ldc + col0;
                const f32x4 g0 = acc[ai][0][m][0], g1 = acc[ai][0][m][1], u0 = acc[ai][1][m][0], u1 = acc[ai][1][m][1];
                u32x4 w; w.x = cvt_pk_bf16(silu_mul(g0[0], u0[0]), silu_mul(g0[1], u0[1])); w.y = cvt_pk_bf16(silu_mul(g0[2], u0[2]), silu_mul(g0[3], u0[3]));
                w.z = cvt_pk_bf16(silu_mul(g1[0], u1[0]), silu_mul(g1[1], u1[1])); w.w = cvt_pk_bf16(silu_mul(g1[2], u1[2]), silu_mul(g1[3], u1[3]));
                *(u32x4*)(rowp) = w; }
    }
};
template <class Epi, class Sched, bool ALIGN_EPI = false, bool SP2 = false>
__device__ __forceinline__ void gemm_phase(PG8_LAS unsigned char* lds, const Gemm g, const Sched& S, const Epi& E) {
    int tid_ = threadIdx.x; asm volatile("" : "+v"(tid_)); const int tid = tid_, wid = __builtin_amdgcn_readfirstlane(tid >> 6), lane = tid & 63, wr = wid >> 2, wc = wid & 3, fr = lane & 15, fq = lane >> 4;
    const int K = g.K, nt = K / BK;
    unsigned voffA[2], voffB[2];
#pragma unroll
    for (int i = 0; i < 2; ++i) { int R, C; stage_rc(tid * 16 + i * 8192, R, C); const int Rb = Epi::PERM ? ((R & ~31) + perm32(R & 31)) : R;
        voffA[i] = (unsigned)(R * K + C) * 2u; voffB[i] = (unsigned)(Rb * K + C) * 2u; }
    const size_t kstep = (size_t)(BK * 2);
    const size_t hstep = (size_t)HALF * K * 2;
    const size_t tstep = 2 * hstep;
    const unsigned ldsw = (unsigned)wid * 1024u;
    const int aoff = lds_byte(wr * 64 + fr, fq * 8), boff = lds_byte(wc * 32 + fr, fq * 8);
#define PG8_SA(b, h) (((b) * 2 + (h)) * HTB)
#define PG8_SB(b, h) ((4 + (b) * 2 + (h)) * HTB)
#define PG8_STAGE(bufoff, gbase, voff) do { _Pragma("unroll") for (int _i = 0; _i < 2; ++_i) \
        __builtin_amdgcn_global_load_lds((const unsigned*)((const char*)(gbase) + (voff)[_i]), (PG8_LAS unsigned*)(lds + (bufoff) + ldsw + _i * 8192), 16, 0, 0); } while (0)
#define PG8_LDA(dst, b, h) do { _Pragma("unroll") for (int m = 0; m < 4; ++m) _Pragma("unroll") for (int k = 0; k < 2; ++k) dst[m][k] = *(const PG8_LAS bf16x8*)(lds + PG8_SA(b, h) + aoff + m * 2048 + k * 1024); } while (0)
#define PG8_LDB(dst, b, h) do { _Pragma("unroll") for (int n = 0; n < 2; ++n) _Pragma("unroll") for (int k = 0; k < 2; ++k) dst[n][k] = *(const PG8_LAS bf16x8*)(lds + PG8_SB(b, h) + boff + n * 2048 + k * 1024); } while (0)
#define PG8_MMA(ai, bj, At, Bt) do { __builtin_amdgcn_s_setprio(1); _Pragma("unroll") for (int m = 0; m < 4; ++m) _Pragma("unroll") for (int n = 0; n < 2; ++n) _Pragma("unroll") for (int k = 0; k < 2; ++k) \
        acc[ai][bj][m][n] = __builtin_amdgcn_mfma_f32_16x16x32_bf16(Bt[n][k], At[m][k], acc[ai][bj][m][n], 0, 0, 0); __builtin_amdgcn_s_setprio(0); } while (0)
#define PG8_WAIT_V(n) asm volatile("s_waitcnt vmcnt(" #n ")" ::: "memory")
#define PG8_WAIT_L(n) asm volatile("s_waitcnt lgkmcnt(" #n ")" ::: "memory")
#define PG8_BAR __builtin_amdgcn_s_barrier()
#define PG8_SCHED __builtin_amdgcn_sched_barrier(0)
    Unit cur, nxt; int ui = 0;
    if (!S.next(0, cur)) return;
    f32x4 acc[2][2][4][2];
#pragma unroll
    for (int a = 0; a < 2; ++a)
#pragma unroll
        for (int b = 0; b < 2; ++b)
#pragma unroll
            for (int m = 0; m < 4; ++m)
#pragma unroll
                for (int n = 0; n < 2; ++n) acc[a][b][m][n] = (f32x4){0.f, 0.f, 0.f, 0.f};
    bf16x8 At[4][2], B0[2][2], B1[2][2];
    const char* cA = (const char*)g.A + (size_t)cur.pm * tstep; const char* cB = (const char*)g.Bt + (size_t)cur.pn * tstep;
    S.a_ready(cur);
    if constexpr (SP2) {
        PG8_STAGE(PG8_SB(0, 0), cB, voffB); PG8_STAGE(PG8_SB(0, 1), cB + hstep, voffB); PG8_STAGE(PG8_SA(0, 0), cA, voffA); PG8_STAGE(PG8_SA(0, 1), cA + hstep, voffA);
        if (wr == 1) PG8_BAR;
        PG8_WAIT_V(2); PG8_BAR;
        PG8_STAGE(PG8_SB(1, 0), cB + kstep, voffB); PG8_STAGE(PG8_SA(1, 0), cA + kstep, voffA); PG8_STAGE(PG8_SB(1, 1), cB + hstep + kstep, voffB);
        PG8_WAIT_V(6); PG8_BAR;
    } else {
        PG8_STAGE(PG8_SB(0, 0), cB, voffB); PG8_STAGE(PG8_SA(0, 0), cA, voffA); PG8_STAGE(PG8_SB(0, 1), cB + hstep, voffB); PG8_STAGE(PG8_SA(0, 1), cA + hstep, voffA);
        if (wr == 1) PG8_BAR;
        PG8_WAIT_V(4); PG8_BAR;
        PG8_STAGE(PG8_SB(1, 0), cB + kstep, voffB); PG8_STAGE(PG8_SA(1, 0), cA + kstep, voffA); PG8_STAGE(PG8_SB(1, 1), cB + hstep + kstep, voffB);
        PG8_WAIT_V(6); PG8_BAR;
    }
    for (;;) {
        const bool has_next = S.next(ui + 1, nxt);
        const char* nA = has_next ? (const char*)g.A + (size_t)nxt.pm * tstep : cA; const char* nB = has_next ? (const char*)g.Bt + (size_t)nxt.pn * tstep : cB;
        for (int t = 0; t < nt; t += 2) {
            const bool last = (t == nt - 2);
            const char* a1 = cA + (size_t)(t + 1) * kstep;
            const char* a2 = last ? nA : cA + (size_t)(t + 2) * kstep; const char* b2 = last ? nB : cB + (size_t)(t + 2) * kstep;
            const char* a3 = a2 + kstep; const char* b3 = b2 + kstep;
            if (last && has_next) S.a_ready(nxt);
            if constexpr (SP2) {
            PG8_LDB(B0, 0, 0); PG8_LDB(B1, 0, 1); PG8_SCHED; PG8_LDA(At, 0, 0); PG8_STAGE(PG8_SA(1, 1), a1 + hstep, voffA);
            PG8_WAIT_V(8); PG8_WAIT_L(0); PG8_BAR; PG8_MMA(0, 0, At, B0); PG8_MMA(0, 1, At, B1); PG8_BAR; PG8_SCHED;
            PG8_LDA(At, 0, 1); PG8_STAGE(PG8_SB(0, 0), b2, voffB); PG8_STAGE(PG8_SB(0, 1), b2 + hstep, voffB); PG8_STAGE(PG8_SA(0, 0), a2, voffA);
            PG8_WAIT_V(8); PG8_WAIT_L(0); PG8_BAR; PG8_MMA(1, 0, At, B0); PG8_MMA(1, 1, At, B1); PG8_BAR; PG8_SCHED;
            PG8_LDB(B0, 1, 0); PG8_LDB(B1, 1, 1); PG8_SCHED; PG8_LDA(At, 1, 0); PG8_STAGE(PG8_SA(0, 1), a2 + hstep, voffA);
            PG8_WAIT_V(8); PG8_WAIT_L(0); PG8_BAR; PG8_MMA(0, 0, At, B0); PG8_MMA(0, 1, At, B1); PG8_BAR; PG8_SCHED;
            PG8_LDA(At, 1, 1); PG8_STAGE(PG8_SB(1, 0), b3, voffB); PG8_STAGE(PG8_SB(1, 1), b3 + hstep, voffB); PG8_STAGE(PG8_SA(1, 0), a3, voffA);
            PG8_WAIT_V(8); PG8_WAIT_L(0); PG8_BAR; PG8_MMA(1, 0, At, B0); PG8_MMA(1, 1, At, B1); PG8_BAR; PG8_SCHED;
            } else {
            PG8_LDB(B0, 0, 0); PG8_SCHED; PG8_LDA(At, 0, 0); PG8_STAGE(PG8_SA(1, 1), a1 + hstep, voffA);
            PG8_WAIT_L(8); PG8_BAR; PG8_WAIT_L(0); PG8_MMA(0, 0, At, B0); PG8_BAR; PG8_SCHED;
            PG8_LDB(B1, 0, 1); PG8_STAGE(PG8_SB(0, 0), b2, voffB);
            PG8_BAR; PG8_WAIT_L(0); PG8_MMA(0, 1, At, B1); PG8_BAR;
            PG8_LDA(At, 0, 1); PG8_STAGE(PG8_SA(0, 0), a2, voffA);
            PG8_BAR; PG8_WAIT_L(0); PG8_MMA(1, 0, At, B0); PG8_BAR; PG8_SCHED;
            PG8_STAGE(PG8_SB(0, 1), b2 + hstep, voffB);
            PG8_WAIT_V(6); PG8_BAR; PG8_MMA(1, 1, At, B1); PG8_BAR;
            PG8_LDB(B0, 1, 0); PG8_SCHED; PG8_LDA(At, 1, 0); PG8_STAGE(PG8_SA(0, 1), a2 + hstep, voffA);
            PG8_WAIT_L(8); PG8_BAR; PG8_WAIT_L(0); PG8_MMA(0, 0, At, B0); PG8_BAR; PG8_SCHED;
            PG8_LDB(B1, 1, 1); PG8_STAGE(PG8_SB(1, 0), b3, voffB);
            PG8_BAR; PG8_WAIT_L(0); PG8_MMA(0, 1, At, B1); PG8_BAR;
            PG8_LDA(At, 1, 1); PG8_STAGE(PG8_SA(1, 0), a3, voffA);
            PG8_BAR; PG8_WAIT_L(0); PG8_MMA(1, 0, At, B0); PG8_BAR; PG8_SCHED;
            PG8_STAGE(PG8_SB(1, 1), b3 + hstep, voffB);
            PG8_WAIT_V(6); PG8_BAR; PG8_MMA(1, 1, At, B1); PG8_BAR;
            }
        }
        if constexpr (ALIGN_EPI) { if (wr == 0) PG8_BAR; }
        if constexpr (!Epi::AFTER_DRAIN) { E(acc, cur, wr, wc, fr, fq); S.done(cur); }
        if (!has_next) break;
#pragma unroll
        for (int a = 0; a < 2; ++a)
#pragma unroll
            for (int b = 0; b < 2; ++b)
#pragma unroll
                for (int m = 0; m < 4; ++m)
#pragma unroll
                    for (int n = 0; n < 2; ++n) acc[a][b][m][n] = (f32x4){0.f, 0.f, 0.f, 0.f};
        cur = nxt; cA = nA; cB = nB; ++ui;
        if constexpr (ALIGN_EPI) { if (wr == 1) PG8_BAR; }
    }
    PG8_WAIT_V(0);
    if constexpr (!ALIGN_EPI) { if (wr == 0) PG8_BAR; }
    PG8_BAR;
    if constexpr (Epi::AFTER_DRAIN) { E.fused(acc, cur, wr, wc, fr, fq, lds, wid, lane); S.done(cur); }
#undef PG8_SA
#undef PG8_SB
#undef PG8_STAGE
#undef PG8_LDA
#undef PG8_LDB
#undef PG8_MMA
#undef PG8_WAIT_V
#undef PG8_WAIT_L
#undef PG8_BAR
#undef PG8_SCHED
}
}
#ifndef PG8_SP2
#define PG8_SP2 true
#endif
#ifndef PG8_ALIGN
#define PG8_ALIGN true
#endif
constexpr int DM = 4096, NTOK = 32768, TOK_P = 16384, L_P = 2048, L_S = 4096, B_P = 8, B_S = 4;
constexpr int NPROJ = 12032, N_IN = 11792, FF = 11008, NGU = 2 * FF;
constexpr int C_AQ = 0, C_AK = 1024, C_AV = 2048, C_BQ = 3072, C_BK = 4096, C_BV = 4352, C_CU = 4608, C_DQ = 7680, C_DK = 8704, C_DV = 9728, C_DO = 10752, C_DG = 11776;
constexpr float EPS = 1e-6f;
constexpr int NWAVES = 8, NTHR = 512;
constexpr size_t al256(size_t x) { return (x + 255) / 256 * 256; }
constexpr size_t WS_CTL = 0, CTL_ZERO_BYTES = 1u << 20;
constexpr size_t WS_WIN = CTL_ZERO_BYTES;
constexpr size_t WS_WOUT = WS_WIN + (size_t)NPROJ * DM * 2;
constexpr size_t WS_WGU = WS_WOUT + (size_t)DM * DM * 2;
constexpr size_t WS_WDN = WS_WGU + (size_t)NGU * DM * 2;
constexpr size_t WS_HA = WS_WDN + (size_t)DM * FF * 2;
constexpr size_t WS_PROJ = WS_HA + (size_t)NTOK * DM * 2;
constexpr size_t WS_GATES = WS_PROJ + (size_t)NTOK * NPROJ * 2;
constexpr size_t WS_GCUM = WS_GATES + (size_t)NTOK * 16 * 4;
constexpr size_t WS_ROPE = WS_GCUM + (size_t)NTOK * 16 * 4;
constexpr size_t WS_HFIL = WS_ROPE + al256((size_t)(2 * 4096 * 16 + 2 * 64 * 32) * 4);
constexpr size_t WS_UCT = WS_HFIL + (size_t)2048 * (2048 + 4096) * 4;
constexpr size_t WS_DH = WS_UCT + (size_t)3072 * NTOK * 2;
constexpr size_t WS_CST = WS_DH + (size_t)2 * NTOK * 1024 * 2;
constexpr size_t WS_NST = WS_CST + (size_t)1024 * 65536 * 2;
constexpr size_t WS_HSP = WS_NST + (size_t)1024 * 256 * 4;
constexpr size_t WS_END = WS_HSP + (size_t)512 * 131072;
constexpr int CW_BAR = 4096;
constexpr int CW_QUEUE = 16384;

constexpr int RING_BYTES = 131072, LDS_BYTES = 147456, LDSCTL_OFF = LDS_BYTES - 1024, MISC_OFF = LDSCTL_OFF + 320;

#define LAS __attribute__((address_space(3)))
typedef unsigned short bf16;
typedef unsigned v4u __attribute__((ext_vector_type(4)));
typedef unsigned v2u __attribute__((ext_vector_type(2)));
typedef float f32x4 __attribute__((ext_vector_type(4)));
#define LDS_WAIT() asm volatile("s_waitcnt lgkmcnt(0)" ::: "memory")
__device__ __forceinline__ unsigned f2bf(float f) { unsigned u = __builtin_bit_cast(unsigned, f); return (u + 0x7fffu + ((u >> 16) & 1u)) >> 16; }
__device__ __forceinline__ unsigned pk2(float lo, float hi) { return f2bf(lo) | (f2bf(hi) << 16); }
__device__ __forceinline__ float bf2f(unsigned short b) { return __builtin_bit_cast(float, (unsigned)b << 16); }
__device__ __forceinline__ float bflo(unsigned w) { return __builtin_bit_cast(float, w << 16); }
__device__ __forceinline__ float bfhi(unsigned w) { return __builtin_bit_cast(float, w & 0xffff0000u); }
__device__ __forceinline__ float wave_sum(float v) {
#pragma unroll
    for (int o = 1; o < 64; o <<= 1) v += __shfl_xor(v, o);
    return v;
}
__device__ __forceinline__ void sincos_rev(double rev, float& s, float& c) { const float f = (float)(rev - rint(rev)); s = __builtin_amdgcn_sinf(f); c = __builtin_amdgcn_cosf(f); }
__device__ const double INV_ROPE[16] = {1.0, 0.44036660267178046, 0.19392274474868576, 0.08539710028576561, 0.03760603093086393, 0.016560440080994446, 0.007292664737217109, 0.003211445994752591, 0.001414213562373095, 0.000622772421914596, 0.0002742481756762073, 0.00012076973741146504, 5.318295896944988e-05, 2.341999896140934e-05, 1.031338537721246e-05, 4.5416704806078695e-06};
__device__ const double INV_AX[32] = {1.0, 0.7498942093324559, 0.5623413251903491, 0.4216965034285822, 0.31622776601683794, 0.23713737056616552, 0.1778279410038923, 0.1333521432163324, 0.1, 0.07498942093324558, 0.05623413251903491, 0.042169650342858224, 0.03162277660168379, 0.023713737056616554, 0.01778279410038923, 0.01333521432163324, 0.01, 0.007498942093324558, 0.005623413251903491, 0.004216965034285823, 0.0031622776601683794, 0.0023713737056616554, 0.0017782794100389228, 0.001333521432163324, 0.001, 0.0007498942093324559, 0.0005623413251903491, 0.00042169650342858224, 0.00031622776601683794, 0.00023713737056616554, 0.00017782794100389227, 0.0001333521432163324};
#define XB_TMO      128
#define XB_XCNT(j)  (256  + 64 * (j))
#define XB_XSUB(j)  (1280 + 64 * (j))
#define XB_XGEN(j)  (2304 + 64 * (j))
#define XB_TOP      3328
#define XB_TOPGEN   3392
#define XCD_BAR_WORDS 3456
#define XB_SPIN_CAP (1u << 22)

__device__ __forceinline__ unsigned xb_ld(unsigned* p)              { return __hip_atomic_load(p, __ATOMIC_RELAXED, __HIP_MEMORY_SCOPE_AGENT); }
__device__ __forceinline__ unsigned xb_add(unsigned* p, unsigned v) { return __hip_atomic_fetch_add(p, v, __ATOMIC_RELAXED, __HIP_MEMORY_SCOPE_AGENT); }
__device__ __forceinline__ unsigned xb_xcc_id() { return (unsigned)__builtin_amdgcn_s_getreg((3 << 11) | 20) & 0xFu; }
#define XB_SPIN(cond, bar) do { unsigned _sp = 0; while (cond) { __builtin_amdgcn_s_sleep(1); \
    if ((++_sp & 255u) == 0u) { if (xb_ld(&(bar)[XB_TMO])) break; if (_sp > XB_SPIN_CAP) { atomicAdd(&(bar)[XB_TMO], 1u); break; } } } } while (0)

struct XcdBarrier {
    unsigned* bar; unsigned x;
    volatile LAS unsigned* st;
};

__device__ __forceinline__ XcdBarrier xcd_barrier_post(unsigned* bar, volatile LAS unsigned* st) {
    XcdBarrier b; b.bar = bar; b.x = xb_xcc_id(); b.st = st;
    if (threadIdx.x == 0) (void)xb_add(&bar[XB_XCNT(b.x)], 1u);
    return b;
}
__device__ __forceinline__ void xcd_barrier_complete(unsigned* bar, unsigned x, unsigned& nloc, unsigned& nx) {
    const unsigned G = gridDim.x * gridDim.y * gridDim.z;
    asm volatile("" : "+s"(x));
    unsigned sum, cnt, mine, sp = 0u;
    for (;;) {
        sum = 0u; cnt = 0u; mine = 0u;
#pragma unroll
        for (unsigned j = 0; j < 16; ++j) { const unsigned c = xb_ld(&bar[XB_XCNT(j)]); sum += c; cnt += (c > 0u) ? 1u : 0u; mine = (j == x) ? c : mine; }
        if (sum == G) break;
        __builtin_amdgcn_s_sleep(1);
        if ((++sp & 255u) == 0u) { if (xb_ld(&bar[XB_TMO])) break; if (sp > XB_SPIN_CAP) { atomicAdd(&bar[XB_TMO], 1u); break; } }
    }
    nloc = mine > 0u ? mine : 1u; nx = cnt > 0u ? cnt : 1u;
}

__device__ __forceinline__ void xcd_barrier(const XcdBarrier& b) {
    asm volatile("s_waitcnt vmcnt(0)" ::: "memory");
    __syncthreads();
    if (threadIdx.x == 0) {
        unsigned* bar = b.bar; asm volatile("" : "+s"(bar));
        __builtin_amdgcn_s_waitcnt(0);
        unsigned nloc = b.st[0], nx = b.st[1];
        if (nloc == 0u) { xcd_barrier_complete(bar, b.x, nloc, nx); b.st[0] = nloc; b.st[1] = nx; }
        const unsigned old = xb_add(&bar[XB_XSUB(b.x)], 1u);
        const unsigned gen = old / nloc;
        if (old + 1u == (gen + 1u) * nloc) {
            __builtin_amdgcn_fence(__ATOMIC_RELEASE, "agent");
            asm volatile("s_waitcnt vmcnt(0)" ::: "memory");
            const unsigned og = xb_add(&bar[XB_TOP], 1u);
            const unsigned tg = og / nx;
            if (og + 1u == (tg + 1u) * nx) xb_add(&bar[XB_TOPGEN], 1u);
            else XB_SPIN(xb_ld(&bar[XB_TOPGEN]) == tg, bar);
            __builtin_amdgcn_fence(__ATOMIC_ACQUIRE, "agent");
            xb_add(&bar[XB_XGEN(b.x)], 1u);
            asm volatile("s_waitcnt vmcnt(0)" ::: "memory");
        } else {
            XB_SPIN(xb_ld(&bar[XB_XGEN(b.x)]) == gen, bar);
            __builtin_amdgcn_fence(__ATOMIC_ACQUIRE, "agent");
            asm volatile("s_waitcnt vmcnt(0)" ::: "memory");
        }
    }
    __syncthreads();
}
struct Args { const float* in[24]; float* out; unsigned char* ws; int ph_lo, ph_hi; };
enum { I_XP = 0, I_XS, I_N1G, I_WIN, I_QKG, I_HCW, I_HCB, I_HW1, I_HB1, I_HF1, I_HW2, I_HB2, I_HF2, I_HW3, I_HDEC, I_HSKIP, I_MLGB, I_MLNG, I_WOUT, I_N2G, I_WG, I_WU, I_WD, I_FG };

struct Ctx {
    LAS unsigned char* lds; int tid, lane, wave, gw, NGW, bid, G;
    unsigned char* ws; const __attribute__((address_space(4))) Args* a;
};
__device__ __forceinline__ int opaque_tid() { int t = threadIdx.x; asm volatile("" : "+v"(t)); return t; }
typedef const __attribute__((address_space(4))) Args CArgs;
__device__ __forceinline__ CArgs* ldargs() { CArgs* ap = (CArgs*)__builtin_amdgcn_kernarg_segment_ptr(); asm volatile("" : "+s"(ap)); return ap; }
__device__ __forceinline__ bool ph_in(int k) { CArgs* ap = ldargs(); return ap->ph_lo <= k && k < ap->ph_hi; }
__device__ __forceinline__ Ctx make_ctx(LAS unsigned char* lds) {
    CArgs* ap = ldargs();
    Ctx C; C.lds = lds; C.tid = opaque_tid(); C.lane = C.tid & 63; C.wave = __builtin_amdgcn_readfirstlane(C.tid >> 6);
    int bid = blockIdx.x, G = gridDim.x; asm volatile("" : "+s"(bid), "+s"(G)); C.bid = bid; C.G = G; C.gw = C.bid * NWAVES + C.wave; C.NGW = C.G * NWAVES; C.ws = ap->ws; C.a = ap;
    return C;
}
__device__ __forceinline__ int seq_pos(int row) { return row < TOK_P ? (row & (L_P - 1)) : ((row - TOK_P) & (L_S - 1)); }

__device__ __forceinline__ void tr_item(const float* W, int K, int N, bf16* WT, int dst_row0, int k0, int n0, LAS float* scr, int lane) {
    const int n = n0 + lane; const bool ok = n < N; const float* wp = W + (size_t)k0 * N + n;
    float v[64];
#pragma unroll
    for (int i = 0; i < 64; ++i) v[i] = ok ? __builtin_nontemporal_load(wp + (size_t)i * N) : 0.f;
#pragma unroll
    for (int i = 0; i < 64; ++i) scr[i * 65 + lane] = v[i];
    LDS_WAIT(); asm volatile("" ::: "memory");
    const int c = lane & 7;
#pragma unroll
    for (int j = 0; j < 8; ++j) { const int nn = (lane >> 3) + 8 * j; const LAS float* s = scr + (8 * c) * 65 + nn;
        v4u o; o.x = pk2(s[0 * 65], s[1 * 65]); o.y = pk2(s[2 * 65], s[3 * 65]); o.z = pk2(s[4 * 65], s[5 * 65]); o.w = pk2(s[6 * 65], s[7 * 65]);
        *(v4u*)(WT + (size_t)(dst_row0 + nn) * K + k0 + 8 * c) = o; }
    LDS_WAIT(); asm volatile("" ::: "memory");
}
constexpr int CV_KB = DM / 64, CV_IN = CV_KB * (NPROJ / 64), CV_OUT = CV_KB * (DM / 64), CV_G = CV_KB * (FF / 64), CV_D = (FF / 64) * (DM / 64), CV_ALL = CV_IN + CV_OUT + 2 * CV_G + CV_D;
__device__ __forceinline__ void convert_item(const Ctx& C, int l, int it, LAS float* scr) {
    const float* Win = C.a->in[I_WIN] + (size_t)l * DM * N_IN; const float* Wout = C.a->in[I_WOUT] + (size_t)l * DM * DM;
    const float* Wg = C.a->in[I_WG] + (size_t)l * DM * FF; const float* Wu = C.a->in[I_WU] + (size_t)l * DM * FF; const float* Wd = C.a->in[I_WD] + (size_t)l * FF * DM;
    bf16* WinT = (bf16*)(C.ws + WS_WIN); bf16* WoutT = (bf16*)(C.ws + WS_WOUT); bf16* WguT = (bf16*)(C.ws + WS_WGU); bf16* WdT = (bf16*)(C.ws + WS_WDN);
    int r = it;
    if (r < CV_IN) { const int nb = NPROJ / 64, kb = r / nb, n0 = 64 * (r % nb); tr_item(Win, DM, N_IN, WinT, n0, 64 * kb, n0, scr, C.lane); return; } r -= CV_IN;
    if (r < CV_OUT) { const int nb = DM / 64, kb = r / nb, n0 = 64 * (r % nb); tr_item(Wout, DM, DM, WoutT, n0, 64 * kb, n0, scr, C.lane); return; } r -= CV_OUT;
    if (r < CV_G) { const int nb = FF / 64, kb = r / nb, n0 = 64 * (r % nb); tr_item(Wg, DM, FF, WguT, 256 * (n0 >> 7) + (n0 & 127), 64 * kb, n0, scr, C.lane); return; } r -= CV_G;
    if (r < CV_G) { const int nb = FF / 64, kb = r / nb, n0 = 64 * (r % nb); tr_item(Wu, DM, FF, WguT, 256 * (n0 >> 7) + 128 + (n0 & 127), 64 * kb, n0, scr, C.lane); return; } r -= CV_G;
    { const int nb = DM / 64, kb = r / nb, n0 = 64 * (r % nb); tr_item(Wd, FF, DM, WdT, n0, 64 * kb, n0, scr, C.lane); }
}
__device__ __forceinline__ void phase_convert_weights(const Ctx& C, int l, int lo, int hi) {
    LAS float* scr = (LAS float*)(C.lds + C.wave * 16640);
    for (int it = lo + C.gw; it < hi; it += C.NGW) convert_item(C, l, it, scr);
}
__device__ __forceinline__ void convert_super_item(const Ctx& C, int l, int base) {
    LAS float* scr = (LAS float*)(C.lds + C.wave * 16640);
    for (int j = 0; j < 8; ++j) convert_item(C, l, base + 8 * j + C.wave, scr);
}
__device__ __forceinline__ void phase_rope_tables(const Ctx& C) {
    float* cosA = (float*)(C.ws + WS_ROPE); float* sinA = cosA + 4096 * 16; float* cosX = sinA + 4096 * 16; float* sinX = cosX + 64 * 32;
    const double inv2pi = 0.15915494309189533577;
    for (int i = C.bid * NTHR + C.tid; i < 4096 * 16 + 64 * 32; i += C.G * NTHR) {
        float s, c;
        if (i < 4096 * 16) { const int t = i >> 4, k = i & 15; sincos_rev((double)t * INV_ROPE[k] * inv2pi, s, c); cosA[i] = c; sinA[i] = s; }
        else { const int j = i - 4096 * 16, p = j >> 5, k = j & 31; sincos_rev((double)p * INV_AX[k] * inv2pi, s, c); cosX[j] = c; sinX[j] = s; }
    }
}
__device__ __forceinline__ void phase_hyena_filters(const Ctx& C, int l) {
    constexpr int PB = 24;
    LAS float* z = (LAS float*)C.lds;
    LAS float* h1 = z + PB * 36;
    LAS float* h2 = h1 + PB * 64;
    const float* w1 = C.a->in[I_HW1] + l * 33 * 64; const float* b1 = C.a->in[I_HB1] + l * 64; const float* fr1 = C.a->in[I_HF1] + l * 64;
    const float* w2 = C.a->in[I_HW2] + l * 64 * 64; const float* b2 = C.a->in[I_HB2] + l * 64; const float* fr2 = C.a->in[I_HF2] + l * 64;
    const float* w3 = C.a->in[I_HW3] + (size_t)l * 64 * 2048; const float* dec = C.a->in[I_HDEC] + l * 2048;
    float* hf = (float*)(C.ws + WS_HFIL);
    for (int it = C.bid; it < (L_P + L_S) / PB; it += C.G) {
        const int gp0 = it * PB;
        __syncthreads();
        for (int u = C.tid; u < PB * 33; u += NTHR) { const int p = u / 33, i = u % 33, gp = gp0 + p; const bool isS = gp >= L_P; const int n = isS ? gp - L_P : gp, L = isS ? L_S : L_P; float v;
            if (i == 0) v = (float)n / (float)(L - 1);
            else { const int j = (i - 1) & 15; const float f = 1e-4f + (float)j * ((15.0f - 1e-4f) / 15.0f); const float rev = (float)n * f / (float)L, fr = rev - rintf(rev); const float s = __builtin_amdgcn_sinf(fr), c = __builtin_amdgcn_cosf(fr); v = (i <= 16) ? c : -s; }
            z[p * 36 + i] = v; }
        __syncthreads();
        for (int u = C.tid; u < PB * 64; u += NTHR) { const int p = u >> 6, j = u & 63; float acc = b1[j];
            for (int i = 0; i < 33; ++i) acc += z[p * 36 + i] * w1[i * 64 + j];
            h1[p * 64 + j] = sinf(fr1[j] * acc); }
        __syncthreads();
        for (int u = C.tid; u < PB * 64; u += NTHR) { const int p = u >> 6, j = u & 63; float acc = b2[j];
            for (int i = 0; i < 64; ++i) acc += h1[p * 64 + i] * w2[i * 64 + j];
            h2[j * PB + p] = sinf(fr2[j] * acc); }
        __syncthreads();
        {
            float acc[4][PB];
#pragma unroll
            for (int q = 0; q < 4; ++q)
#pragma unroll
                for (int p = 0; p < PB; ++p) acc[q][p] = 0.f;
            for (int j = 0; j < 64; ++j) {
                float hv[PB];
#pragma unroll
                for (int k = 0; k < PB / 4; ++k) { const f32x4 t = *(const LAS f32x4*)(h2 + j * PB + 4 * k); hv[4 * k] = t.x; hv[4 * k + 1] = t.y; hv[4 * k + 2] = t.z; hv[4 * k + 3] = t.w; }
#pragma unroll
                for (int q = 0; q < 4; ++q) { const float w = w3[j * 2048 + C.tid + NTHR * q];
#pragma unroll
                    for (int p = 0; p < PB; ++p) acc[q][p] += hv[p] * w; }
            }
#pragma unroll
            for (int q = 0; q < 4; ++q) { const int col = C.tid + NTHR * q; const float d = dec[col];
#pragma unroll
                for (int p = 0; p < PB; ++p) { const int gp = gp0 + p; const bool isS = gp >= L_P; const int n = isS ? gp - L_P : gp, L = isS ? L_S : L_P;
                    const float r = fabsf((float)(n - L / 2)) / (float)(L / 2);
                    (isS ? hf + (size_t)2048 * L_P + (size_t)col * L_S : hf + (size_t)col * L_P)[n] = acc[q][p] * __expf(-r * d); } }
        }
    }
    __syncthreads();
}
template <bool TO_BF16>
__device__ __forceinline__ void phase_rmsnorm(const Ctx& C, const float* src_lo, const float* src_hi, const float* g, void* dst) {
    for (int row = C.gw; row < NTOK; row += C.NGW) {
        const float* xr = row < TOK_P ? src_lo + (size_t)row * DM : src_hi + (size_t)(row - TOK_P) * DM;
        f32x4 v[16]; float ss = 0.f;
#pragma unroll
        for (int j = 0; j < 16; ++j) { v[j] = __builtin_nontemporal_load((const f32x4*)xr + C.lane + 64 * j); ss += (v[j].x * v[j].x + v[j].y * v[j].y) + (v[j].z * v[j].z + v[j].w * v[j].w); }
        ss = wave_sum(ss);
        const float r = 1.0f / sqrtf(ss * (1.0f / DM) + EPS);
#pragma unroll
        for (int j = 0; j < 16; ++j) { const f32x4 gv = ((const f32x4*)g)[C.lane + 64 * j]; const f32x4 o = v[j] * r * gv;
            if (TO_BF16) { v2u w; w.x = pk2(o.x, o.y); w.y = pk2(o.z, o.w); ((v2u*)((bf16*)dst + (size_t)row * DM))[C.lane + 64 * j] = w; }
            else ((f32x4*)((float*)dst + (size_t)row * DM))[C.lane + 64 * j] = o; }
    }
}
template <bool TO_BF16>
__device__ __forceinline__ void rms_row(const float* xr, const float* g, void* drow, int lane) {
    f32x4 v[16]; float ss = 0.f;
#pragma unroll
    for (int j = 0; j < 16; ++j) { v[j] = __builtin_nontemporal_load((const f32x4*)xr + lane + 64 * j); ss += (v[j].x * v[j].x + v[j].y * v[j].y) + (v[j].z * v[j].z + v[j].w * v[j].w); }
    ss = wave_sum(ss);
    const float r = 1.0f / sqrtf(ss * (1.0f / DM) + EPS);
#pragma unroll
    for (int j = 0; j < 16; ++j) { const f32x4 gv = ((const f32x4*)g)[lane + 64 * j]; const f32x4 o = v[j] * r * gv;
        if constexpr (TO_BF16) { v2u w; w.x = pk2(o.x, o.y); w.y = pk2(o.z, o.w); ((v2u*)drow)[lane + 64 * j] = w; }
        else ((f32x4*)drow)[lane + 64 * j] = o; }
}
template <bool TO_BF16>
__device__ __forceinline__ void rms_row_lite(const float* xr, const float* g, void* drow, int lane) {
    float ss = 0.f;
#pragma nounroll
    for (int j0 = 0; j0 < 16; j0 += 4) { f32x4 v[4];
#pragma unroll
        for (int j = 0; j < 4; ++j) v[j] = ((const f32x4*)xr)[lane + 64 * (j0 + j)];
#pragma unroll
        for (int j = 0; j < 4; ++j) ss += (v[j].x * v[j].x + v[j].y * v[j].y) + (v[j].z * v[j].z + v[j].w * v[j].w); }
    ss = wave_sum(ss);
    const float r = 1.0f / sqrtf(ss * (1.0f / DM) + EPS);
#pragma nounroll
    for (int j0 = 0; j0 < 16; j0 += 4) { f32x4 v[4];
#pragma unroll
        for (int j = 0; j < 4; ++j) v[j] = __builtin_nontemporal_load((const f32x4*)xr + lane + 64 * (j0 + j));
#pragma unroll
        for (int j = 0; j < 4; ++j) { const f32x4 gv = ((const f32x4*)g)[lane + 64 * (j0 + j)]; const f32x4 o = v[j] * r * gv;
            if constexpr (TO_BF16) { v2u w; w.x = pk2(o.x, o.y); w.y = pk2(o.z, o.w); ((v2u*)drow)[lane + 64 * (j0 + j)] = w; }
            else ((f32x4*)drow)[lane + 64 * (j0 + j)] = o; } }
}
template <bool TO_BF16>
__device__ __forceinline__ void rms_row2(const float* xa, const float* xb, const float* g, void* da, void* db, int lane) {
    f32x4 va[16], vb[16]; float sa = 0.f, sb = 0.f;
#pragma unroll
    for (int j = 0; j < 16; ++j) va[j] = __builtin_nontemporal_load((const f32x4*)xa + lane + 64 * j);
#pragma unroll
    for (int j = 0; j < 16; ++j) vb[j] = __builtin_nontemporal_load((const f32x4*)xb + lane + 64 * j);
#pragma unroll
    for (int j = 0; j < 16; ++j) sa += (va[j].x * va[j].x + va[j].y * va[j].y) + (va[j].z * va[j].z + va[j].w * va[j].w);
#pragma unroll
    for (int j = 0; j < 16; ++j) sb += (vb[j].x * vb[j].x + vb[j].y * vb[j].y) + (vb[j].z * vb[j].z + vb[j].w * vb[j].w);
    sa = wave_sum(sa); sb = wave_sum(sb);
    const float ra = 1.0f / sqrtf(sa * (1.0f / DM) + EPS), rb = 1.0f / sqrtf(sb * (1.0f / DM) + EPS);
#pragma unroll
    for (int j = 0; j < 16; ++j) { const f32x4 gv = ((const f32x4*)g)[lane + 64 * j]; const f32x4 oa = va[j] * ra * gv, ob = vb[j] * rb * gv;
        if constexpr (TO_BF16) { v2u w; w.x = pk2(oa.x, oa.y); w.y = pk2(oa.z, oa.w); ((v2u*)da)[lane + 64 * j] = w; v2u u; u.x = pk2(ob.x, ob.y); u.y = pk2(ob.z, ob.w); ((v2u*)db)[lane + 64 * j] = u; }
        else { ((f32x4*)da)[lane + 64 * j] = oa; ((f32x4*)db)[lane + 64 * j] = ob; } }
}
template <bool TO_BF16>
__device__ __forceinline__ void phase_rmsnorm_half(const Ctx& C, const float* src, const float* g, void* dst, int nrows = TOK_P) {
    for (int row = C.gw; row < nrows; row += C.NGW) { void* drow; if constexpr (TO_BF16) drow = (bf16*)dst + (size_t)row * DM; else drow = (float*)dst + (size_t)row * DM; rms_row<TO_BF16>(src + (size_t)row * DM, g, drow, C.lane); }
}
template <bool TO_BF16, int RPS>
struct SlotNormOrder : pg8::StaticOrder {
    const float* src; const float* g; void* dst; int nrows, gw, ngw, lane; mutable int k;
    __device__ __forceinline__ void* drow_of(int row) const { if constexpr (TO_BF16) return (bf16*)dst + (size_t)row * DM; else return (float*)dst + (size_t)row * DM; }
    __device__ __forceinline__ void slot() const {
#pragma nounroll
        for (int q = 0; q < RPS; q += 2) { const int row = gw + ngw * (k * RPS + q), row2 = row + ngw; if (row >= nrows) break;
            int ln = lane; asm volatile("" : "+v"(ln));
            if (RPS > 1 && q + 1 < RPS && row2 < nrows) rms_row2<TO_BF16>(src + (size_t)row * DM, src + (size_t)row2 * DM, g, drow_of(row), drow_of(row2), ln);
            else rms_row<TO_BF16>(src + (size_t)row * DM, g, drow_of(row), ln); }
        ++k;
    }
    __device__ __forceinline__ void done(const pg8::Unit&) const { slot(); }
    __device__ __forceinline__ void flush() const { while (gw + ngw * (k * RPS) < nrows) slot(); }
};
__device__ __forceinline__ void phase_prep(const Ctx& C, int l) {
    bf16* proj = (bf16*)(C.ws + WS_PROJ);
    const float* cosA = (const float*)(C.ws + WS_ROPE); const float* sinA = cosA + 4096 * 16; const float* cosX = sinA + 4096 * 16; const float* sinX = cosX + 64 * 32;
    const float* qkg = C.a->in[I_QKG] + l * 256;
    {
        const int d1 = C.lane < 32 ? C.lane : C.lane + 32, d2 = d1 + 32; const float gq1 = qkg[d1], gq2 = qkg[d2], gk1 = qkg[128 + d1], gk2 = qkg[128 + d2];
        for (int row = C.gw; row < NTOK; row += C.NGW) {
            const int t = seq_pos(row); bf16* pr = proj + (size_t)row * NPROJ;
            float a1[4], a2[4], ca[4], sa[4], b1[10], b2[10];
#pragma unroll
            for (int k = 0; k < 4; ++k) { const int idx = 64 * k + C.lane, hh = idx >> 4, i = idx & 15; const int col = (hh < 8 ? C_AQ + hh * 128 : C_AK + (hh - 8) * 128) + i;
                a1[k] = bf2f(pr[col]); a2[k] = bf2f(pr[col + 16]); ca[k] = cosA[t * 16 + i]; sa[k] = sinA[t * 16 + i]; }
#pragma unroll
            for (int hh = 0; hh < 10; ++hh) { const int base = hh < 8 ? C_BQ + hh * 128 : C_BK + (hh - 8) * 128; b1[hh] = bf2f(pr[base + d1]); b2[hh] = bf2f(pr[base + d2]); }
            const float c = C.lane < 32 ? cosX[(t >> 6) * 32 + C.lane] : cosX[(t & 63) * 32 + C.lane - 32];
            const float s = C.lane < 32 ? sinX[(t >> 6) * 32 + C.lane] : sinX[(t & 63) * 32 + C.lane - 32];
#pragma unroll
            for (int k = 0; k < 4; ++k) { const int idx = 64 * k + C.lane, hh = idx >> 4, i = idx & 15; const int col = (hh < 8 ? C_AQ + hh * 128 : C_AK + (hh - 8) * 128) + i;
                pr[col] = (bf16)f2bf(a1[k] * ca[k] - a2[k] * sa[k]); pr[col + 16] = (bf16)f2bf(a2[k] * ca[k] + a1[k] * sa[k]); }
#pragma unroll
            for (int hh = 0; hh < 10; ++hh) { const int base = hh < 8 ? C_BQ + hh * 128 : C_BK + (hh - 8) * 128;
                const float ss = wave_sum(b1[hh] * b1[hh] + b2[hh] * b2[hh]); const float r = 1.0f / sqrtf(ss * (1.0f / 128.0f) + EPS);
                const float x1 = b1[hh] * r * (hh < 8 ? gq1 : gk1), x2 = b2[hh] * r * (hh < 8 ? gq2 : gk2);
                pr[base + d1] = (bf16)f2bf(x1 * c - x2 * s); pr[base + d2] = (bf16)f2bf(x2 * c + x1 * s); }
        }
    }
    {
        LAS float* tile = (LAS float*)C.lds + C.wave * (64 * 65);
        const float* cw = C.a->in[I_HCW] + l * 3 * 3072; const float* cb = C.a->in[I_HCB] + l * 3072; bf16* uct = (bf16*)(C.ws + WS_UCT);
        for (int it = C.gw; it < (NTOK / 64) * 48; it += C.NGW) {
            const int tb = it / 48, cbk = it % 48, cg = cbk * 64 + C.lane; const int row0 = tb * 64, t0 = seq_pos(row0), L = row0 < TOK_P ? L_P : L_S;
            const float w0 = cw[cg], w1 = cw[3072 + cg], w2 = cw[2 * 3072 + cg], bb = cb[cg];
            const bf16* p = proj + (size_t)row0 * NPROJ + C_CU + cg;
            unsigned short u[66];
#pragma unroll
            for (int j = 0; j < 64; ++j) u[j + 1] = p[(size_t)j * NPROJ];
            u[0] = t0 > 0 ? p[-(ptrdiff_t)NPROJ] : (unsigned short)0; u[65] = t0 + 64 < L ? p[(size_t)64 * NPROJ] : (unsigned short)0;
#pragma unroll
            for (int j = 0; j < 64; ++j) tile[C.lane * 65 + j] = bb + bf2f(u[j]) * w0 + bf2f(u[j + 1]) * w1 + bf2f(u[j + 2]) * w2;
            LDS_WAIT(); asm volatile("" ::: "memory");
#pragma unroll
            for (int k = 0; k < 8; ++k) { const int id = C.lane + 64 * k, ch = id >> 3, part = id & 7; const LAS float* s = tile + ch * 65 + part * 8;
                v4u o; o.x = pk2(s[0], s[1]); o.y = pk2(s[2], s[3]); o.z = pk2(s[4], s[5]); o.w = pk2(s[6], s[7]);
                *(v4u*)(uct + (size_t)(cbk * 64 + ch) * NTOK + row0 + part * 8) = o; }
            LDS_WAIT(); asm volatile("" ::: "memory");
        }
        __syncthreads();
    }
    {
        const float* gates = (const float*)(C.ws + WS_GATES); const float* gb = C.a->in[I_MLGB] + l * 16; float* gc = (float*)(C.ws + WS_GCUM);
        LAS float* tot = (LAS float*)C.lds;
        for (int it = C.bid; it < 12 * 4 * 2; it += C.G) {
            const int dir = it & 1, h = (it >> 1) & 3, sq = it >> 3; const int L = sq < B_P ? L_P : L_S; const int row0 = sq < B_P ? sq * L_P : TOK_P + (sq - B_P) * L_S;
            const float bi = gb[(2 * dir) * 4 + h], bf_ = gb[(2 * dir + 1) * 4 + h]; const int nch = L / 512;
            float xs[8], gis[8]; float carry = 0.f;
            __syncthreads();
#pragma unroll
            for (int c = 0; c < 8; ++c) if (c < nch) {
                const int sidx = (C.wave * nch + c) * 64 + C.lane; const int tl = dir == 0 ? sidx : L - 1 - sidx; const int row = row0 + tl;
                gis[c] = gates[(size_t)row * 16 + (2 * dir) * 4 + h] + bi; const float gf = gates[(size_t)row * 16 + (2 * dir + 1) * 4 + h] + bf_;
                float x = fminf(gf, 0.f) - log1pf(__expf(-fabsf(gf)));
#pragma unroll
                for (int o = 1; o < 64; o <<= 1) { const float y = __shfl_up(x, o); if (C.lane >= o) x += y; }
                x += carry; carry = __shfl(x, 63); xs[c] = x;
            }
            if (C.lane == 0) tot[C.wave] = carry;
            __syncthreads();
            float pre = 0.f;
            for (int w = 0; w < C.wave; ++w) pre += tot[w];
#pragma unroll
            for (int c = 0; c < 8; ++c) if (c < nch) {
                const int sidx = (C.wave * nch + c) * 64 + C.lane; const int tl = dir == 0 ? sidx : L - 1 - sidx; const int row = row0 + tl;
                gc[(size_t)((2 * dir) * 4 + h) * NTOK + row] = xs[c] + pre; gc[(size_t)((2 * dir + 1) * 4 + h) * NTOK + row] = gis[c];
            }
        }
        __syncthreads();
    }
}
namespace att {
using bf16x8 = __attribute__((ext_vector_type(8))) short;
using s16x4  = __attribute__((ext_vector_type(4))) short;
using f32x16 = __attribute__((ext_vector_type(16))) float;
using u32x4  = __attribute__((ext_vector_type(4))) unsigned;
constexpr int   D = 128, NW = 8, QBLK = 32, KVBLK = 64;
constexpr float SCALE = 0.088388347648318440f;
constexpr float THR = 8.f;
constexpr size_t SHM_V = KVBLK * D * 2, SHM_K = KVBLK * D * 2, SHM_ATTN = 2 * SHM_V + 2 * SHM_K + NW * 64 * 4;
#define KSWZ(row, colB) ((row) * 256 + ((colB) ^ (((row) & 7) << 4)))
#define SBAR() __builtin_amdgcn_sched_barrier(0)
__device__ __forceinline__ int crow(int r, int hi) { return (r & 3) + 8 * (r >> 2) + 4 * hi; }
__device__ __forceinline__ unsigned cvtpk(float lo, float hi) { unsigned r; asm volatile("v_cvt_pk_bf16_f32 %0, %1, %2" : "=v"(r) : "v"(lo), "v"(hi)); return r; }
__device__ __forceinline__ void partialSM(f32x16& p0, f32x16& p1, float& m_reg, float& mn, float& alpha) {
  constexpr float C = SCALE * 1.4426950408889634f;
  float pmax = p0[0]; for (int r = 1; r < 16; ++r) pmax = fmaxf(pmax, p0[r]); for (int r = 0; r < 16; ++r) pmax = fmaxf(pmax, p1[r]);
  { auto rr = __builtin_amdgcn_permlane32_swap(__float_as_uint(pmax), __float_as_uint(pmax), false, false);
    pmax = fmaxf(__uint_as_float(rr[0]), __uint_as_float(rr[1])); }
  if (__builtin_expect(__all(pmax - m_reg <= THR / SCALE), 1)) { mn = m_reg; alpha = 1.f; }
  else { mn = fmaxf(m_reg, pmax); alpha = __builtin_amdgcn_exp2f((m_reg - mn) * C); m_reg = mn; }
  float mnC = -mn * C;
  for (int r = 0; r < 16; ++r) p0[r] = fmaf(p0[r], C, mnC); for (int r = 0; r < 16; ++r) p1[r] = fmaf(p1[r], C, mnC);
  for (int r = 0; r < 16; ++r) p0[r] = __builtin_amdgcn_exp2f(p0[r]);
}
__device__ __forceinline__ void finishSM(f32x16& p0, f32x16& p1, float alpha, float& l_reg, bf16x8& pa0, bf16x8& pa1, bf16x8& pa2, bf16x8& pa3) {
  for (int r = 0; r < 16; ++r) p1[r] = __builtin_amdgcn_exp2f(p1[r]);
  float ps = 0; for (int r = 0; r < 16; ++r) ps += p0[r]; for (int r = 0; r < 16; ++r) ps += p1[r];
  { auto rr = __builtin_amdgcn_permlane32_swap(__float_as_uint(ps), __float_as_uint(ps), false, false);
    ps = __uint_as_float(rr[0]) + __uint_as_float(rr[1]); }
  l_reg = l_reg * alpha + ps;
#define PK4(P, BASE, OUT) do { unsigned a0 = cvtpk(P[BASE + 0], P[BASE + 1]), a1 = cvtpk(P[BASE + 2], P[BASE + 3]);   \
    unsigned b0 = cvtpk(P[BASE + 4], P[BASE + 5]), b1 = cvtpk(P[BASE + 6], P[BASE + 7]);                              \
    auto r0 = __builtin_amdgcn_permlane32_swap(a0, b0, false, false); auto r1 = __builtin_amdgcn_permlane32_swap(a1, b1, false, false); \
    u32x4 w = {r0[0], r1[0], r0[1], r1[1]}; OUT = *reinterpret_cast<bf16x8*>(&w); } while (0)
  PK4(p0, 0, pa0); PK4(p0, 8, pa1); PK4(p1, 0, pa2); PK4(p1, 8, pa3);
#undef PK4
}
__device__ __forceinline__ void qkt(f32x16& p0, f32x16& p1, const unsigned short* Ks, const bf16x8* qr, int r32, int hi) {
  p0 = f32x16{}; p1 = f32x16{};
  for (int d0 = 0; d0 < 8; ++d0) { int cb = (d0 * 16 + hi * 8) * 2;
    bf16x8 b0 = *reinterpret_cast<const bf16x8*>((const char*)Ks + KSWZ(r32, cb));
    bf16x8 b1 = *reinterpret_cast<const bf16x8*>((const char*)Ks + KSWZ(32 + r32, cb));
    p0 = __builtin_amdgcn_mfma_f32_32x32x16_bf16(b0, qr[d0], p0, 0, 0, 0);
    p1 = __builtin_amdgcn_mfma_f32_32x32x16_bf16(b1, qr[d0], p1, 0, 0, 0); }
}
__device__ __forceinline__ int v_st(int k, int c) { const int kk = (k & ~0xC) | ((k & 4) << 1) | ((k & 8) >> 1); return ((kk >> 3) * 4 + (c >> 5)) * 512 + ((kk & 7) * 32 + (c & 31)) * 2; }
__device__ __forceinline__ int v_rd_base(int lane) { return ((lane & 3) << 3) | (((lane >> 2) & 3) << 6) | (((lane >> 4) & 1) << 5) | (((lane >> 5) & 1) << 8); }
constexpr int v_rd_off(int d0, int ks, int half) { return d0 * 512 + ks * 4096 + half * 2048; }
template <int OFF> __device__ __forceinline__ s16x4 tr_read(int vb) {
  s16x4 r; asm volatile("ds_read_b64_tr_b16 %0, %1 offset:%2" : "=&v"(r) : "v"(vb), "i"(OFF) : "memory"); return r;
}
template <int D0> __device__ __forceinline__ void pv_one(f32x16& od, int vb, bf16x8 pa0, bf16x8 pa1, bf16x8 pa2, bf16x8 pa3) {
  const s16x4 l0 = tr_read<v_rd_off(D0, 0, 0)>(vb), h0 = tr_read<v_rd_off(D0, 0, 1)>(vb), l1 = tr_read<v_rd_off(D0, 1, 0)>(vb), h1 = tr_read<v_rd_off(D0, 1, 1)>(vb);
  const s16x4 l2 = tr_read<v_rd_off(D0, 2, 0)>(vb), h2 = tr_read<v_rd_off(D0, 2, 1)>(vb), l3 = tr_read<v_rd_off(D0, 3, 0)>(vb), h3 = tr_read<v_rd_off(D0, 3, 1)>(vb);
  asm volatile("s_waitcnt lgkmcnt(0)" ::: "memory"); SBAR();
#define PK(L, H) (bf16x8){L[0], L[1], L[2], L[3], H[0], H[1], H[2], H[3]}
  od = __builtin_amdgcn_mfma_f32_32x32x16_bf16(pa0, PK(l0, h0), od, 0, 0, 0);
  od = __builtin_amdgcn_mfma_f32_32x32x16_bf16(pa1, PK(l1, h1), od, 0, 0, 0);
  od = __builtin_amdgcn_mfma_f32_32x32x16_bf16(pa2, PK(l2, h2), od, 0, 0, 0);
  od = __builtin_amdgcn_mfma_f32_32x32x16_bf16(pa3, PK(l3, h3), od, 0, 0, 0);
#undef PK
}
__device__ __forceinline__ void pv_d0(f32x16* o, int vb, bf16x8 pa0, bf16x8 pa1, bf16x8 pa2, bf16x8 pa3) {
  pv_one<0>(o[0], vb, pa0, pa1, pa2, pa3); pv_one<1>(o[1], vb, pa0, pa1, pa2, pa3); pv_one<2>(o[2], vb, pa0, pa1, pa2, pa3); pv_one<3>(o[3], vb, pa0, pa1, pa2, pa3);
}
__device__ __forceinline__ void dil_bias(f32x16& p0, f32x16& p1, int dbase, int hi) {
  constexpr float IC = 1.0f / (SCALE * 1.4426950408889634f);
  const int d0 = dbase + 4 * hi;
#pragma unroll
  for (int r = 0; r < 16; ++r) {
#pragma unroll
    for (int half = 0; half < 2; ++half) {
      const int dl = d0 + (r & 3) + 8 * (r >> 2) + 32 * half; const int ad = dl < 0 ? -dl : dl;
      const float f1 = ad <= 64 ? 1.f : 0.f, f2 = (((dl & 3) == 0) & (ad <= 256)) ? 1.f : 0.f, f3 = (((dl & 15) == 0) & (ad <= 1024)) ? 1.f : 0.f;
      const float b = IC * __builtin_amdgcn_logf(f1 + f2 + f3);
      if (half == 0) p0[r] += b; else p1[r] += b;
    }
  }
}
template <int DK> __device__ __forceinline__ void qkt_dk(f32x16& p0, f32x16& p1, const char* Ks, const bf16x8* qr, int r32, int hi) {
  p0 = f32x16{}; p1 = f32x16{};
#pragma unroll
  for (int d0 = 0; d0 < DK / 16; ++d0) { const int cb = (d0 * 16 + hi * 8) * 2;
    bf16x8 b0 = *reinterpret_cast<const bf16x8*>(Ks + r32 * (DK * 2) + (cb ^ ((r32 & 7) << 4)));
    bf16x8 b1 = *reinterpret_cast<const bf16x8*>(Ks + (32 + r32) * (DK * 2) + (cb ^ ((r32 & 7) << 4)));
    p0 = __builtin_amdgcn_mfma_f32_32x32x16_bf16(b0, qr[d0], p0, 0, 0, 0);
    p1 = __builtin_amdgcn_mfma_f32_32x32x16_bf16(b1, qr[d0], p1, 0, 0, 0); }
}
__device__ __forceinline__ float pack_p(const f32x16& p0, const f32x16& p1, bf16x8& pa0, bf16x8& pa1, bf16x8& pa2, bf16x8& pa3) {
  float ps = 0; for (int r = 0; r < 16; ++r) ps += p0[r]; for (int r = 0; r < 16; ++r) ps += p1[r];
  { auto rr = __builtin_amdgcn_permlane32_swap(__float_as_uint(ps), __float_as_uint(ps), false, false);
    ps = __uint_as_float(rr[0]) + __uint_as_float(rr[1]); }
#define PK4(P, BASE, OUT) do { unsigned a0 = cvtpk(P[BASE + 0], P[BASE + 1]), a1 = cvtpk(P[BASE + 2], P[BASE + 3]);   \
    unsigned b0 = cvtpk(P[BASE + 4], P[BASE + 5]), b1 = cvtpk(P[BASE + 6], P[BASE + 7]);                              \
    auto r0 = __builtin_amdgcn_permlane32_swap(a0, b0, false, false); auto r1 = __builtin_amdgcn_permlane32_swap(a1, b1, false, false); \
    u32x4 w = {r0[0], r1[0], r0[1], r1[1]}; OUT = *reinterpret_cast<bf16x8*>(&w); } while (0)
  PK4(p0, 0, pa0); PK4(p0, 8, pa1); PK4(p1, 0, pa2); PK4(p1, 8, pa3);
#undef PK4
  return ps;
}
__device__ __forceinline__ void store_o_tile(const f32x16* o, const float* rli, unsigned short* Ow, int LDO, __attribute__((address_space(3))) unsigned char* ldsl, int wid, int lane) {
  typedef __attribute__((address_space(3))) unsigned short LUS; typedef __attribute__((address_space(3))) u32x4 LU4;
  constexpr int RP = 272;
  const int r32 = lane & 31, hi = lane >> 5;
  unsigned wb = (unsigned)(uintptr_t)ldsl + (unsigned)(wid * (32 * RP) + 4 * hi * RP + r32 * 2), rb = (unsigned)(uintptr_t)ldsl + (unsigned)(wid * (32 * RP) + (lane >> 4) * RP + (lane & 15) * 16);
  asm volatile("" : "+v"(wb), "+v"(rb));
#pragma unroll
  for (int r = 0; r < 16; ++r)
#pragma unroll
    for (int d0 = 0; d0 < 4; ++d0) *(LUS*)(uintptr_t)(wb + (unsigned)(((r & 3) + 8 * (r >> 2)) * RP + d0 * 64)) = (unsigned short)f2bf(o[d0][r] * rli[r]);
  asm volatile("s_waitcnt lgkmcnt(0)" ::: "memory");
  unsigned short* gp = Ow + (long)(lane >> 4) * LDO + (lane & 15) * 8;
#pragma unroll
  for (int k = 0; k < 8; ++k) { const u32x4 w = *(const LU4*)(uintptr_t)(rb + (unsigned)(4 * k * RP)); *reinterpret_cast<u32x4*>(gp + (long)(4 * k) * LDO) = w; }
}
#define WAITBAR(n) do { asm volatile("s_waitcnt vmcnt(" #n ") lgkmcnt(0)" ::: "memory"); __builtin_amdgcn_s_barrier(); asm volatile("" ::: "memory"); } while (0)
template <int MODE, int DK, int LDQ, int LDK, int LDV>
__device__ __forceinline__ void flash_body(const unsigned short* __restrict__ Qb, const unsigned short* __restrict__ Kh, const unsigned short* __restrict__ Vh, int NT, int dk0,
                                           const float* gq, const float* gkc, const float* gkl, int dir, const unsigned short* CT, const float* nst, float gref, unsigned short* Ob, int LDO, __attribute__((address_space(3))) unsigned char* ldsl, int tid) {
  typedef __attribute__((address_space(3))) unsigned LU;
  constexpr int SHM_KD = KVBLK * DK * 2, CPR = DK / 8, KROWS = 512 / CPR, KP = 64 / KROWS, NVB = DK == 128 ? 3 : 2;
  char* lds = (char*)ldsl;
  const int wid = __builtin_amdgcn_readfirstlane(tid >> 6), lane = tid & 63, r32 = lane & 31, hi = lane >> 5;
  char* K_lds = lds + NVB * SHM_V;
  float* ws = (float*)(lds + NVB * SHM_V + 3 * SHM_KD) + wid * 64; float* li_l = ws; float* al_l = ws + 32;
  float* cs_l = (float*)(lds + NVB * SHM_V + 3 * SHM_KD + NW * 256);
  float m_reg = -1e30f, l_reg = 0; f32x16 o[4] = {}; bf16x8 qr[DK / 16];
  const unsigned short* Qw = Qb + (long)(wid * QBLK + r32) * LDQ + hi * 8;
#pragma unroll
  for (int d0 = 0; d0 < DK / 16; ++d0) qr[d0] = *reinterpret_cast<const bf16x8*>(Qw + d0 * 16);
  const int vb0 = (int)(uintptr_t)ldsl + v_rd_base(lane);
  const int dbase0 = dk0 - (wid * QBLK + r32);
  const int krow = tid / CPR, kch = (tid % CPR) ^ (krow & 7);
  const unsigned voffk = (unsigned)(krow * LDK) * 2u + (unsigned)kch * 16u;
  const int vkk = (tid >> 7) * 8 + ((tid >> 2) & 7), vk = (vkk & ~0xC) | ((vkk & 4) << 1) | ((vkk & 8) >> 1), vc = ((tid >> 5) & 3) * 32 + (tid & 3) * 8;
  const unsigned voffv = (unsigned)(vk * LDV + vc) * 2u;
  const float gql = (MODE == 1) ? gq[wid * QBLK + r32] : 0.f;
  const char* kp = (const char*)Kh; const char* vp = (const char*)Vh;
  int ks = 0, vs = 0;
  LU* const kl0 = (LU*)(ldsl + NVB * SHM_V + wid * 1024); LU* const vl0 = (LU*)(ldsl + wid * 1024);
#define STAGE_K() do { _Pragma("unroll") for (int i_ = 0; i_ < KP; ++i_) __builtin_amdgcn_global_load_lds((const unsigned*)(kp + voffk + (unsigned)(i_ * KROWS) * (LDK * 2u)), kl0 + (ks * SHM_KD + i_ * 8192) / 4, 16, 0, 0); \
    kp += KVBLK * LDK * 2; ks = ks == 2 ? 0 : ks + 1; } while (0)
#define STAGE_V() do { _Pragma("unroll") for (int i_ = 0; i_ < 2; ++i_) __builtin_amdgcn_global_load_lds((const unsigned*)(vp + voffv + (unsigned)(i_ * 32) * (LDV * 2u)), vl0 + (vs * SHM_V + i_ * 8192) / 4, 16, 0, 0); \
    vp += KVBLK * LDV * 2; vs = vs == NVB - 1 ? 0 : vs + 1; } while (0)
  bf16x8 pa0, pa1, pa2, pa3; f32x16 p0, p1; float cst = 0.f;
  float b16[8];
#pragma unroll
  for (int i = 0; i < 8; ++i) b16[i] = (MODE == 2 && ((dbase0 + 4 * hi + (i & 3) + 8 * (i >> 2)) & 15) == 0) ? 0.f : -__builtin_inff();
  if (MODE == 1 && tid < 64) cs_l[tid] = gkc[tid] - gkl[tid];
  STAGE_V(); STAGE_K();
  if (MODE == 1 && CT != nullptr) {
    const float sc = __builtin_amdgcn_exp2f((gql - gref) * 1.4426950408889634f); float dn = 0.f;
    const unsigned ctoff = (unsigned)(r32 * 256 + hi * 8) * 2u, noff = (unsigned)hi * 32u; const char* ctb = (const char*)CT; const char* nb = (const char*)nst;
    asm volatile("" : "+s"(ctb), "+s"(nb));
#pragma unroll
    for (int d0 = 0; d0 < DK / 16; ++d0) {
      const u32x4 qw = *reinterpret_cast<const u32x4*>(&qr[d0]); const unsigned qa[4] = {qw.x, qw.y, qw.z, qw.w};
      const f32x4 n0 = *(const f32x4*)(nb + noff + d0 * 64), n1 = *(const f32x4*)(nb + noff + d0 * 64 + 16); const float nn[8] = {n0.x, n0.y, n0.z, n0.w, n1.x, n1.y, n1.z, n1.w};
      unsigned qo[4];
#pragma unroll
      for (int k = 0; k < 4; ++k) { const float a = __builtin_bit_cast(float, qa[k] << 16) * sc, b = __builtin_bit_cast(float, qa[k] & 0xffff0000u) * sc; dn += a * nn[2 * k] + b * nn[2 * k + 1]; qo[k] = cvtpk(a, b); }
      const u32x4 qsw = {qo[0], qo[1], qo[2], qo[3]}; const bf16x8 qs = *reinterpret_cast<const bf16x8*>(&qsw);
#pragma unroll
      for (int eb = 0; eb < 4; ++eb) { const bf16x8 cb = *reinterpret_cast<const bf16x8*>(ctb + ctoff + (eb * 32 * 256 + d0 * 16) * 2);
        o[eb] = __builtin_amdgcn_mfma_f32_32x32x16_bf16(qs, cb, o[eb], 0, 0, 0); }
    }
    { auto rr = __builtin_amdgcn_permlane32_swap(__float_as_uint(dn), __float_as_uint(dn), false, false); dn = __uint_as_float(rr[0]) + __uint_as_float(rr[1]); }
    l_reg += dn;
  }
  if (NVB == 3) { STAGE_V(); STAGE_K(); if (KP == 2) WAITBAR(4); else WAITBAR(6); }
  else { STAGE_K(); if (KP == 2) WAITBAR(2); else WAITBAR(4); }
  int kc = 0, vcur = 0;
#pragma nounroll
  for (int j = 0; j < NT; ++j) {
    if (MODE == 1 && tid < 64 && j + 1 < NT) cst = gkc[(j + 1) * KVBLK + tid] - gkl[(j + 1) * KVBLK + tid];
    const bool more = j + 2 < NT;
    if (NVB == 3) { if (more) { STAGE_V(); STAGE_K(); } }
    else { if (j + 1 < NT) STAGE_V(); if (more) STAGE_K(); }
    SBAR(); qkt_dk<DK>(p0, p1, K_lds + kc * SHM_KD, qr, r32, hi);
    if (MODE == 1) {
      const int b = j & 1;
      const int dbase = dbase0 + 64 * j;
      const int wmin = dk0 + 64 * j - wid * QBLK - 31, wmax = dk0 + 64 * j + 63 - wid * QBLK;
      const bool need_mask = dir == 0 ? (wmax > 0) : (wmin < 0);
      const float* cs = cs_l + b * 64 + 4 * hi;
#pragma unroll
      for (int g = 0; g < 4; ++g) { const f32x4 c0 = *(const f32x4*)(cs + 8 * g), c1 = *(const f32x4*)(cs + 32 + 8 * g);
#pragma unroll
        for (int i = 0; i < 4; ++i) { const int r = 4 * g + i;
          p0[r] *= __builtin_amdgcn_exp2f((gql - c0[i]) * 1.4426950408889634f - 4.0f); p1[r] *= __builtin_amdgcn_exp2f((gql - c1[i]) * 1.4426950408889634f - 4.0f); } }
      if (need_mask) {
#pragma unroll
        for (int r = 0; r < 16; ++r) { const int d0_ = dbase + (r & 3) + 8 * (r >> 2) + 4 * hi, d1_ = d0_ + 32;
          const bool ok0 = dir == 0 ? (d0_ <= 0) : (d0_ >= 0), ok1 = dir == 0 ? (d1_ <= 0) : (d1_ >= 0);
          p0[r] = ok0 ? p0[r] : 0.f; p1[r] = ok1 ? p1[r] : 0.f; }
      }
      l_reg += pack_p(p0, p1, pa0, pa1, pa2, pa3);
    } else {
      if (MODE == 2) {
        const int wmin = dk0 + 64 * j - wid * QBLK - 31, wmax = dk0 + 64 * j + 63 - wid * QBLK;
        if ((wmin > 256 && wmax <= 1024) || (wmax < -256 && wmin >= -1024)) {
#pragma unroll
          for (int r = 0; r < 16; ++r) { const float b = b16[(r & 3) + 4 * ((r >> 2) & 1)]; p0[r] += b; p1[r] += b; }
        } else dil_bias(p0, p1, dbase0 + 64 * j, hi);
      }
      float mn, alpha; partialSM(p0, p1, m_reg, mn, alpha);
      if (__any(alpha < 1.f)) { if (hi == 0) al_l[r32] = alpha; asm volatile("s_waitcnt lgkmcnt(0)" ::: "memory");
        for (int d = 0; d < 4; ++d) for (int r = 0; r < 16; ++r) o[d][r] *= al_l[crow(r, hi)]; }
      finishSM(p0, p1, alpha, l_reg, pa0, pa1, pa2, pa3);
    }
    SBAR();
    pv_d0(o, vb0 + vcur * (int)SHM_V, pa0, pa1, pa2, pa3);
    kc = kc == 2 ? 0 : kc + 1; vcur = vcur == NVB - 1 ? 0 : vcur + 1;
    if (MODE == 1) { if (more) { if (KP == 2) asm volatile("s_waitcnt vmcnt(2)" ::: "memory"); else asm volatile("s_waitcnt vmcnt(4)" ::: "memory"); } else asm volatile("s_waitcnt vmcnt(0)" ::: "memory");
      if (tid < 64 && j + 1 < NT) cs_l[((j + 1) & 1) * 64 + tid] = cst; }
    if (more) { if (NVB == 3) { if (KP == 2) WAITBAR(4); else WAITBAR(6); } else { if (KP == 2) WAITBAR(2); else WAITBAR(4); } }
    else WAITBAR(0);
  }
  if (hi == 0) li_l[r32] = l_reg; asm volatile("s_waitcnt lgkmcnt(0)" ::: "memory");
  float rli[16];
#pragma unroll
  for (int r = 0; r < 16; ++r) { const float lv = li_l[crow(r, hi)]; rli[r] = (MODE == 1) ? 1.0f / fmaxf(fabsf(lv), 1.0f) : __builtin_amdgcn_rcpf(lv); }
  store_o_tile(o, rli, Ob + (long)(wid * QBLK) * LDO, LDO, ldsl, wid, lane);
  __syncthreads();
#undef STAGE_K
#undef STAGE_V
}
template <int MODE, int LDQ, int LDK, int LDV>
__device__ __forceinline__ void flash_body3(const unsigned short* __restrict__ Qb, const unsigned short* __restrict__ Kh, const unsigned short* __restrict__ Vh, int NT, int dk0,
                                            unsigned short* Ob, int LDO, __attribute__((address_space(3))) unsigned char* ldsl, int tid) {
  typedef __attribute__((address_space(3))) unsigned LU;
  constexpr int DK = 128, SHM_KD = KVBLK * DK * 2, CPR = DK / 8;
  char* lds = (char*)ldsl;
  const int wid = __builtin_amdgcn_readfirstlane(tid >> 6), lane = tid & 63, r32 = lane & 31, hi = lane >> 5;
  char* K_lds = lds + 4 * SHM_V;
  float* ws = (float*)(lds + 4 * SHM_V + 4 * SHM_KD) + wid * 64; float* li_l = ws; float* al_l = ws + 32;
  float m_reg = -1e30f, l_reg = 0; f32x16 o[4] = {}; bf16x8 qr[8];
  const unsigned short* Qw = Qb + (long)(wid * QBLK + r32) * LDQ + hi * 8;
#pragma unroll
  for (int d0 = 0; d0 < 8; ++d0) qr[d0] = *reinterpret_cast<const bf16x8*>(Qw + d0 * 16);
  const int vb0 = (int)(uintptr_t)ldsl + v_rd_base(lane);
  const int dbase0 = dk0 - (wid * QBLK + r32);
  const int krow = tid / CPR, kch = (tid % CPR) ^ (krow & 7);
  const unsigned voffk = (unsigned)(krow * LDK) * 2u + (unsigned)kch * 16u;
  const int vkk = (tid >> 7) * 8 + ((tid >> 2) & 7), vk = (vkk & ~0xC) | ((vkk & 4) << 1) | ((vkk & 8) >> 1), vc = ((tid >> 5) & 3) * 32 + (tid & 3) * 8;
  const unsigned voffv = (unsigned)(vk * LDV + vc) * 2u;
  float b16[8];
#pragma unroll
  for (int i = 0; i < 8; ++i) b16[i] = (MODE == 2 && ((dbase0 + 4 * hi + (i & 3) + 8 * (i >> 2)) & 15) == 0) ? 0.f : -__builtin_inff();
  const char* kp = (const char*)Kh; const char* vp = (const char*)Vh; int ks = 0, vs = 0;
  LU* const kl0 = (LU*)(ldsl + 4 * SHM_V + wid * 1024); LU* const vl0 = (LU*)(ldsl + wid * 1024);
#define STAGE_K() do { _Pragma("unroll") for (int i_ = 0; i_ < 2; ++i_) __builtin_amdgcn_global_load_lds((const unsigned*)(kp + voffk + (unsigned)(i_ * 32) * (LDK * 2u)), kl0 + (ks * SHM_KD + i_ * 8192) / 4, 16, 0, 0); \
    kp += KVBLK * LDK * 2; ks = (ks + 1) & 3; } while (0)
#define STAGE_V() do { _Pragma("unroll") for (int i_ = 0; i_ < 2; ++i_) __builtin_amdgcn_global_load_lds((const unsigned*)(vp + voffv + (unsigned)(i_ * 32) * (LDV * 2u)), vl0 + (vs * SHM_V + i_ * 8192) / 4, 16, 0, 0); \
    vp += KVBLK * LDV * 2; vs = (vs + 1) & 3; } while (0)
#define RESC(a) do { if (__any((a) < 1.f)) { if (hi == 0) al_l[r32] = (a); asm volatile("s_waitcnt lgkmcnt(0)" ::: "memory"); \
    for (int d = 0; d < 4; ++d) for (int r = 0; r < 16; ++r) o[d][r] *= al_l[crow(r, hi)]; } } while (0)
#define BIAS(P0, P1, t) do { if (MODE == 2) { const int wmin_ = dk0 + 64 * (t) - wid * QBLK - 31, wmax_ = dk0 + 64 * (t) + 63 - wid * QBLK; \
    if ((wmin_ > 256 && wmax_ <= 1024) || (wmax_ < -256 && wmin_ >= -1024)) { _Pragma("unroll") for (int r_ = 0; r_ < 16; ++r_) { const float b_ = b16[(r_ & 3) + 4 * ((r_ >> 2) & 1)]; P0[r_] += b_; P1[r_] += b_; } } \
    else dil_bias(P0, P1, dbase0 + 64 * (t), hi); } } while (0)
  f32x16 pA0, pA1, pB0, pB1; float mnA, mnB, alA, alB; bf16x8 pa0, pa1, pa2, pa3;
  STAGE_K(); STAGE_K(); STAGE_K(); STAGE_V(); STAGE_V();
  WAITBAR(0);
  qkt_dk<DK>(pA0, pA1, K_lds, qr, r32, hi); BIAS(pA0, pA1, 0); partialSM(pA0, pA1, m_reg, mnA, alA);
  asm volatile("s_waitcnt lgkmcnt(0)" ::: "memory"); __builtin_amdgcn_s_barrier(); asm volatile("" ::: "memory");
  int kn = 1, vcur = 0;
  for (int j = 0; j < NT; j += 2) {
    if (j + 3 < NT) STAGE_K(); if (j + 4 < NT) STAGE_K(); if (j + 2 < NT) STAGE_V(); if (j + 3 < NT) STAGE_V();
    SBAR(); qkt_dk<DK>(pB0, pB1, K_lds + kn * SHM_KD, qr, r32, hi); kn = (kn + 1) & 3;
    finishSM(pA0, pA1, alA, l_reg, pa0, pa1, pa2, pa3); SBAR();
    pv_d0(o, vb0 + vcur * (int)SHM_V, pa0, pa1, pa2, pa3); vcur = (vcur + 1) & 3;
    BIAS(pB0, pB1, j + 1); partialSM(pB0, pB1, m_reg, mnB, alB); RESC(alB);
    const bool m2 = j + 2 < NT;
    SBAR(); if (m2) { qkt_dk<DK>(pA0, pA1, K_lds + kn * SHM_KD, qr, r32, hi); kn = (kn + 1) & 3; }
    finishSM(pB0, pB1, alB, l_reg, pa0, pa1, pa2, pa3); SBAR();
    pv_d0(o, vb0 + vcur * (int)SHM_V, pa0, pa1, pa2, pa3); vcur = (vcur + 1) & 3;
    if (m2) { BIAS(pA0, pA1, j + 2); partialSM(pA0, pA1, m_reg, mnA, alA); RESC(alA); }
    WAITBAR(0);
  }
  if (hi == 0) li_l[r32] = l_reg; asm volatile("s_waitcnt lgkmcnt(0)" ::: "memory");
  float rli[16];
#pragma unroll
  for (int r = 0; r < 16; ++r) rli[r] = __builtin_amdgcn_rcpf(li_l[crow(r, hi)]);
  store_o_tile(o, rli, Ob + (long)(wid * QBLK) * LDO, LDO, ldsl, wid, lane);
  __syncthreads();
#undef STAGE_K
#undef STAGE_V
#undef RESC
#undef BIAS
}
template <int MODE, int LDQ, int LDK, int LDV>
__device__ __forceinline__ void flash_body2(const unsigned short* __restrict__ Qb, const unsigned short* __restrict__ Kh, const unsigned short* __restrict__ Vh, int NT, int dk0,
                                            unsigned short* Ob, int LDO, __attribute__((address_space(3))) unsigned char* ldsl, int tid) {
  typedef __attribute__((address_space(3))) unsigned LU;
  constexpr int DK = 128, SHM_KD = KVBLK * DK * 2, CPR = DK / 8;
  char* lds = (char*)ldsl;
  const int wid = __builtin_amdgcn_readfirstlane(tid >> 6), lane = tid & 63, r32 = lane & 31, hi = lane >> 5;
  char* K_lds = lds + 3 * SHM_V;
  float* ws = (float*)(lds + 3 * SHM_V + 3 * SHM_KD) + wid * 64; float* li_l = ws; float* al_l = ws + 32;
  float m_reg = -1e30f, l_reg = 0; f32x16 o[4] = {}; bf16x8 qr[8];
  const unsigned short* Qw = Qb + (long)(wid * QBLK + r32) * LDQ + hi * 8;
#pragma unroll
  for (int d0 = 0; d0 < 8; ++d0) qr[d0] = *reinterpret_cast<const bf16x8*>(Qw + d0 * 16);
  const int vb0 = (int)(uintptr_t)ldsl + v_rd_base(lane);
  const int dbase0 = dk0 - (wid * QBLK + r32);
  const int krow = tid / CPR, kch = (tid % CPR) ^ (krow & 7);
  const unsigned voffk = (unsigned)(krow * LDK) * 2u + (unsigned)kch * 16u;
  const int vkk = (tid >> 7) * 8 + ((tid >> 2) & 7), vk = (vkk & ~0xC) | ((vkk & 4) << 1) | ((vkk & 8) >> 1), vc = ((tid >> 5) & 3) * 32 + (tid & 3) * 8;
  const unsigned voffv = (unsigned)(vk * LDV + vc) * 2u;
  const char* kp = (const char*)Kh; const char* vp = (const char*)Vh; int ks = 0, vs = 0;
  LU* const kl0 = (LU*)(ldsl + 3 * SHM_V + wid * 1024); LU* const vl0 = (LU*)(ldsl + wid * 1024);
#define STAGE_K() do { _Pragma("unroll") for (int i_ = 0; i_ < 2; ++i_) __builtin_amdgcn_global_load_lds((const unsigned*)(kp + voffk + (unsigned)(i_ * 32) * (LDK * 2u)), kl0 + (ks * SHM_KD + i_ * 8192) / 4, 16, 0, 0); \
    kp += KVBLK * LDK * 2; ks = ks == 2 ? 0 : ks + 1; } while (0)
#define STAGE_V() do { _Pragma("unroll") for (int i_ = 0; i_ < 2; ++i_) __builtin_amdgcn_global_load_lds((const unsigned*)(vp + voffv + (unsigned)(i_ * 32) * (LDV * 2u)), vl0 + (vs * SHM_V + i_ * 8192) / 4, 16, 0, 0); \
    vp += KVBLK * LDV * 2; vs = vs == 2 ? 0 : vs + 1; } while (0)
#define RESC(a) do { if (__any((a) < 1.f)) { if (hi == 0) al_l[r32] = (a); asm volatile("s_waitcnt lgkmcnt(0)" ::: "memory"); \
    for (int d = 0; d < 4; ++d) for (int r = 0; r < 16; ++r) o[d][r] *= al_l[crow(r, hi)]; } } while (0)
#define BIAS(P0, P1, t) do { if (MODE == 2) dil_bias(P0, P1, dbase0 + 64 * (t), hi); } while (0)
  f32x16 pA0, pA1, pB0, pB1; float mnA, mnB, alA, alB; bf16x8 pa0, pa1, pa2, pa3;
  STAGE_K(); STAGE_V(); STAGE_K(); STAGE_K(); STAGE_V();
  WAITBAR(4);
  qkt_dk<DK>(pA0, pA1, K_lds, qr, r32, hi); BIAS(pA0, pA1, 0); partialSM(pA0, pA1, m_reg, mnA, alA);
  asm volatile("s_waitcnt lgkmcnt(0)" ::: "memory"); __builtin_amdgcn_s_barrier(); asm volatile("" ::: "memory");
  int kn = 1, vcur = 0;
  for (int j = 0; j < NT; j += 2) {
    const bool m3 = j + 3 < NT, m2 = j + 2 < NT;
    if (m3) STAGE_K(); if (m2) STAGE_V();
    SBAR(); qkt_dk<DK>(pB0, pB1, K_lds + kn * SHM_KD, qr, r32, hi); kn = kn == 2 ? 0 : kn + 1;
    finishSM(pA0, pA1, alA, l_reg, pa0, pa1, pa2, pa3); SBAR();
    pv_d0(o, vb0 + vcur * (int)SHM_V, pa0, pa1, pa2, pa3); vcur = vcur == 2 ? 0 : vcur + 1;
    BIAS(pB0, pB1, j + 1); partialSM(pB0, pB1, m_reg, mnB, alB); RESC(alB);
    if (m3) WAITBAR(4); else if (m2) WAITBAR(2); else WAITBAR(0);
    const bool n3 = j + 4 < NT, n2 = j + 3 < NT;
    if (n3) STAGE_K(); if (n2) STAGE_V();
    SBAR(); if (m2) { qkt_dk<DK>(pA0, pA1, K_lds + kn * SHM_KD, qr, r32, hi); kn = kn == 2 ? 0 : kn + 1; }
    finishSM(pB0, pB1, alB, l_reg, pa0, pa1, pa2, pa3); SBAR();
    pv_d0(o, vb0 + vcur * (int)SHM_V, pa0, pa1, pa2, pa3); vcur = vcur == 2 ? 0 : vcur + 1;
    if (m2) { BIAS(pA0, pA1, j + 2); partialSM(pA0, pA1, m_reg, mnA, alA); RESC(alA); }
    if (n3) WAITBAR(4); else if (n2) WAITBAR(2); else WAITBAR(0);
  }
  if (hi == 0) li_l[r32] = l_reg; asm volatile("s_waitcnt lgkmcnt(0)" ::: "memory");
  float rli[16];
#pragma unroll
  for (int r = 0; r < 16; ++r) rli[r] = __builtin_amdgcn_rcpf(li_l[crow(r, hi)]);
  store_o_tile(o, rli, Ob + (long)(wid * QBLK) * LDO, LDO, ldsl, wid, lane);
  __syncthreads();
#undef STAGE_K
#undef STAGE_V
#undef RESC
#undef BIAS
}
#undef WAITBAR
#undef KSWZ
#undef SBAR
}
__device__ __forceinline__ int ml_state_index(int sq, int h, int dir, int c) { return sq < B_P ? ((sq * 4 + h) * 2 + dir) * 8 + c : 512 + (((sq - B_P) * 4 + h) * 2 + dir) * 16 + c; }
__device__ __forceinline__ void prep_mlstm_states(const Ctx& C, int l) {
    using att::bf16x8; using att::s16x4; using att::f32x16;
    const bf16* proj = (const bf16*)(C.ws + WS_PROJ); const float* gates = (const float*)(C.ws + WS_GATES); const float* gb = C.a->in[I_MLGB] + l * 16;
    bf16* cst = (bf16*)(C.ws + WS_CST); float* nstb = (float*)(C.ws + WS_NST);
    char* ldsg = (char*)C.lds; LAS float* wts = (LAS float*)(C.lds + 49152); LAS float* tot = wts + 256;
    const int wid = C.wave, lane = C.lane, r32 = lane & 31, hi = lane >> 5;
    const int vbK = (int)(uintptr_t)C.lds + (wid >> 2) * 16384 + (wid & 3) * 512 + att::v_rd_base(lane);
    const int vbV = (int)(uintptr_t)C.lds + 32768 + att::v_rd_base(lane);
    for (int it = C.bid; it < 192; it += C.G) {
        const int eh = it & 1, dir = (it >> 1) & 1, h = (it >> 2) & 3, sq = it >> 4;
        const int L = sq < B_P ? L_P : L_S, row0 = sq < B_P ? sq * L_P : TOK_P + (sq - B_P) * L_S, nc = L / 256;
        const float bi = gb[(2 * dir) * 4 + h], bf_ = gb[(2 * dir + 1) * 4 + h];
        f32x16 acc[4] = {}; f32x16 nacc = {};
        for (int ci = 0; ci < nc; ++ci) {
            const int c = dir == 0 ? ci : nc - 1 - ci; const int st = ml_state_index(sq, h, dir, c);
            { bf16* ct = cst + (size_t)st * 65536 + (size_t)(eh * 128) * 256;
#pragma unroll
              for (int eb = 0; eb < 4; ++eb)
#pragma unroll
                for (int g = 0; g < 4; ++g) { v2u w; w.x = pk2(acc[eb][4 * g], acc[eb][4 * g + 1]); w.y = pk2(acc[eb][4 * g + 2], acc[eb][4 * g + 3]);
                    *(v2u*)(ct + (size_t)(eb * 32 + r32) * 256 + wid * 32 + 8 * g + 4 * hi) = w; }
              if (eh == 0 && r32 == 0) { float* np = nstb + (size_t)st * 256 + wid * 32;
#pragma unroll
                for (int r = 0; r < 16; ++r) np[(r & 3) + 8 * (r >> 2) + 4 * hi] = nacc[r]; } }
            if (ci == nc - 1) break;
            __syncthreads();
            float T;
            { float x = 0.f, gi = 0.f;
              if (C.tid < 256) { const int tl = dir == 0 ? C.tid : 255 - C.tid; const size_t row = (size_t)row0 + 256 * c + tl;
                  gi = gates[row * 16 + (2 * dir) * 4 + h] + bi; const float gf = gates[row * 16 + (2 * dir + 1) * 4 + h] + bf_;
                  x = fminf(gf, 0.f) - log1pf(__expf(-fabsf(gf))); }
              const float lf = x;
#pragma unroll
              for (int o = 1; o < 64; o <<= 1) { const float y = __shfl_up(x, o); if (lane >= o) x += y; }
              if (C.tid < 256 && lane == 63) tot[wid] = x;
              __syncthreads();
              float pre = 0.f; for (int w = 0; w < 4; ++w) { const float tw = tot[w]; if (w < wid) pre += tw; }
              T = tot[0] + tot[1] + tot[2] + tot[3];
              if (C.tid < 256) { const float incl = x + pre; const int tl = dir == 0 ? C.tid : 255 - C.tid;
                  wts[tl] = __expf(T - incl + gi) * 0.0625f; (void)lf; }
            }
            __syncthreads();
            { const float aT = __expf(T);
#pragma unroll
              for (int eb = 0; eb < 4; ++eb) acc[eb] = acc[eb] * aT;
              nacc = nacc * aT; }
            const bf16* kb = proj + (size_t)(row0 + 256 * c) * NPROJ + C_DK + h * 256; const bf16* vb = proj + (size_t)(row0 + 256 * c) * NPROJ + C_DV + h * 256 + eh * 128;
            v4u kreg[4], vreg[2];
#define ST_LOAD(kt_) do { _Pragma("unroll") for (int i = 0; i < 4; ++i) { const int id = C.tid + 512 * i, row = id >> 5, c16 = id & 31; kreg[i] = *(const v4u*)(kb + (size_t)(64 * (kt_) + row) * NPROJ + c16 * 8); } \
    _Pragma("unroll") for (int i = 0; i < 2; ++i) { const int id = C.tid + 512 * i, row = id >> 4, c16 = id & 15; vreg[i] = *(const v4u*)(vb + (size_t)(64 * (kt_) + row) * NPROJ + c16 * 8); } } while (0)
            ST_LOAD(0);
            for (int kt = 0; kt < 4; ++kt) {
#pragma unroll
                for (int i = 0; i < 4; ++i) { const int id = C.tid + 512 * i, row = id >> 5, c16 = id & 31; const float w = wts[64 * kt + row]; const unsigned kw[4] = {kreg[i].x, kreg[i].y, kreg[i].z, kreg[i].w}; v4u o;
                    o.x = pk2(bflo(kw[0]) * w, bfhi(kw[0]) * w); o.y = pk2(bflo(kw[1]) * w, bfhi(kw[1]) * w); o.z = pk2(bflo(kw[2]) * w, bfhi(kw[2]) * w); o.w = pk2(bflo(kw[3]) * w, bfhi(kw[3]) * w);
                    *(v4u*)(ldsg + (c16 >> 4) * 16384 + att::v_st(row, (c16 & 15) * 8)) = o; }
#pragma unroll
                for (int i = 0; i < 2; ++i) { const int id = C.tid + 512 * i, row = id >> 4, c16 = id & 15; *(v4u*)(ldsg + 32768 + att::v_st(row, c16 * 8)) = vreg[i]; }
                if (kt + 1 < 4) ST_LOAD(kt + 1);
                __syncthreads();
#pragma unroll
                for (int ks = 0; ks < 4; ++ks) {
                    s16x4 al, ah;
                    if (ks == 0) { al = att::tr_read<att::v_rd_off(0, 0, 0)>(vbK); ah = att::tr_read<att::v_rd_off(0, 0, 1)>(vbK); }
                    else if (ks == 1) { al = att::tr_read<att::v_rd_off(0, 1, 0)>(vbK); ah = att::tr_read<att::v_rd_off(0, 1, 1)>(vbK); }
                    else if (ks == 2) { al = att::tr_read<att::v_rd_off(0, 2, 0)>(vbK); ah = att::tr_read<att::v_rd_off(0, 2, 1)>(vbK); }
                    else { al = att::tr_read<att::v_rd_off(0, 3, 0)>(vbK); ah = att::tr_read<att::v_rd_off(0, 3, 1)>(vbK); }
                    s16x4 bl[4], bh[4];
#define RDB(EB) do { if (ks == 0) { bl[EB] = att::tr_read<att::v_rd_off(EB, 0, 0)>(vbV); bh[EB] = att::tr_read<att::v_rd_off(EB, 0, 1)>(vbV); } \
                     else if (ks == 1) { bl[EB] = att::tr_read<att::v_rd_off(EB, 1, 0)>(vbV); bh[EB] = att::tr_read<att::v_rd_off(EB, 1, 1)>(vbV); } \
                     else if (ks == 2) { bl[EB] = att::tr_read<att::v_rd_off(EB, 2, 0)>(vbV); bh[EB] = att::tr_read<att::v_rd_off(EB, 2, 1)>(vbV); } \
                     else { bl[EB] = att::tr_read<att::v_rd_off(EB, 3, 0)>(vbV); bh[EB] = att::tr_read<att::v_rd_off(EB, 3, 1)>(vbV); } } while (0)
                    RDB(0); RDB(1); RDB(2); RDB(3);
#undef RDB
                    asm volatile("s_waitcnt lgkmcnt(0)" ::: "memory"); __builtin_amdgcn_sched_barrier(0);
                    const bf16x8 a = (bf16x8){al[0], al[1], al[2], al[3], ah[0], ah[1], ah[2], ah[3]};
                    const bf16x8 ones = (bf16x8){0x3f80, 0x3f80, 0x3f80, 0x3f80, 0x3f80, 0x3f80, 0x3f80, 0x3f80};
#pragma unroll
                    for (int eb = 0; eb < 4; ++eb) { const bf16x8 b = (bf16x8){bl[eb][0], bl[eb][1], bl[eb][2], bl[eb][3], bh[eb][0], bh[eb][1], bh[eb][2], bh[eb][3]};
                        acc[eb] = __builtin_amdgcn_mfma_f32_32x32x16_bf16(a, b, acc[eb], 0, 0, 0); }
                    nacc = __builtin_amdgcn_mfma_f32_32x32x16_bf16(a, ones, nacc, 0, 0, 0);
                }
                __syncthreads();
            }
#undef ST_LOAD
        }
    }
    __syncthreads();
}
namespace hy {
typedef float f32x2 __attribute__((ext_vector_type(2)));
typedef __attribute__((address_space(3))) f32x2 LF2;
__device__ __forceinline__ int phys(int i) { return i + (i >> 4); }
__device__ constexpr float ROT_C[8] = {1.0f, 0.9238795325112867f, 0.7071067811865476f, 0.3826834323650898f, 0.0f, -0.3826834323650898f, -0.7071067811865476f, -0.9238795325112867f};
__device__ constexpr float ROT_S[8] = {0.0f, 0.3826834323650898f, 0.7071067811865476f, 0.9238795325112867f, 1.0f, 0.9238795325112867f, 0.7071067811865476f, 0.3826834323650898f};
template <int K, bool INV> __device__ __forceinline__ void fft_pass(LF2* X, int logN, int s, int tid) {
    constexpr int R = 1 << K; const int lq = logN - s - K, q = 1 << lq; const float rms = 1.0f / (float)(q << K);
    for (int g = tid; g < (1 << (logN - K)); g += NTHR) {
        const int p = g & (q - 1), i0 = ((g >> lq) << (lq + K)) + p;
        f32x2 v[R];
#pragma unroll
        for (int e = 0; e < R; ++e) v[e] = X[phys(i0 + e * q)];
        float wc[K], wsn[K];
        { const float f = (float)p * rms; wc[0] = __builtin_amdgcn_cosf(f); wsn[0] = __builtin_amdgcn_sinf(f);
#pragma unroll
          for (int j = 1; j < K; ++j) { wc[j] = wc[j - 1] * wc[j - 1] - wsn[j - 1] * wsn[j - 1]; wsn[j] = 2.0f * wc[j - 1] * wsn[j - 1]; } }
#pragma unroll
        for (int jj = 0; jj < K; ++jj) { const int j = INV ? K - 1 - jj : jj; const int dist = R >> (j + 1);
#pragma unroll
            for (int e = 0; e < R; ++e) if (((e / dist) & 1) == 0) { const int a = e, b = e + dist; const int t8 = (a % dist) * (8 / dist);
                const float cr = ROT_C[t8], sr = ROT_S[t8]; const float c = wc[j] * cr - wsn[j] * sr, sn = wsn[j] * cr + wc[j] * sr;
                if (!INV) { const f32x2 t = v[a] - v[b]; v[a] = v[a] + v[b]; v[b] = (f32x2){t.x * c + t.y * sn, t.y * c - t.x * sn}; }
                else { const f32x2 t = (f32x2){v[b].x * c - v[b].y * sn, v[b].y * c + v[b].x * sn}; v[b] = v[a] - t; v[a] = v[a] + t; } }
        }
#pragma unroll
        for (int e = 0; e < R; ++e) X[phys(i0 + e * q)] = v[e];
    }
}
__device__ __forceinline__ void fft_fwd(LF2* X, int logN, int tid) {
    int s; if (logN == 13) { fft_pass<4, false>(X, logN, 0, tid); s = 4; } else { fft_pass<3, false>(X, logN, 0, tid); s = 3; }
    __syncthreads();
    for (; s < logN; s += 3) { fft_pass<3, false>(X, logN, s, tid); __syncthreads(); }
}
__device__ __forceinline__ void fft_inv(LF2* X, int logN, int tid) {
    const int s0 = logN == 13 ? 4 : 3;
    for (int s = logN - 3; s >= s0; s -= 3) { fft_pass<3, true>(X, logN, s, tid); __syncthreads(); }
    if (logN == 13) fft_pass<4, true>(X, logN, 0, tid); else fft_pass<3, true>(X, logN, 0, tid);
    __syncthreads();
}
template <int LOGN>
__device__ __forceinline__ void hyena_fft_unit_t(const Ctx& C, int l, int c) {
    constexpr int N = 1 << LOGN, L = N / 2, NB = LOGN == 13 ? B_S : B_P, row0 = LOGN == 13 ? TOK_P : 0, XB = (N + N / 16) * 8, NH = N / NTHR;
    LF2* X0 = (LF2*)C.lds; LF2* X1 = (LF2*)(C.lds + XB);
    bf16* uct = (bf16*)(C.ws + WS_UCT); const float* hfil = (const float*)(C.ws + WS_HFIL) + (LOGN == 13 ? (size_t)2048 * L_P : 0); const float* skip = C.a->in[I_HSKIP] + l * 2048;
    const float rn = 1.0f / (float)N;
    f32x2* hsp = (f32x2*)(C.ws + WS_HSP + (size_t)C.bid * 131072);
    { const float* h0 = hfil + (size_t)c * L; const float* h1 = hfil + (size_t)(1024 + c) * L;
      __syncthreads();
      for (int n = C.tid; n < N; n += NTHR) X0[phys(n)] = n < L ? (f32x2){h0[n], h1[n]} : (f32x2){0.f, 0.f};
      __syncthreads();
      fft_fwd(X0, LOGN, C.tid);
      const float hr = 0.5f * rn;
#pragma unroll 2
      for (int p = C.tid; p < N; p += NTHR) { const int kn = (int)(__builtin_bitreverse32((unsigned)p) >> (32 - LOGN)), p2 = (int)(__builtin_bitreverse32((unsigned)((N - kn) & (N - 1))) >> (32 - LOGN));
          const f32x2 z1 = X0[phys(p)], z2 = X0[phys(p2)];
          hsp[p] = (f32x2){(z1.x + z2.x) * hr, (z1.y - z2.y) * hr}; hsp[8192 + p] = (f32x2){(z1.y + z2.y) * hr, (z2.x - z1.x) * hr}; } }
    for (int o = 0; o < 2; ++o) {
        const float sk = skip[o * 1024 + c];
        f32x2 hf[NH];
#pragma unroll
        for (int k = 0; k < NH; ++k) hf[k] = hsp[o * 8192 + C.tid + NTHR * k];
        bf16* src = uct + (size_t)c * NTOK + row0; const bf16* gate = uct + (size_t)((o + 1) * 1024 + c) * NTOK + row0; bf16* dst = o == 0 ? src : uct + (size_t)(1024 + c) * NTOK + row0;
        for (int pp = 0; pp < NB / 4; ++pp) {
            __syncthreads();
            const int n0 = 8 * C.tid; const bool act = n0 < L;
            v4u sa[2], sb[2], qa[2], qb[2];
#pragma unroll
            for (int w = 0; w < 2; ++w) { const int t1 = (4 * pp + 2 * w) * L, t2 = t1 + L; if (act) { sa[w] = *(const v4u*)(src + t1 + n0); sb[w] = *(const v4u*)(src + t2 + n0); } }
#pragma unroll
            for (int w = 0; w < 2; ++w) { const int t1 = (4 * pp + 2 * w) * L, t2 = t1 + L; if (act) { qa[w] = *(const v4u*)(gate + t1 + n0); qb[w] = *(const v4u*)(gate + t2 + n0); } }
#pragma unroll
            for (int w = 0; w < 2; ++w) { LF2* X = w ? X1 : X0;
                for (int n8 = C.tid; n8 < N / 8; n8 += NTHR) { const int n = 8 * n8;
                    if (n < L) { const unsigned aw[4] = {sa[w].x, sa[w].y, sa[w].z, sa[w].w}, bw[4] = {sb[w].x, sb[w].y, sb[w].z, sb[w].w};
#pragma unroll
                        for (int k = 0; k < 4; ++k) { X[phys(n + 2 * k)] = (f32x2){bflo(aw[k]), bflo(bw[k])}; X[phys(n + 2 * k + 1)] = (f32x2){bfhi(aw[k]), bfhi(bw[k])}; } }
                    else {
#pragma unroll
                        for (int k = 0; k < 8; ++k) X[phys(n + k)] = (f32x2){0.f, 0.f}; } } }
            __syncthreads();
            { int s; if (LOGN == 13) { fft_pass<4, false>(X0, LOGN, 0, C.tid); fft_pass<4, false>(X1, LOGN, 0, C.tid); s = 4; } else { fft_pass<3, false>(X0, LOGN, 0, C.tid); fft_pass<3, false>(X1, LOGN, 0, C.tid); s = 3; }
              __syncthreads();
              for (; s < LOGN; s += 3) { fft_pass<3, false>(X0, LOGN, s, C.tid); fft_pass<3, false>(X1, LOGN, s, C.tid); __syncthreads(); } }
#pragma unroll
            for (int k = 0; k < NH; ++k) { const int i = phys(C.tid + NTHR * k); const f32x2 b = hf[k]; const f32x2 a0 = X0[i], a1 = X1[i];
                X0[i] = (f32x2){a0.x * b.x - a0.y * b.y, a0.x * b.y + a0.y * b.x}; X1[i] = (f32x2){a1.x * b.x - a1.y * b.y, a1.x * b.y + a1.y * b.x}; }
            __syncthreads();
            { const int s0 = LOGN == 13 ? 4 : 3;
              for (int s = LOGN - 3; s >= s0; s -= 3) { fft_pass<3, true>(X0, LOGN, s, C.tid); fft_pass<3, true>(X1, LOGN, s, C.tid); __syncthreads(); }
              if (LOGN == 13) { fft_pass<4, true>(X0, LOGN, 0, C.tid); fft_pass<4, true>(X1, LOGN, 0, C.tid); } else { fft_pass<3, true>(X0, LOGN, 0, C.tid); fft_pass<3, true>(X1, LOGN, 0, C.tid); }
              __syncthreads(); }
#pragma unroll
            for (int w = 0; w < 2; ++w) { const LF2* X = w ? X1 : X0; const int t1 = (4 * pp + 2 * w) * L, t2 = t1 + L;
                if (act) { const int t = n0;
                    const v4u ua = sa[w], ub = sb[w], ga = qa[w], gb = qb[w];
                    const unsigned uaw[4] = {ua.x, ua.y, ua.z, ua.w}, ubw[4] = {ub.x, ub.y, ub.z, ub.w}, gaw[4] = {ga.x, ga.y, ga.z, ga.w}, gbw[4] = {gb.x, gb.y, gb.z, gb.w}; unsigned ra[4], rb[4];
#pragma unroll
                    for (int k = 0; k < 4; ++k) { const f32x2 y0 = X[phys(t + L / 2 + 2 * k)], y1 = X[phys(t + L / 2 + 2 * k + 1)];
                        ra[k] = pk2(bflo(gaw[k]) * (y0.x + sk * bflo(uaw[k])), bfhi(gaw[k]) * (y1.x + sk * bfhi(uaw[k])));
                        rb[k] = pk2(bflo(gbw[k]) * (y0.y + sk * bflo(ubw[k])), bfhi(gbw[k]) * (y1.y + sk * bfhi(ubw[k]))); }
                    *(v4u*)(dst + t1 + t) = (v4u){ra[0], ra[1], ra[2], ra[3]}; *(v4u*)(dst + t2 + t) = (v4u){rb[0], rb[1], rb[2], rb[3]}; } }
        }
    }
    __syncthreads();
}
__device__ __forceinline__ void hyena_fft_unit(const Ctx& C, int l, int c, int grp) { if (grp) hyena_fft_unit_t<13>(C, l, c); else hyena_fft_unit_t<12>(C, l, c); }
}
template <int DK, int DV, int KT, int MODE>
__device__ __forceinline__ void valu_attn_item(const Ctx& C, const bf16* Qp, int ldq, const bf16* Kp, int ldk, const bf16* Vp, int ldv, int q0, int kt_lo, int kt_hi, float qscale,
                                               const float* gcum, const float* gli, int dir, bf16* outb, float* outf, int ldo) {
    constexpr int QD = DK / 4, VD = DV / 4;
    LAS float* Ks = (LAS float*)C.lds; LAS float* Vs = Ks + KT * DK; LAS float* Gs = Vs + KT * DV;
    const int qi = C.tid >> 2, part = C.tid & 3, tq = q0 + qi;
    float q[QD], o[VD];
    { const bf16* qp = Qp + (size_t)tq * ldq + part * QD;
#pragma unroll
      for (int j = 0; j < QD; j += 8) { const v4u w = *(const v4u*)(qp + j);
          q[j] = bflo(w.x) * qscale; q[j + 1] = bfhi(w.x) * qscale; q[j + 2] = bflo(w.y) * qscale; q[j + 3] = bfhi(w.y) * qscale; q[j + 4] = bflo(w.z) * qscale; q[j + 5] = bfhi(w.z) * qscale; q[j + 6] = bflo(w.w) * qscale; q[j + 7] = bfhi(w.w) * qscale; } }
#pragma unroll
    for (int j = 0; j < VD; ++j) o[j] = 0.f;
    float m = -1e30f, lsum = 0.f; const float gq = (MODE == 1) ? gcum[tq] : 0.f;
    for (int kt = kt_lo; kt < kt_hi; ++kt) {
        __syncthreads();
        for (int idx = C.tid; idx < KT * DK / 8; idx += NTHR) { const int s = idx / (DK / 8), c8 = idx % (DK / 8); const v4u w = *(const v4u*)(Kp + (size_t)(kt * KT + s) * ldk + c8 * 8);
            LAS f32x4* d = (LAS f32x4*)(Ks + s * DK + c8 * 8); d[0] = (f32x4){bflo(w.x), bfhi(w.x), bflo(w.y), bfhi(w.y)}; d[1] = (f32x4){bflo(w.z), bfhi(w.z), bflo(w.w), bfhi(w.w)}; }
        for (int idx = C.tid; idx < KT * DV / 8; idx += NTHR) { const int s = idx / (DV / 8), c8 = idx % (DV / 8); const v4u w = *(const v4u*)(Vp + (size_t)(kt * KT + s) * ldv + c8 * 8);
            LAS f32x4* d = (LAS f32x4*)(Vs + s * DV + c8 * 8); d[0] = (f32x4){bflo(w.x), bfhi(w.x), bflo(w.y), bfhi(w.y)}; d[1] = (f32x4){bflo(w.z), bfhi(w.z), bflo(w.w), bfhi(w.w)}; }
        if (MODE == 1 && C.tid < KT) { Gs[2 * C.tid] = gcum[kt * KT + C.tid]; Gs[2 * C.tid + 1] = gli[kt * KT + C.tid]; }
        __syncthreads();
        for (int s = 0; s < KT; ++s) {
            const LAS f32x4* kr = (const LAS f32x4*)(Ks + s * DK + part * QD); float dot = 0.f;
#pragma unroll
            for (int j = 0; j < QD / 4; ++j) { const f32x4 kv = kr[j]; dot += (q[4 * j] * kv.x + q[4 * j + 1] * kv.y) + (q[4 * j + 2] * kv.z + q[4 * j + 3] * kv.w); }
            dot += __shfl_xor(dot, 1); dot += __shfl_xor(dot, 2);
            const int ks = kt * KT + s; float p;
            if (MODE == 1) { const bool ok = dir == 0 ? (ks <= tq) : (ks >= tq); p = ok ? dot * __expf(gq - Gs[2 * s] + Gs[2 * s + 1]) : 0.f; lsum += p; }
            else {
                float mult = 1.f;
                if (MODE == 2) { const int dl = ks - tq, ad = dl < 0 ? -dl : dl; mult = (ad <= 64 ? 1.f : 0.f) + (((dl & 3) == 0 && ad <= 256) ? 1.f : 0.f) + (((dl & 15) == 0 && ad <= 1024) ? 1.f : 0.f); }
                if (mult > 0.f) {
                    if (dot > m) { const float al = __expf(m - dot); lsum *= al;
#pragma unroll
                        for (int j = 0; j < VD; ++j) o[j] *= al;
                        m = dot; }
                    p = mult * __expf(dot - m); lsum += p;
                } else p = 0.f;
            }
            const LAS f32x4* vr = (const LAS f32x4*)(Vs + s * DV + part * VD);
#pragma unroll
            for (int j = 0; j < VD / 4; ++j) { const f32x4 vv = vr[j]; o[4 * j] += p * vv.x; o[4 * j + 1] += p * vv.y; o[4 * j + 2] += p * vv.z; o[4 * j + 3] += p * vv.w; }
        }
    }
    const float inv = (MODE == 1) ? 1.0f / fmaxf(fabsf(lsum), 1.0f) : 1.0f / lsum;
    if (MODE == 1) { float* op = outf + (size_t)tq * ldo + part * VD;
#pragma unroll
        for (int j = 0; j < VD; j += 4) *(f32x4*)(op + j) = (f32x4){o[j] * inv, o[j + 1] * inv, o[j + 2] * inv, o[j + 3] * inv}; }
    else { bf16* op = outb + (size_t)tq * ldo + part * VD;
#pragma unroll
        for (int j = 0; j < VD; j += 8) { v4u w; w.x = pk2(o[j] * inv, o[j + 1] * inv); w.y = pk2(o[j + 2] * inv, o[j + 3] * inv); w.z = pk2(o[j + 4] * inv, o[j + 5] * inv); w.w = pk2(o[j + 6] * inv, o[j + 7] * inv); *(v4u*)(op + j) = w; } }
}
__device__ __forceinline__ void hyena_direct_item(const Ctx& C, int l, int c, int row0, int L) {
    LAS float* su = (LAS float*)C.lds;
    LAS float* sz = su + 4096;
    LAS float* sh = sz + 4096;
    const bf16* uct = (const bf16*)(C.ws + WS_UCT); const float* hf = (const float*)(C.ws + WS_HFIL) + (L == L_S ? (size_t)2048 * L_P : 0);
    const float* skip = C.a->in[I_HSKIP] + l * 2048; bf16* y = (bf16*)(C.ws + WS_HA);
    const bf16* vch = uct + (size_t)c * NTOK + row0; const bf16* x1ch = uct + (size_t)(1024 + c) * NTOK + row0; const bf16* x2ch = uct + (size_t)(2048 + c) * NTOK + row0;
    __syncthreads();
    for (int t = C.tid; t < L; t += NTHR) su[t] = bf2f(vch[t]);
    for (int o = 0; o < 2; ++o) {
        const float* h = hf + (size_t)(o * 1024 + c) * L; const float sk = skip[o * 1024 + c];
        for (int i = C.tid; i < 2 * L; i += NTHR) { const int n = i - L / 2; sh[i] = (n >= 0 && n < L) ? h[n] : 0.f; }
        __syncthreads();
        const LAS float* in = o == 0 ? su : sz;
        if (C.tid < L / 8) {
            const int t0 = 8 * C.tid; float acc[8];
#pragma unroll
            for (int j = 0; j < 8; ++j) acc[j] = 0.f;
            for (int s8 = 0; s8 < L; s8 += 8) {
                const f32x4 ua = *(const LAS f32x4*)(in + s8), ub = *(const LAS f32x4*)(in + s8 + 4); const float uu[8] = {ua.x, ua.y, ua.z, ua.w, ub.x, ub.y, ub.z, ub.w};
                const LAS f32x4* hp = (const LAS f32x4*)(sh + (t0 - s8 + L - 8)); const f32x4 h0 = hp[0], h1 = hp[1], h2 = hp[2], h3 = hp[3];
                const float hh[16] = {h0.x, h0.y, h0.z, h0.w, h1.x, h1.y, h1.z, h1.w, h2.x, h2.y, h2.z, h2.w, h3.x, h3.y, h3.z, h3.w};
#pragma unroll
                for (int j = 0; j < 8; ++j)
#pragma unroll
                    for (int jj = 0; jj < 8; ++jj) acc[j] += uu[jj] * hh[8 + j - jj];
            }
            if (o == 0) {
#pragma unroll
                for (int j = 0; j < 8; ++j) { const int t = t0 + j; sz[t] = bf2f(x1ch[t]) * (acc[j] + sk * su[t]); }
            } else {
#pragma unroll
                for (int j = 0; j < 8; ++j) { const int t = t0 + j; y[(size_t)(row0 + t) * DM + 2048 + c] = (bf16)f2bf(bf2f(x2ch[t]) * (acc[j] + sk * sz[t])); }
            }
        }
        __syncthreads();
    }
}
__device__ __forceinline__ void c_transpose_chunk(const Ctx& C, int k) {
    LAS unsigned short* tile = (LAS unsigned short*)C.lds + C.wave * (64 * 72);
    const bf16* uct = (const bf16*)(C.ws + WS_UCT) + (size_t)1024 * NTOK; bf16* yy = (bf16*)(C.ws + WS_HA);
    { const int it = C.gw + k * C.NGW; if (it >= (NTOK / 64) * 16) return;
        const int tb = it >> 4, cbk = it & 15;
#pragma unroll
        for (int k = 0; k < 8; ++k) { const int id = C.lane + 64 * k, chw = id >> 3, part = id & 7; const v4u w = *(const v4u*)(uct + (size_t)(cbk * 64 + chw) * NTOK + tb * 64 + part * 8);
            *(LAS v4u*)(tile + chw * 72 + part * 8) = w; }
        LDS_WAIT(); asm volatile("" ::: "memory");
#pragma unroll
        for (int k = 0; k < 8; ++k) { const int id = C.lane + 64 * k, tok = id >> 3, cp = id & 7; unsigned short e[8];
#pragma unroll
            for (int j = 0; j < 8; ++j) e[j] = tile[(cp * 8 + j) * 72 + tok];
            v4u w; w.x = e[0] | ((unsigned)e[1] << 16); w.y = e[2] | ((unsigned)e[3] << 16); w.z = e[4] | ((unsigned)e[5] << 16); w.w = e[6] | ((unsigned)e[7] << 16);
            *(v4u*)(yy + (size_t)(tb * 64 + tok) * DM + 2048 + cbk * 64 + cp * 8) = w; }
        LDS_WAIT(); asm volatile("" ::: "memory");
    }
}
__device__ __forceinline__ void post_head(const Ctx& C, int l, int rb, int h) {
    const bf16* proj = (const bf16*)(C.ws + WS_PROJ); bf16* y = (bf16*)(C.ws + WS_HA); const bf16* dh = (const bf16*)(C.ws + WS_DH);
    const int col = h * 256 + 4 * C.lane; const f32x4 gv = *(const f32x4*)(C.a->in[I_MLNG] + l * 1024 + col);
#pragma nounroll
    for (int i = 0; i < 32; i += 4) {
        v2u a[4], b[4], o[4];
#pragma unroll
        for (int u = 0; u < 4; ++u) { const size_t row = (size_t)(rb + C.wave + 8 * (i + u));
            a[u] = *(const v2u*)(dh + row * 1024 + col); b[u] = *(const v2u*)(dh + (size_t)NTOK * 1024 + row * 1024 + col); o[u] = *(const v2u*)(proj + row * NPROJ + C_DO + col); }
#pragma unroll
        for (int u = 0; u < 4; ++u) { const size_t row = (size_t)(rb + C.wave + 8 * (i + u));
            const float h0 = bflo(a[u].x) + bflo(b[u].x), h1 = bfhi(a[u].x) + bfhi(b[u].x), h2 = bflo(a[u].y) + bflo(b[u].y), h3 = bfhi(a[u].y) + bfhi(b[u].y);
            const float ss = wave_sum((h0 * h0 + h1 * h1) + (h2 * h2 + h3 * h3));
            const float r = 1.0f / sqrtf(ss * (1.0f / 256.0f) + EPS);
            const float y0 = h0 * r * gv.x / (1.0f + __expf(-bflo(o[u].x))), y1 = h1 * r * gv.y / (1.0f + __expf(-bfhi(o[u].x))), y2 = h2 * r * gv.z / (1.0f + __expf(-bflo(o[u].y))), y3 = h3 * r * gv.w / (1.0f + __expf(-bfhi(o[u].y)));
            v2u w; w.x = pk2(y0, y1); w.y = pk2(y2, y3); *(v2u*)(y + row * DM + 3072 + col) = w; }
    }
}
__device__ __forceinline__ void phase_mix_d(const Ctx& C, int l) {
    const bf16* proj = (const bf16*)(C.ws + WS_PROJ); const float* gc = (const float*)(C.ws + WS_GCUM); bf16* dh = (bf16*)(C.ws + WS_DH);
    const bf16* cst = (const bf16*)(C.ws + WS_CST); const float* nstb = (const float*)(C.ws + WS_NST);
    LAS unsigned char* ldsg = C.lds;
    const int vcu = (C.G & 7) == 0 ? (C.bid & 7) * (C.G >> 3) + (C.bid >> 3) : C.bid;
    const int NI = ((NTOK / 64) * 16 + C.NGW - 1) / C.NGW; int kt = 0;
    for (int it2 = vcu; it2 < 512; it2 += C.G) {
        int sq, h, qb;
        { const int it = 2 * it2; if (it < 512) { sq = B_P + (it >> 7); h = (it >> 5) & 3; qb = (it >> 1) & 15; } else { const int r = it - 512; sq = r >> 6; h = (r >> 4) & 3; qb = (r >> 1) & 7; } }
        const int L = sq < B_P ? L_P : L_S, row0 = sq < B_P ? sq * L_P : TOK_P + (sq - B_P) * L_S, nc = L / 256; const bf16* base = proj + (size_t)row0 * NPROJ; const int q0 = qb * 256;
        for (int eh = 0; eh < 2; ++eh) {
            const bf16* Qb = base + (size_t)q0 * NPROJ + C_DQ + h * 256; const bf16* Kb = base + (size_t)q0 * NPROJ + C_DK + h * 256; const bf16* Vb = base + (size_t)q0 * NPROJ + C_DV + h * 256 + eh * 128;
            bf16* of = dh + (size_t)(row0 + q0) * 1024 + h * 256 + eh * 128;
            for (int dir = 0; dir < 2; ++dir) {
                const float* gcs = gc + (size_t)((2 * dir) * 4 + h) * NTOK + row0; const float* gls = gc + (size_t)((2 * dir + 1) * 4 + h) * NTOK + row0;
                const bool inter = dir == 0 ? (qb > 0) : (qb < nc - 1); const float gref = inter ? (dir == 0 ? gcs[q0 - 1] : gcs[q0 + 256]) : 0.f;
                const int st = ml_state_index(sq, h, dir, qb);
                att::flash_body<1, 256, NPROJ, NPROJ, NPROJ>(Qb, Kb, Vb, 4, 0, gcs + q0, gcs + q0, gls + q0, dir, inter ? cst + (size_t)st * 65536 + (size_t)(eh * 128) * 256 : nullptr, nstb + (size_t)st * 256, gref,
                                                             of + (size_t)dir * NTOK * 1024, 1024, ldsg, opaque_tid());
            }
            if (kt < NI) { const Ctx C2 = make_ctx(C.lds); c_transpose_chunk(C2, kt); ++kt; __syncthreads(); }
        }
        { const Ctx C2 = make_ctx(C.lds); post_head(C2, l, row0 + q0, h); }
    }
    for (; kt < NI; ++kt) { const Ctx C2 = make_ctx(C.lds); c_transpose_chunk(C2, kt); }
}
__device__ __forceinline__ void unit_decode(int u, int& sq, int& h, int& qb) { if (u < 512) { const int r = u; sq = B_P + (r >> 7); h = (r >> 4) & 7; qb = r & 15; } else { const int r = u - 512; sq = r >> 6; h = (r >> 3) & 7; qb = r & 7; } }
__device__ __forceinline__ void phase_mix_b(const Ctx& C, int l) {
    const bf16* proj = (const bf16*)(C.ws + WS_PROJ); bf16* y = (bf16*)(C.ws + WS_HA); LAS unsigned char* ldsg = C.lds;
    const int vcu = (C.G & 7) == 0 ? (C.bid & 7) * (C.G >> 3) + (C.bid >> 3) : C.bid;
    for (int it = vcu; it < 1024; it += C.G) {
        int sq, h, qb; unit_decode(it, sq, h, qb);
        const int L = sq < B_P ? L_P : L_S, row0 = sq < B_P ? sq * L_P : TOK_P + (sq - B_P) * L_S; const bf16* base = proj + (size_t)row0 * NPROJ; const int q0 = qb * 256;
        att::flash_body3<0, NPROJ, NPROJ, NPROJ>(base + (size_t)q0 * NPROJ + C_BQ + h * 128, base + C_BK + (h >> 2) * 128, base + C_BV + (h >> 2) * 128, L / 64, 0, y + (size_t)(row0 + q0) * DM + 1024 + h * 128, DM, ldsg, C.tid);
    }
}
__device__ __forceinline__ void phase_mix_a(const Ctx& C, int l) {
    const bf16* proj = (const bf16*)(C.ws + WS_PROJ); bf16* y = (bf16*)(C.ws + WS_HA); LAS unsigned char* ldsg = C.lds;
    const int vcu = (C.G & 7) == 0 ? (C.bid & 7) * (C.G >> 3) + (C.bid >> 3) : C.bid;
    for (int it = vcu; it < 1024; it += C.G) {
        int sq, h, qb; unit_decode(it, sq, h, qb);
        const int L = sq < B_P ? L_P : L_S, row0 = sq < B_P ? sq * L_P : TOK_P + (sq - B_P) * L_S; const bf16* base = proj + (size_t)row0 * NPROJ; const int q0 = qb * 256;
        const int klo = q0 - 1024 < 0 ? 0 : q0 - 1024, khi = q0 + 256 + 1024 > L ? L : q0 + 256 + 1024;
        att::flash_body3<2, NPROJ, NPROJ, NPROJ>(base + (size_t)q0 * NPROJ + C_AQ + h * 128, base + (size_t)klo * NPROJ + C_AK + h * 128, base + (size_t)klo * NPROJ + C_AV + h * 128, (khi - klo) / 64, klo - q0,
                                                     y + (size_t)(row0 + q0) * DM + h * 128, DM, ldsg, C.tid);
    }
}
__device__ __forceinline__ void phase_mix_c(const Ctx& C, int l) {
    unsigned* ctr = (unsigned*)(C.ws + WS_CTL) + CW_QUEUE + 64 * l; volatile LAS unsigned* slot = (volatile LAS unsigned*)(C.lds + LDSCTL_OFF + 64);
    for (;;) {
        __syncthreads();
        if (C.tid == 0) *slot = __hip_atomic_fetch_add(ctr, 1u, __ATOMIC_RELAXED, __HIP_MEMORY_SCOPE_AGENT);
        __syncthreads();
        const int it = (int)*slot;
        constexpr int NS_REST = (CV_ALL - CV_IN) / 64, NS_IN = CV_IN / 64;
        const int NC = NS_REST + (l == 0 ? NS_IN : 0), NT = 2048 + NC;
        if (it >= NT) break;
        const int cb = (it * NC) / NT, ca = ((it + 1) * NC) / NT, fi = it - cb;
        if (ca == cb) { const Ctx C2 = make_ctx(C.lds); hy::hyena_fft_unit(C2, l, fi & 1023, fi < 1024 ? 1 : 0); }
        else if (cb < NS_REST) { const Ctx C2 = make_ctx(C.lds); convert_super_item(C2, l, CV_IN + 64 * cb); }
        else { const Ctx C2 = make_ctx(C.lds); convert_super_item(C2, 1, 64 * (cb - NS_REST)); }
    }
    __syncthreads();
}
constexpr int NPH = 9, NPHASES = 2 * NPH + 1;
constexpr int R3 = 24576, R1 = NTOK - R3;
#define IN(k) ph_in(k)
#define SEAM(k) do { if (IN(k) && IN((k) + 1)) { XcdBarrier b_; b_.bar = (unsigned*)(ldargs()->ws + WS_CTL) + CW_BAR; b_.x = xb_xcc_id(); b_.st = MISC + 8; xcd_barrier(b_); } } while (0)
template <int l> __device__ __forceinline__ void layer_body(LAS unsigned char* lds, volatile LAS unsigned* MISC) {
        const int pb = l * NPH;
        if (IN(pb + 0)) {
            const Ctx C = make_ctx(lds); CArgs& args = *C.a; bf16* hA = (bf16*)(C.ws + WS_HA); float* out = args.out;
            if (l == 0) phase_convert_weights(C, 0, 0, CV_IN);
            if (l == 0) phase_rope_tables(C);
            phase_hyena_filters(C, l);
            if (l == 0) phase_rmsnorm_half<true>(C, args.in[I_XP], args.in[I_N1G], hA);
            (void)out;
        }
        SEAM(pb + 0);
        if (IN(pb + 1)) {
            const Ctx C = make_ctx(lds);
            {
                CArgs& args = *C.a; const float* nsrc = l == 0 ? args.in[I_XS] : args.out + (size_t)R3 * DM;
                pg8::Gemm g{(const bf16*)(C.ws + WS_HA), (const bf16*)(C.ws + WS_WIN), TOK_P, NPROJ, DM};
                SlotNormOrder<true, 2> S; S.init(TOK_P, NPROJ, C.G, C.bid); S.src = nsrc; S.g = args.in[I_N1G] + l * DM; S.dst = (bf16*)(C.ws + WS_HA) + (size_t)(l == 0 ? TOK_P : R3) * DM; S.nrows = l == 0 ? TOK_P : R1; S.gw = C.gw; S.ngw = C.NGW; S.lane = C.lane; S.k = 0;
                pg8::EpiProj E{(bf16*)(C.ws + WS_PROJ), NPROJ, (float*)(C.ws + WS_GATES), C_DG / 256};
                pg8::gemm_phase<pg8::EpiProj, SlotNormOrder<true, 2>, PG8_ALIGN, PG8_SP2>(lds, g, S, E);
                S.flush();
            }
            { XcdBarrier b_; b_.bar = (unsigned*)(ldargs()->ws + WS_CTL) + CW_BAR; b_.x = xb_xcc_id(); b_.st = MISC + 8; xcd_barrier(b_); }
            {   const Ctx C1 = make_ctx(lds); const size_t r0 = (size_t)TOK_P;
                pg8::Gemm g{(const bf16*)(C1.ws + WS_HA) + r0 * DM, (const bf16*)(C1.ws + WS_WIN), TOK_P, NPROJ, DM}; pg8::StaticOrder S; S.init(TOK_P, NPROJ, C1.G, C1.bid);
                pg8::EpiProj E{(bf16*)(C1.ws + WS_PROJ) + r0 * NPROJ, NPROJ, (float*)(C1.ws + WS_GATES) + r0 * 16, C_DG / 256};
                pg8::gemm_phase<pg8::EpiProj, pg8::StaticOrder, PG8_ALIGN, PG8_SP2>(lds, g, S, E);
            }
        }
        SEAM(pb + 1);
        if (IN(pb + 2)) { const Ctx C = make_ctx(lds); phase_prep(C, l); }
        SEAM(pb + 2);
        if (IN(pb + 3)) {
            { const Ctx C = make_ctx(lds); prep_mlstm_states(C, l); } { const Ctx C = make_ctx(lds); phase_mix_b(C, l); } { const Ctx C = make_ctx(lds); phase_mix_a(C, l); } { const Ctx C = make_ctx(lds); phase_mix_c(C, l); }
            { XcdBarrier b_; b_.bar = (unsigned*)(ldargs()->ws + WS_CTL) + CW_BAR; b_.x = xb_xcc_id(); b_.st = MISC + 8; xcd_barrier(b_); }
            { const Ctx C = make_ctx(lds); phase_mix_d(C, l); }
        }
        SEAM(pb + 3);
        if (IN(pb + 5)) {
            {   const Ctx C = make_ctx(lds); CArgs& args = *C.a; float* out = args.out;
                pg8::Gemm g{(const bf16*)(C.ws + WS_HA), (const bf16*)(C.ws + WS_WOUT), R3, DM, DM}; pg8::StaticOrder S; S.init(R3, DM, C.G, C.bid);
                pg8::EpiResid E{l == 0 ? args.in[I_XP] : out, l == 0 ? args.in[I_XS] : out + (size_t)TOK_P * DM, TOK_P, out, DM};
                pg8::gemm_phase<pg8::EpiResid, pg8::StaticOrder, PG8_ALIGN, PG8_SP2>(lds, g, S, E);
            }
            { XcdBarrier b_; b_.bar = (unsigned*)(ldargs()->ws + WS_CTL) + CW_BAR; b_.x = xb_xcc_id(); b_.st = MISC + 8; xcd_barrier(b_); }
            {
                const Ctx C = make_ctx(lds); CArgs& args = *C.a; float* out = args.out; const size_t r0 = (size_t)R3;
                pg8::Gemm g{(const bf16*)(C.ws + WS_HA) + r0 * DM, (const bf16*)(C.ws + WS_WOUT), R1, DM, DM};
                SlotNormOrder<true, 6> S; S.init(R1, DM, C.G, C.bid); S.src = out; S.g = args.in[I_N2G] + l * DM; S.dst = (bf16*)(C.ws + WS_HA); S.nrows = R3; S.gw = C.gw; S.ngw = C.NGW; S.lane = C.lane; S.k = 0;
                const float* base = l == 0 ? args.in[I_XS] + (size_t)(R3 - TOK_P) * DM : out + r0 * DM;
                pg8::EpiResid E{base, base, R1, out + r0 * DM, DM};
                pg8::gemm_phase<pg8::EpiResid, SlotNormOrder<true, 6>, PG8_ALIGN, PG8_SP2>(lds, g, S, E);
                S.flush();
            }
        }
        SEAM(pb + 5);
        if (IN(pb + 6)) { const Ctx C = make_ctx(lds); CArgs& args = *C.a; float* out = args.out;
            phase_rmsnorm_half<true>(C, out + (size_t)R3 * DM, args.in[I_N2G] + l * DM, (bf16*)(C.ws + WS_HA) + (size_t)R3 * DM, R1); }
        SEAM(pb + 6);
        if (IN(pb + 7)) {
            const Ctx C = make_ctx(lds);
            pg8::Gemm g{(const bf16*)(C.ws + WS_HA), (const bf16*)(C.ws + WS_WGU), NTOK, NGU, DM}; pg8::StaticOrder S; S.init(NTOK, NGU, C.G, C.bid);
            pg8::EpiGateUp E{(bf16*)(C.ws + WS_PROJ), FF};
            pg8::gemm_phase<pg8::EpiGateUp, pg8::StaticOrder, PG8_ALIGN, PG8_SP2>(lds, g, S, E);
        }
        SEAM(pb + 7);
        if (IN(pb + 8)) {
            {   const Ctx C = make_ctx(lds); float* out = C.a->out;
                pg8::Gemm g{(const bf16*)(C.ws + WS_PROJ), (const bf16*)(C.ws + WS_WDN), R3, DM, FF}; pg8::StaticOrder S; S.init(R3, DM, C.G, C.bid);
                pg8::EpiResid E{out, out, R3, out, DM};
                pg8::gemm_phase<pg8::EpiResid, pg8::StaticOrder, PG8_ALIGN, PG8_SP2>(lds, g, S, E);
            }
            { XcdBarrier b_; b_.bar = (unsigned*)(ldargs()->ws + WS_CTL) + CW_BAR; b_.x = xb_xcc_id(); b_.st = MISC + 8; xcd_barrier(b_); }
            {
                const Ctx C = make_ctx(lds); CArgs& args = *C.a; float* out = args.out; const size_t r0 = (size_t)R3;
                pg8::Gemm g{(const bf16*)(C.ws + WS_PROJ) + r0 * FF, (const bf16*)(C.ws + WS_WDN), R1, DM, FF};
                pg8::EpiResid E{out + r0 * DM, out + r0 * DM, R1, out + r0 * DM, DM};
                SlotNormOrder<l == 0, 6> S; S.init(R1, DM, C.G, C.bid); S.src = out; S.g = l == 0 ? args.in[I_N1G] + DM : args.in[I_FG]; S.dst = l == 0 ? (void*)(C.ws + WS_HA) : (void*)out; S.nrows = R3; S.gw = C.gw; S.ngw = C.NGW; S.lane = C.lane; S.k = 0;
                pg8::gemm_phase<pg8::EpiResid, SlotNormOrder<l == 0, 6>, PG8_ALIGN, PG8_SP2>(lds, g, S, E); S.flush();
            }
        }
        SEAM(pb + 8);
    }
__global__ void __launch_bounds__(NTHR, 2) fwd_kernel(Args args_by_value) {
    extern __shared__ __attribute__((aligned(16))) unsigned char lds_raw[];
    LAS unsigned char* lds = (LAS unsigned char*)lds_raw;
    for (int u = threadIdx.x; u < (LDS_BYTES - LDSCTL_OFF) / 4; u += NTHR) ((LAS unsigned*)(lds + LDSCTL_OFF))[u] = 0u;
    __syncthreads();
    volatile LAS unsigned* MISC = (volatile LAS unsigned*)(lds + MISC_OFF);
    (void)xcd_barrier_post((unsigned*)(ldargs()->ws + WS_CTL) + CW_BAR, MISC + 8);
    layer_body<0>(lds, MISC);
    layer_body<1>(lds, MISC);
    if (IN(2 * NPH)) { const Ctx C = make_ctx(lds); float* out = C.a->out + (size_t)R3 * DM; phase_rmsnorm_half<false>(C, out, C.a->in[I_FG], out, R1); }
#undef IN
#undef SEAM
}

#ifndef MK_PER_PHASE
#define MK_PER_PHASE 0
#endif
extern "C" void kernel_launch(void* const* d_in, const int* in_sizes, int n_in, void* d_out, int out_size, void* d_ws, size_t ws_size, hipStream_t stream) {
    static int grid = 0;
    if (grid == 0) {
        if (n_in != 24 || out_size != NTOK * DM || ws_size < WS_END) { fprintf(stderr, "kernel_launch: unexpected shapes: n_in %d out %d ws %zu (need %zu)\n", n_in, out_size, ws_size, (size_t)WS_END); grid = -1; return; }
        int dev = 0, cus = 0, per_cu = 0;
        if (hipGetDevice(&dev) != hipSuccess || hipDeviceGetAttribute(&cus, hipDeviceAttributeMultiprocessorCount, dev) != hipSuccess) { grid = -1; return; }
        if (hipFuncSetAttribute((const void*)fwd_kernel, hipFuncAttributeMaxDynamicSharedMemorySize, LDS_BYTES) != hipSuccess) { fprintf(stderr, "kernel_launch: hipFuncSetAttribute failed\n"); grid = -1; return; }
        if (hipOccupancyMaxActiveBlocksPerMultiprocessor(&per_cu, (const void*)fwd_kernel, NTHR, LDS_BYTES) != hipSuccess || per_cu < 1) fprintf(stderr, "kernel_launch: occupancy query reports %d\n", per_cu);
        (void)hipGetLastError();
        grid = cus;
    }
    if (grid < 0) return;
    (void)hipMemsetAsync((char*)d_ws + WS_CTL, 0, CTL_ZERO_BYTES, stream);
    Args a{};
    for (int i = 0; i < 24; ++i) a.in[i] = (const float*)d_in[i];
    a.out = (float*)d_out; a.ws = (unsigned char*)d_ws;
#if MK_PER_PHASE
    for (int k = 0; k < NPHASES; ++k) { a.ph_lo = k; a.ph_hi = k + 1; hipLaunchKernelGGL(fwd_kernel, dim3(grid), dim3(NTHR), LDS_BYTES, stream, a); }
#else
    a.ph_lo = 0; a.ph_hi = NPHASES;
    hipLaunchKernelGGL(fwd_kernel, dim3(grid), dim3(NTHR), LDS_BYTES, stream, a);
#endif
    const hipError_t le = hipPeekAtLastError();
    if (le != hipSuccess) fprintf(stderr, "kernel_launch: launch failed: %s\n", hipGetErrorName(le));
}
```

```cpp
#include <hip/hip_runtime.h>
#include <cstdio>
#include <cstdint>
#include <cmath>
namespace pg8 {
#define PG8_LAS __attribute__((address_space(3)))
typedef unsigned short bf16_t;
typedef short bf16x8 __attribute__((ext_vector_type(8)));
typedef float f32x4 __attribute__((ext_vector_type(4)));
typedef unsigned u32x4 __attribute__((ext_vector_type(4)));
constexpr int BM = 256, BK = 64, HALF = 128, HTB = HALF * BK * 2  , STAGE_BYTES = 8 * HTB, NXCD = 8, WGM = 8;

__host__ __device__ __forceinline__ int lds_byte(int r, int c) { const int st = (r >> 4) * 2 + (c >> 5), rr = r & 15, cc = c & 31, ob = rr * 64 + cc * 2; return st * 1024 + (ob ^ (((ob >> 9) & 1) << 5)); }
__host__ __device__ __forceinline__ void stage_rc(int b, int& R, int& C) { const int st = b / 1024, sb = b % 1024, swz = sb ^ (((sb >> 9) & 1) << 5); R = (st >> 1) * 16 + swz / 64; C = (st & 1) * 32 + (swz % 64) / 2; }
__host__ __device__ __forceinline__ int perm32(int rho) { const int n = rho >> 4, i = rho & 15; return 8 * (i >> 2) + 4 * n + (i & 3); }

struct Unit { int pm, pn; };
struct Gemm { const bf16_t* A; const bf16_t* Bt; int M, N, K; };

struct StaticOrder {
    int nM, nN, nwg, G, c;
    __host__ __device__ void init(int M, int N, int G_, int c_) { nM = M / BM; nN = N / BM; nwg = nM * nN; G = G_; c = c_; }
    __host__ __device__ bool next(int i, Unit& u) const {
        const long L = (long)i * G + c; if (L >= nwg) return false;
        int wgid = (int)L; { const int q = nwg / NXCD, r = nwg % NXCD, xcd = wgid % NXCD, off = wgid / NXCD; wgid = (xcd < r ? xcd * (q + 1) : r * (q + 1) + (xcd - r) * q) + off; }
        const int nig = WGM * nN, gid = wgid / nig, fm = gid * WGM, gsz = (nM - fm) < WGM ? (nM - fm) : WGM;
        u.pm = fm + ((wgid % nig) % gsz); u.pn = (wgid % nig) / gsz; return true;
    }
    __device__ __forceinline__ void a_ready(const Unit&) const {}
    __device__ __forceinline__ void done(const Unit&) const {}
};

__device__ __forceinline__ unsigned cvt_pk_bf16(float lo, float hi) { unsigned r; asm volatile("v_cvt_pk_bf16_f32 %0, %1, %2" : "=v"(r) : "v"(lo), "v"(hi)); return r; }
typedef float f32x2 __attribute__((ext_vector_type(2)));
struct EpiProj {
    static constexpr bool PERM = true, AFTER_DRAIN = false;
    bf16_t* O; int ldc; float* gates; int gate_pn;
    __device__ __forceinline__ void operator()(const f32x4 (&acc)[2][2][4][2], const Unit& u, int wr, int wc, int fr, int fq) const {
        const int row0 = u.pm * BM + wr * 64 + fr, col0 = u.pn * BM + wc * 32 + 8 * fq;
#pragma unroll
        for (int ai = 0; ai < 2; ++ai)
#pragma unroll
            for (int m = 0; m < 4; ++m) { bf16_t* rowp = O + (size_t)(row0 + ai * HALF + m * 16) * ldc + col0;
#pragma unroll
                for (int bj = 0; bj < 2; ++bj) { const f32x4 v0 = acc[ai][bj][m][0], v1 = acc[ai][bj][m][1];
                    u32x4 w; w.x = cvt_pk_bf16(v0[0], v0[1]); w.y = cvt_pk_bf16(v0[2], v0[3]); w.z = cvt_pk_bf16(v1[0], v1[1]); w.w = cvt_pk_bf16(v1[2], v1[3]);
                    *(u32x4*)(rowp + bj * HALF) = w; } }
        if (u.pn == gate_pn && wc == 0 && fq < 2) {
#pragma unroll
            for (int ai = 0; ai < 2; ++ai)
#pragma unroll
                for (int m = 0; m < 4; ++m) { float* gp = gates + (size_t)(row0 + ai * HALF + m * 16) * 16 + 8 * fq;
                    *(f32x4*)(gp) = acc[ai][0][m][0]; *(f32x4*)(gp + 4) = acc[ai][0][m][1]; }
        }
    }
};
struct EpiResid {
    static constexpr bool PERM = false, AFTER_DRAIN = false;
    const float* base_lo; const float* base_hi; int split; float* out; int ldc;
    __device__ __forceinline__ void operator()(const f32x4 (&acc)[2][2][4][2], const Unit& u, int wr, int wc, int fr, int fq) const {
        const int row0 = u.pm * BM + wr * 64 + fr, col0 = u.pn * BM + wc * 32 + 4 * fq;
#pragma unroll
        for (int ai = 0; ai < 2; ++ai)
#pragma unroll
            for (int m = 0; m < 4; ++m) { const int row = row0 + ai * HALF + m * 16;
                const float* bp = (row < split ? base_lo + (size_t)row * ldc : base_hi + (size_t)(row - split) * ldc) + col0; float* op = out + (size_t)row * ldc + col0;
#pragma unroll
                for (int bj = 0; bj < 2; ++bj)
#pragma unroll
                    for (int n = 0; n < 2; ++n) *(f32x4*)(op + bj * HALF + n * 16) = *(const f32x4*)(bp + bj * HALF + n * 16) + acc[ai][bj][m][n]; }
    }
};
__device__ __forceinline__ float silu_mul(float g, float u) { const float e = __builtin_amdgcn_exp2f(-1.4426950408889634f * g); return g * __builtin_amdgcn_rcpf(1.0f + e) * u; }
struct EpiGateUp {
    static constexpr bool PERM = true, AFTER_DRAIN = false;
    bf16_t* H; int ldc;
    __device__ __forceinline__ void operator()(const f32x4 (&acc)[2][2][4][2], const Unit& u, int wr, int wc, int fr, int fq) const {
        const int row0 = u.pm * BM + wr * 64 + fr, col0 = u.pn * HALF + wc * 32 + 8 * fq;
#pragma unroll
        for (int ai = 0; ai < 2; ++ai)
#pragma unroll
            for (int m = 0; m < 4; ++m) { bf16_t* rowp = H + (size_t)(row0 + ai * HALF + m * 16) * ldc + col0;
                const f32x4 g0 = acc[ai][0][m][0], g1 = acc[ai][0][m][1], u0 = acc[ai][1][m][0], u1 = acc[ai][1][m][1];
                u32x4 w; w.x = cvt_pk_bf16(silu_mul(g0[0], u0[0]), silu_mul(g0[1], u0[1])); w.y = cvt_pk_bf16(silu_mul(g0[2], u0[2]), silu_mul(g0[3], u0[3]));
                w.z = cvt_pk_bf16(silu_mul(g1[0], u1[0]), silu_mul(g1[1], u1[1])); w.w = cvt_pk_bf16(silu_mul(g1[2], u1[2]), silu_mul(g1[3], u1[3]));
                *(u32x4*)(rowp) = w; }
    }
};
template <class Epi, class Sched, bool ALIGN_EPI = false, bool SP2 = false>
__device__ __forceinline__ void gemm_phase(PG8_LAS unsigned char* lds, const Gemm g, const Sched& S, const Epi& E) {
    int tid_ = threadIdx.x; asm volatile("" : "+v"(tid_)); const int tid = tid_, wid = __builtin_amdgcn_readfirstlane(tid >> 6), lane = tid & 63, wr = wid >> 2, wc = wid & 3, fr = lane & 15, fq = lane >> 4;
    const int K = g.K, nt = K / BK;
    unsigned voffA[2], voffB[2];
#pragma unroll
    for (int i = 0; i < 2; ++i) { int R, C; stage_rc(tid * 16 + i * 8192, R, C); const int Rb = Epi::PERM ? ((R & ~31) + perm32(R & 31)) : R;
        voffA[i] = (unsigned)(R * K + C) * 2u; voffB[i] = (unsigned)(Rb * K + C) * 2u; }
    const size_t kstep = (size_t)(BK * 2);
    const size_t hstep = (size_t)HALF * K * 2;
    const size_t tstep = 2 * hstep;
    const unsigned ldsw = (unsigned)wid * 1024u;
    const int aoff = lds_byte(wr * 64 + fr, fq * 8), boff = lds_byte(wc * 32 + fr, fq * 8);
#define PG8_SA(b, h) (((b) * 2 + (h)) * HTB)
#define PG8_SB(b, h) ((4 + (b) * 2 + (h)) * HTB)
#define PG8_STAGE(bufoff, gbase, voff) do { _Pragma("unroll") for (int _i = 0; _i < 2; ++_i) \
        __builtin_amdgcn_global_load_lds((const unsigned*)((const char*)(gbase) + (voff)[_i]), (PG8_LAS unsigned*)(lds + (bufoff) + ldsw + _i * 8192), 16, 0, 0); } while (0)
#define PG8_LDA(dst, b, h) do { _Pragma("unroll") for (int m = 0; m < 4; ++m) _Pragma("unroll") for (int k = 0; k < 2; ++k) dst[m][k] = *(const PG8_LAS bf16x8*)(lds + PG8_SA(b, h) + aoff + m * 2048 + k * 1024); } while (0)
#define PG8_LDB(dst, b, h) do { _Pragma("unroll") for (int n = 0; n < 2; ++n) _Pragma("unroll") for (int k = 0; k < 2; ++k) dst[n][k] = *(const PG8_LAS bf16x8*)(lds + PG8_SB(b, h) + boff + n * 2048 + k * 1024); } while (0)
#define PG8_MMA(ai, bj, At, Bt) do { __builtin_amdgcn_s_setprio(1); _Pragma("unroll") for (int m = 0; m < 4; ++m) _Pragma("unroll") for (int n = 0; n < 2; ++n) _Pragma("unroll") for (int k = 0; k < 2; ++k) \
        acc[ai][bj][m][n] = __builtin_amdgcn_mfma_f32_16x16x32_bf16(Bt[n][k], At[m][k], acc[ai][bj][m][n], 0, 0, 0); __builtin_amdgcn_s_setprio(0); } while (0)
#define PG8_WAIT_V(n) asm volatile("s_waitcnt vmcnt(" #n ")" ::: "memory")
#define PG8_WAIT_L(n) asm volatile("s_waitcnt lgkmcnt(" #n ")" ::: "memory")
#define PG8_BAR __builtin_amdgcn_s_barrier()
#define PG8_SCHED __builtin_amdgcn_sched_barrier(0)
    Unit cur, nxt; int ui = 0;
    if (!S.next(0, cur)) return;
    f32x4 acc[2][2][4][2];
#pragma unroll
    for (int a = 0; a < 2; ++a)
#pragma unroll
        for (int b = 0; b < 2; ++b)
#pragma unroll
            for (int m = 0; m < 4; ++m)
#pragma unroll
                for (int n = 0; n < 2; ++n) acc[a][b][m][n] = (f32x4){0.f, 0.f, 0.f, 0.f};
    bf16x8 At[4][2], B0[2][2], B1[2][2];
    const char* cA = (const char*)g.A + (size_t)cur.pm * tstep; const char* cB = (const char*)g.Bt + (size_t)cur.pn * tstep;
    S.a_ready(cur);
    if constexpr (SP2) {
        PG8_STAGE(PG8_SB(0, 0), cB, voffB); PG8_STAGE(PG8_SB(0, 1), cB + hstep, voffB); PG8_STAGE(PG8_SA(0, 0), cA, voffA); PG8_STAGE(PG8_SA(0, 1), cA + hstep, voffA);
        if (wr == 1) PG8_BAR;
        PG8_WAIT_V(2); PG8_BAR;
        PG8_STAGE(PG8_SB(1, 0), cB + kstep, voffB); PG8_STAGE(PG8_SA(1, 0), cA + kstep, voffA); PG8_STAGE(PG8_SB(1, 1), cB + hstep + kstep, voffB);
        PG8_WAIT_V(6); PG8_BAR;
    } else {
        PG8_STAGE(PG8_SB(0, 0), cB, voffB); PG8_STAGE(PG8_SA(0, 0), cA, voffA); PG8_STAGE(PG8_SB(0, 1), cB + hstep, voffB); PG8_STAGE(PG8_SA(0, 1), cA + hstep, voffA);
        if (wr == 1) PG8_BAR;
        PG8_WAIT_V(4); PG8_BAR;
        PG8_STAGE(PG8_SB(1, 0), cB + kstep, voffB); PG8_STAGE(PG8_SA(1, 0), cA + kstep, voffA); PG8_STAGE(PG8_SB(1, 1), cB + hstep + kstep, voffB);
        PG8_WAIT_V(6); PG8_BAR;
    }
    for (;;) {
        const bool has_next = S.next(ui + 1, nxt);
        const char* nA = has_next ? (const char*)g.A + (size_t)nxt.pm * tstep : cA; const char* nB = has_next ? (const char*)g.Bt + (size_t)nxt.pn * tstep : cB;
        for (int t = 0; t < nt; t += 2) {
            const bool last = (t == nt - 2);
            const char* a1 = cA + (size_t)(t + 1) * kstep;
            const char* a2 = last ? nA : cA + (size_t)(t + 2) * kstep; const char* b2 = last ? nB : cB + (size_t)(t + 2) * kstep;
            const char* a3 = a2 + kstep; const char* b3 = b2 + kstep;
            if (last && has_next) S.a_ready(nxt);
            if constexpr (SP2) {
            PG8_LDB(B0, 0, 0); PG8_LDB(B1, 0, 1); PG8_SCHED; PG8_LDA(At, 0, 0); PG8_STAGE(PG8_SA(1, 1), a1 + hstep, voffA);
            PG8_WAIT_V(8); PG8_WAIT_L(0); PG8_BAR; PG8_MMA(0, 0, At, B0); PG8_MMA(0, 1, At, B1); PG8_BAR; PG8_SCHED;
            PG8_LDA(At, 0, 1); PG8_STAGE(PG8_SB(0, 0), b2, voffB); PG8_STAGE(PG8_SB(0, 1), b2 + hstep, voffB); PG8_STAGE(PG8_SA(0, 0), a2, voffA);
            PG8_WAIT_V(8); PG8_WAIT_L(0); PG8_BAR; PG8_MMA(1, 0, At, B0); PG8_MMA(1, 1, At, B1); PG8_BAR; PG8_SCHED;
            PG8_LDB(B0, 1, 0); PG8_LDB(B1, 1, 1); PG8_SCHED; PG8_LDA(At, 1, 0); PG8_STAGE(PG8_SA(0, 1), a2 + hstep, voffA);
            PG8_WAIT_V(8); PG8_WAIT_L(0); PG8_BAR; PG8_MMA(0, 0, At, B0); PG8_MMA(0, 1, At, B1); PG8_BAR; PG8_SCHED;
            PG8_LDA(At, 1, 1); PG8_STAGE(PG8_SB(1, 0), b3, voffB); PG8_STAGE(PG8_SB(1, 1), b3 + hstep, voffB); PG8_STAGE(PG8_SA(1, 0), a3, voffA);
            PG8_WAIT_V(8); PG8_WAIT_L(0); PG8_BAR; PG8_MMA(1, 0, At, B0); PG8_MMA(1, 1, At, B1); PG8_BAR; PG8_SCHED;
            } else {
            PG8_LDB(B0, 0, 0); PG8_SCHED; PG8_LDA(At, 0, 0); PG8_STAGE(PG8_SA(1, 1), a1 + hstep, voffA);
            PG8_WAIT_L(8); PG8_BAR; PG8_WAIT_L(0); PG8_MMA(0, 0, At, B0); PG8_BAR; PG8_SCHED;
            PG8_LDB(B1, 0, 1); PG8_STAGE(PG8_SB(0, 0), b2, voffB);
            PG8_BAR; PG8_WAIT_L(0); PG8_MMA(0, 1, At, B1); PG8_BAR;
            PG8_LDA(At, 0, 1); PG8_STAGE(PG8_SA(0, 0), a2, voffA);
            PG8_BAR; PG8_WAIT_L(0); PG8_MMA(1, 0, At, B0); PG8_BAR; PG8_SCHED;
            PG8_STAGE(PG8_SB(0, 1), b2 + hstep, voffB);
            PG8_WAIT_V(6); PG8_BAR; PG8_MMA(1, 1, At, B1); PG8_BAR;
            PG8_LDB(B0, 1, 0); PG8_SCHED; PG8_LDA(At, 1, 0); PG8_STAGE(PG8_SA(0, 1), a2 + hstep, voffA);
            PG8_WAIT_L(8); PG8_BAR; PG8_WAIT_L(0); PG8_MMA(0, 0, At, B0); PG8_BAR; PG8_SCHED;
            PG8_LDB(B1, 1, 1); PG8_STAGE(PG8_SB(1, 0), b3, voffB);
            PG8_BAR; PG8_WAIT_L(0); PG8_MMA(0, 1, At, B1); PG8_BAR;
            PG8_LDA(At, 1, 1); PG8_STAGE(PG8_SA(1, 0), a3, voffA);
            PG8_BAR; PG8_WAIT_L(0); PG8_MMA(1, 0, At, B0); PG8_BAR; PG8_SCHED;
            PG8_STAGE(PG8_SB(1, 1), b3 + hstep, voffB);
            PG8_WAIT_V(6); PG8_BAR; PG8_MMA(1, 1, At, B1); PG8_BAR;
            }
        }
        if constexpr (ALIGN_EPI) { if (wr == 0) PG8_BAR; }
        if constexpr (!Epi::AFTER_DRAIN) { E(acc, cur, wr, wc, fr, fq); S.done(cur); }
        if (!has_next) break;
#pragma unroll
        for (int a = 0; a < 2; ++a)
#pragma unroll
            for (int b = 0; b < 2; ++b)
#pragma unroll
                for (int m = 0; m < 4; ++m)
#pragma unroll
                    for (int n = 0; n < 2; ++n) acc[a][b][m][n] = (f32x4){0.f, 0.f, 0.f, 0.f};
        cur = nxt; cA = nA; cB = nB; ++ui;
        if constexpr (ALIGN_EPI) { if (wr == 1) PG8_BAR; }
    }
    PG8_WAIT_V(0);
    if constexpr (!ALIGN_EPI) { if (wr == 0) PG8_BAR; }
    PG8_BAR;
    if constexpr (Epi::AFTER_DRAIN) { E.fused(acc, cur, wr, wc, fr, fq, lds, wid, lane); S.done(cur); }
#undef PG8_SA
#undef PG8_SB
#undef PG8_STAGE
#undef PG8_LDA
#undef PG8_LDB
#undef PG8_MMA
#undef PG8_WAIT_V
#undef PG8_WAIT_L
#undef PG8_BAR
#undef PG8_SCHED
}
}
#ifndef PG8_SP2
#define PG8_SP2 true
#endif
#ifndef PG8_ALIGN
#define PG8_ALIGN true
#endif
constexpr int DM = 4096, NTOK = 32768, TOK_P = 16384, L_P = 2048, L_S = 4096, B_P = 8, B_S = 4;
constexpr int NPROJ = 12032, N_IN = 11792, FF = 11008, NGU = 2 * FF;
constexpr int C_AQ = 0, C_AK = 1024, C_AV = 2048, C_BQ = 3072, C_BK = 4096, C_BV = 4352, C_CU = 4608, C_DQ = 7680, C_DK = 8704, C_DV = 9728, C_DO = 10752, C_DG = 11776;
constexpr float EPS = 1e-6f;
constexpr int NWAVES = 8, NTHR = 512;
constexpr size_t al256(size_t x) { return (x + 255) / 256 * 256; }
constexpr size_t WS_CTL = 0, CTL_ZERO_BYTES = 1u << 20;
constexpr size_t WS_WIN = CTL_ZERO_BYTES;
constexpr size_t WS_WOUT = WS_WIN + (size_t)NPROJ * DM * 2;
constexpr size_t WS_WGU = WS_WOUT + (size_t)DM * DM * 2;
constexpr size_t WS_WDN = WS_WGU + (size_t)NGU * DM * 2;
constexpr size_t WS_HA = WS_WDN + (size_t)DM * FF * 2;
constexpr size_t WS_PROJ = WS_HA + (size_t)NTOK * DM * 2;
constexpr size_t WS_GATES = WS_PROJ + (size_t)NTOK * NPROJ * 2;
constexpr size_t WS_GCUM = WS_GATES + (size_t)NTOK * 16 * 4;
constexpr size_t WS_ROPE = WS_GCUM + (size_t)NTOK * 16 * 4;
constexpr size_t WS_HFIL = WS_ROPE + al256((size_t)(2 * 4096 * 16 + 2 * 64 * 32) * 4);
constexpr size_t WS_UCT = WS_HFIL + (size_t)2048 * (2048 + 4096) * 4;
constexpr size_t WS_DH = WS_UCT + (size_t)3072 * NTOK * 2;
constexpr size_t WS_CST = WS_DH + (size_t)2 * NTOK * 1024 * 2;
constexpr size_t WS_NST = WS_CST + (size_t)1024 * 65536 * 2;
constexpr size_t WS_HSP = WS_NST + (size_t)1024 * 256 * 4;
constexpr size_t WS_END = WS_HSP + (size_t)512 * 131072;
constexpr int CW_BAR = 4096;
constexpr int CW_QUEUE = 16384;

constexpr int RING_BYTES = 131072, LDS_BYTES = 147456, LDSCTL_OFF = LDS_BYTES - 1024, MISC_OFF = LDSCTL_OFF + 320;

#define LAS __attribute__((address_space(3)))
typedef unsigned short bf16;
typedef unsigned v4u __attribute__((ext_vector_type(4)));
typedef unsigned v2u __attribute__((ext_vector_type(2)));
typedef float f32x4 __attribute__((ext_vector_type(4)));
#define LDS_WAIT() asm volatile("s_waitcnt lgkmcnt(0)" ::: "memory")
__device__ __forceinline__ unsigned f2bf(float f) { unsigned u = __builtin_bit_cast(unsigned, f); return (u + 0x7fffu + ((u >> 16) & 1u)) >> 16; }
__device__ __forceinline__ unsigned pk2(float lo, float hi) { return f2bf(lo) | (f2bf(hi) << 16); }
__device__ __forceinline__ float bf2f(unsigned short b) { return __builtin_bit_cast(float, (unsigned)b << 16); }
__device__ __forceinline__ float bflo(unsigned w) { return __builtin_bit_cast(float, w << 16); }
__device__ __forceinline__ float bfhi(unsigned w) { return __builtin_bit_cast(float, w & 0xffff0000u); }
__device__ __forceinline__ float wave_sum(float v) {
#pragma unroll
    for (int o = 1; o < 64; o <<= 1) v += __shfl_xor(v, o);
    return v;
}
__device__ __forceinline__ void sincos_rev(double rev, float& s, float& c) { const float f = (float)(rev - rint(rev)); s = __builtin_amdgcn_sinf(f); c = __builtin_amdgcn_cosf(f); }
__device__ const double INV_ROPE[16] = {1.0, 0.44036660267178046, 0.19392274474868576, 0.08539710028576561, 0.03760603093086393, 0.016560440080994446, 0.007292664737217109, 0.003211445994752591, 0.001414213562373095, 0.000622772421914596, 0.0002742481756762073, 0.00012076973741146504, 5.318295896944988e-05, 2.341999896140934e-05, 1.031338537721246e-05, 4.5416704806078695e-06};
__device__ const double INV_AX[32] = {1.0, 0.7498942093324559, 0.5623413251903491, 0.4216965034285822, 0.31622776601683794, 0.23713737056616552, 0.1778279410038923, 0.1333521432163324, 0.1, 0.07498942093324558, 0.05623413251903491, 0.042169650342858224, 0.03162277660168379, 0.023713737056616554, 0.01778279410038923, 0.01333521432163324, 0.01, 0.007498942093324558, 0.005623413251903491, 0.004216965034285823, 0.0031622776601683794, 0.0023713737056616554, 0.0017782794100389228, 0.001333521432163324, 0.001, 0.0007498942093324559, 0.0005623413251903491, 0.00042169650342858224, 0.00031622776601683794, 0.00023713737056616554, 0.00017782794100389227, 0.0001333521432163324};
#define XB_TMO      128
#define XB_XCNT(j)  (256  + 64 * (j))
#define XB_XSUB(j)  (1280 + 64 * (j))
#define XB_XGEN(j)  (2304 + 64 * (j))
#define XB_TOP      3328
#define XB_TOPGEN   3392
#define XCD_BAR_WORDS 3456
#define XB_SPIN_CAP (1u << 22)

__device__ __forceinline__ unsigned xb_ld(unsigned* p)              { return __hip_atomic_load(p, __ATOMIC_RELAXED, __HIP_MEMORY_SCOPE_AGENT); }
__device__ __forceinline__ unsigned xb_add(unsigned* p, unsigned v) { return __hip_atomic_fetch_add(p, v, __ATOMIC_RELAXED, __HIP_MEMORY_SCOPE_AGENT); }
__device__ __forceinline__ unsigned xb_xcc_id() { return (unsigned)__builtin_amdgcn_s_getreg((3 << 11) | 20) & 0xFu; }
#define XB_SPIN(cond, bar) do { unsigned _sp = 0; while (cond) { __builtin_amdgcn_s_sleep(1); \
    if ((++_sp & 255u) == 0u) { if (xb_ld(&(bar)[XB_TMO])) break; if (_sp > XB_SPIN_CAP) { atomicAdd(&(bar)[XB_TMO], 1u); break; } } } } while (0)

struct XcdBarrier {
    unsigned* bar; unsigned x;
    volatile LAS unsigned* st;
};

__device__ __forceinline__ XcdBarrier xcd_barrier_post(unsigned* bar, volatile LAS unsigned* st) {
    XcdBarrier b; b.bar = bar; b.x = xb_xcc_id(); b.st = st;
    if (threadIdx.x == 0) (void)xb_add(&bar[XB_XCNT(b.x)], 1u);
    return b;
}
__device__ __forceinline__ void xcd_barrier_complete(unsigned* bar, unsigned x, unsigned& nloc, unsigned& nx) {
    const unsigned G = gridDim.x * gridDim.y * gridDim.z;
    asm volatile("" : "+s"(x));
    unsigned sum, cnt, mine, sp = 0u;
    for (;;) {
        sum = 0u; cnt = 0u; mine = 0u;
#pragma unroll
        for (unsigned j = 0; j < 16; ++j) { const unsigned c = xb_ld(&bar[XB_XCNT(j)]); sum += c; cnt += (c > 0u) ? 1u : 0u; mine = (j == x) ? c : mine; }
        if (sum == G) break;
        __builtin_amdgcn_s_sleep(1);
        if ((++sp & 255u) == 0u) { if (xb_ld(&bar[XB_TMO])) break; if (sp > XB_SPIN_CAP) { atomicAdd(&bar[XB_TMO], 1u); break; } }
    }
    nloc = mine > 0u ? mine : 1u; nx = cnt > 0u ? cnt : 1u;
}

__device__ __forceinline__ void xcd_barrier(const XcdBarrier& b) {
    asm volatile("s_waitcnt vmcnt(0)" ::: "memory");
    __syncthreads();
    if (threadIdx.x == 0) {
        unsigned* bar = b.bar; asm volatile("" : "+s"(bar));
        __builtin_amdgcn_s_waitcnt(0);
        unsigned nloc = b.st[0], nx = b.st[1];
        if (nloc == 0u) { xcd_barrier_complete(bar, b.x, nloc, nx); b.st[0] = nloc; b.st[1] = nx; }
        const unsigned old = xb_add(&bar[XB_XSUB(b.x)], 1u);
        const unsigned gen = old / nloc;
        if (old + 1u == (gen + 1u) * nloc) {
            __builtin_amdgcn_fence(__ATOMIC_RELEASE, "agent");
            asm volatile("s_waitcnt vmcnt(0)" ::: "memory");
            const unsigned og = xb_add(&bar[XB_TOP], 1u);
            const unsigned tg = og / nx;
            if (og + 1u == (tg + 1u) * nx) xb_add(&bar[XB_TOPGEN], 1u);
            else XB_SPIN(xb_ld(&bar[XB_TOPGEN]) == tg, bar);
            __builtin_amdgcn_fence(__ATOMIC_ACQUIRE, "agent");
            xb_add(&bar[XB_XGEN(b.x)], 1u);
            asm volatile("s_waitcnt vmcnt(0)" ::: "memory");
        } else {
            XB_SPIN(xb_ld(&bar[XB_XGEN(b.x)]) == gen, bar);
            __builtin_amdgcn_fence(__ATOMIC_ACQUIRE, "agent");
            asm volatile("s_waitcnt vmcnt(0)" ::: "memory");
        }
    }
    __syncthreads();
}
struct Args { const float* in[24]; float* out; unsigned char* ws; int ph_lo, ph_hi; };
enum { I_XP = 0, I_XS, I_N1G, I_WIN, I_QKG, I_HCW, I_HCB, I_HW1, I_HB1, I_HF1, I_HW2, I_HB2, I_HF2, I_HW3, I_HDEC, I_HSKIP, I_MLGB, I_MLNG, I_WOUT, I_N2G, I_WG, I_WU, I_WD, I_FG };

struct Ctx {
    LAS unsigned char* lds; int tid, lane, wave, gw, NGW, bid, G;
    unsigned char* ws; const __attribute__((address_space(4))) Args* a;
};
__device__ __forceinline__ int opaque_tid() { int t = threadIdx.x; asm volatile("" : "+v"(t)); return t; }
typedef const __attribute__((address_space(4))) Args CArgs;
__device__ __forceinline__ CArgs* ldargs() { CArgs* ap = (CArgs*)__builtin_amdgcn_kernarg_segment_ptr(); asm volatile("" : "+s"(ap)); return ap; }
__device__ __forceinline__ bool ph_in(int k) { CArgs* ap = ldargs(); return ap->ph_lo <= k && k < ap->ph_hi; }
__device__ __forceinline__ Ctx make_ctx(LAS unsigned char* lds) {
    CArgs* ap = ldargs();
    Ctx C; C.lds = lds; C.tid = opaque_tid(); C.lane = C.tid & 63; C.wave = __builtin_amdgcn_readfirstlane(C.tid >> 6);
    int bid = blockIdx.x, G = gridDim.x; asm volatile("" : "+s"(bid), "+s"(G)); C.bid = bid; C.G = G; C.gw = C.bid * NWAVES + C.wave; C.NGW = C.G * NWAVES; C.ws = ap->ws; C.a = ap;
    return C;
}
__device__ __forceinline__ int seq_pos(int row) { return row < TOK_P ? (row & (L_P - 1)) : ((row - TOK_P) & (L_S - 1)); }

__device__ __forceinline__ void tr_item(const float* W, int K, int N, bf16* WT, int dst_row0, int k0, int n0, LAS float* scr, int lane) {
    const int n = n0 + lane; const bool ok = n < N; const float* wp = W + (size_t)k0 * N + n;
    float v[64];
#pragma unroll
    for (int i = 0; i < 64; ++i) v[i] = ok ? __builtin_nontemporal_load(wp + (size_t)i * N) : 0.f;
#pragma unroll
    for (int i = 0; i < 64; ++i) scr[i * 65 + lane] = v[i];
    LDS_WAIT(); asm volatile("" ::: "memory");
    const int c = lane & 7;
#pragma unroll
    for (int j = 0; j < 8; ++j) { const int nn = (lane >> 3) + 8 * j; const LAS float* s = scr + (8 * c) * 65 + nn;
        v4u o; o.x = pk2(s[0 * 65], s[1 * 65]); o.y = pk2(s[2 * 65], s[3 * 65]); o.z = pk2(s[4 * 65], s[5 * 65]); o.w = pk2(s[6 * 65], s[7 * 65]);
        *(v4u*)(WT + (size_t)(dst_row0 + nn) * K + k0 + 8 * c) = o; }
    LDS_WAIT(); asm volatile("" ::: "memory");
}
constexpr int CV_KB = DM / 64, CV_IN = CV_KB * (NPROJ / 64), CV_OUT = CV_KB * (DM / 64), CV_G = CV_KB * (FF / 64), CV_D = (FF / 64) * (DM / 64), CV_ALL = CV_IN + CV_OUT + 2 * CV_G + CV_D;
__device__ __forceinline__ void convert_item(const Ctx& C, int l, int it, LAS float* scr) {
    const float* Win = C.a->in[I_WIN] + (size_t)l * DM * N_IN; const float* Wout = C.a->in[I_WOUT] + (size_t)l * DM * DM;
    const float* Wg = C.a->in[I_WG] + (size_t)l * DM * FF; const float* Wu = C.a->in[I_WU] + (size_t)l * DM * FF; const float* Wd = C.a->in[I_WD] + (size_t)l * FF * DM;
    bf16* WinT = (bf16*)(C.ws + WS_WIN); bf16* WoutT = (bf16*)(C.ws + WS_WOUT); bf16* WguT = (bf16*)(C.ws + WS_WGU); bf16* WdT = (bf16*)(C.ws + WS_WDN);
    int r = it;
    if (r < CV_IN) { const int nb = NPROJ / 64, kb = r / nb, n0 = 64 * (r % nb); tr_item(Win, DM, N_IN, WinT, n0, 64 * kb, n0, scr, C.lane); return; } r -= CV_IN;
    if (r < CV_OUT) { const int nb = DM / 64, kb = r / nb, n0 = 64 * (r % nb); tr_item(Wout, DM, DM, WoutT, n0, 64 * kb, n0, scr, C.lane); return; } r -= CV_OUT;
    if (r < CV_G) { const int nb = FF / 64, kb = r / nb, n0 = 64 * (r % nb); tr_item(Wg, DM, FF, WguT, 256 * (n0 >> 7) + (n0 & 127), 64 * kb, n0, scr, C.lane); return; } r -= CV_G;
    if (r < CV_G) { const int nb = FF / 64, kb = r / nb, n0 = 64 * (r % nb); tr_item(Wu, DM, FF, WguT, 256 * (n0 >> 7) + 128 + (n0 & 127), 64 * kb, n0, scr, C.lane); return; } r -= CV_G;
    { const int nb = DM / 64, kb = r / nb, n0 = 64 * (r % nb); tr_item(Wd, FF, DM, WdT, n0, 64 * kb, n0, scr, C.lane); }
}
__device__ __forceinline__ void phase_convert_weights(const Ctx& C, int l, int lo, int hi) {
    LAS float* scr = (LAS float*)(C.lds + C.wave * 16640);
    for (int it = lo + C.gw; it < hi; it += C.NGW) convert_item(C, l, it, scr);
}
__device__ __forceinline__ void convert_super_item(const Ctx& C, int l, int base) {
    LAS float* scr = (LAS float*)(C.lds + C.wave * 16640);
    for (int j = 0; j < 8; ++j) convert_item(C, l, base + 8 * j + C.wave, scr);
}
__device__ __forceinline__ void phase_rope_tables(const Ctx& C) {
    float* cosA = (float*)(C.ws + WS_ROPE); float* sinA = cosA + 4096 * 16; float* cosX = sinA + 4096 * 16; float* sinX = cosX + 64 * 32;
    const double inv2pi = 0.15915494309189533577;
    for (int i = C.bid * NTHR + C.tid; i < 4096 * 16 + 64 * 32; i += C.G * NTHR) {
        float s, c;
        if (i < 4096 * 16) { const int t = i >> 4, k = i & 15; sincos_rev((double)t * INV_ROPE[k] * inv2pi, s, c); cosA[i] = c; sinA[i] = s; }
        else { const int j = i - 4096 * 16, p = j >> 5, k = j & 31; sincos_rev((double)p * INV_AX[k] * inv2pi, s, c); cosX[j] = c; sinX[j] = s; }
    }
}
__device__ __forceinline__ void phase_hyena_filters(const Ctx& C, int l) {
    constexpr int PB = 24;
    LAS float* z = (LAS float*)C.lds;
    LAS float* h1 = z + PB * 36;
    LAS float* h2 = h1 + PB * 64;
    const float* w1 = C.a->in[I_HW1] + l * 33 * 64; const float* b1 = C.a->in[I_HB1] + l * 64; const float* fr1 = C.a->in[I_HF1] + l * 64;
    const float* w2 = C.a->in[I_HW2] + l * 64 * 64; const float* b2 = C.a->in[I_HB2] + l * 64; const float* fr2 = C.a->in[I_HF2] + l * 64;
    const float* w3 = C.a->in[I_HW3] + (size_t)l * 64 * 2048; const float* dec = C.a->in[I_HDEC] + l * 2048;
    float* hf = (float*)(C.ws + WS_HFIL);
    for (int it = C.bid; it < (L_P + L_S) / PB; it += C.G) {
        const int gp0 = it * PB;
        __syncthreads();
        for (int u = C.tid; u < PB * 33; u += NTHR) { const int p = u / 33, i = u % 33, gp = gp0 + p; const bool isS = gp >= L_P; const int n = isS ? gp - L_P : gp, L = isS ? L_S : L_P; float v;
            if (i == 0) v = (float)n / (float)(L - 1);
            else { const int j = (i - 1) & 15; const float f = 1e-4f + (float)j * ((15.0f - 1e-4f) / 15.0f); const float rev = (float)n * f / (float)L, fr = rev - rintf(rev); const float s = __builtin_amdgcn_sinf(fr), c = __builtin_amdgcn_cosf(fr); v = (i <= 16) ? c : -s; }
            z[p * 36 + i] = v; }
        __syncthreads();
        for (int u = C.tid; u < PB * 64; u += NTHR) { const int p = u >> 6, j = u & 63; float acc = b1[j];
            for (int i = 0; i < 33; ++i) acc += z[p * 36 + i] * w1[i * 64 + j];
            h1[p * 64 + j] = sinf(fr1[j] * acc); }
        __syncthreads();
        for (int u = C.tid; u < PB * 64; u += NTHR) { const int p = u >> 6, j = u & 63; float acc = b2[j];
            for (int i = 0; i < 64; ++i) acc += h1[p * 64 + i] * w2[i * 64 + j];
            h2[j * PB + p] = sinf(fr2[j] * acc); }
        __syncthreads();
        {
            float acc[4][PB];
#pragma unroll
            for (int q = 0; q < 4; ++q)
#pragma unroll
                for (int p = 0; p < PB; ++p) acc[q][p] = 0.f;
            for (int j = 0; j < 64; ++j) {
                float hv[PB];
#pragma unroll
                for (int k = 0; k < PB / 4; ++k) { const f32x4 t = *(const LAS f32x4*)(h2 + j * PB + 4 * k); hv[4 * k] = t.x; hv[4 * k + 1] = t.y; hv[4 * k + 2] = t.z; hv[4 * k + 3] = t.w; }
#pragma unroll
                for (int q = 0; q < 4; ++q) { const float w = w3[j * 2048 + C.tid + NTHR * q];
#pragma unroll
                    for (int p = 0; p < PB; ++p) acc[q][p] += hv[p] * w; }
            }
#pragma unroll
            for (int q = 0; q < 4; ++q) { const int col = C.tid + NTHR * q; const float d = dec[col];
#pragma unroll
                for (int p = 0; p < PB; ++p) { const int gp = gp0 + p; const bool isS = gp >= L_P; const int n = isS ? gp - L_P : gp, L = isS ? L_S : L_P;
                    const float r = fabsf((float)(n - L / 2)) / (float)(L / 2);
                    (isS ? hf + (size_t)2048 * L_P + (size_t)col * L_S : hf + (size_t)col * L_P)[n] = acc[q][p] * __expf(-r * d); } }
        }
    }
    __syncthreads();
}
template <bool TO_BF16>
__device__ __forceinline__ void phase_rmsnorm(const Ctx& C, const float* src_lo, const float* src_hi, const float* g, void* dst) {
    for (int row = C.gw; row < NTOK; row += C.NGW) {
        const float* xr = row < TOK_P ? src_lo + (size_t)row * DM : src_hi + (size_t)(row - TOK_P) * DM;
        f32x4 v[16]; float ss = 0.f;
#pragma unroll
        for (int j = 0; j < 16; ++j) { v[j] = __builtin_nontemporal_load((const f32x4*)xr + C.lane + 64 * j); ss += (v[j].x * v[j].x + v[j].y * v[j].y) + (v[j].z * v[j].z + v[j].w * v[j].w); }
        ss = wave_sum(ss);
        const float r = 1.0f / sqrtf(ss * (1.0f / DM) + EPS);
#pragma unroll
        for (int j = 0; j < 16; ++j) { const f32x4 gv = ((const f32x4*)g)[C.lane + 64 * j]; const f32x4 o = v[j] * r * gv;
            if (TO_BF16) { v2u w; w.x = pk2(o.x, o.y); w.y = pk2(o.z, o.w); ((v2u*)((bf16*)dst + (size_t)row * DM))[C.lane + 64 * j] = w; }
            else ((f32x4*)((float*)dst + (size_t)row * DM))[C.lane + 64 * j] = o; }
    }
}
template <bool TO_BF16>
__device__ __forceinline__ void rms_row(const float* xr, const float* g, void* drow, int lane) {
    f32x4 v[16]; float ss = 0.f;
#pragma unroll
    for (int j = 0; j < 16; ++j) { v[j] = __builtin_nontemporal_load((const f32x4*)xr + lane + 64 * j); ss += (v[j].x * v[j].x + v[j].y * v[j].y) + (v[j].z * v[j].z + v[j].w * v[j].w); }
    ss = wave_sum(ss);
    const float r = 1.0f / sqrtf(ss * (1.0f / DM) + EPS);
#pragma unroll
    for (int j = 0; j < 16; ++j) { const f32x4 gv = ((const f32x4*)g)[lane + 64 * j]; const f32x4 o = v[j] * r * gv;
        if constexpr (TO_BF16) { v2u w; w.x = pk2(o.x, o.y); w.y = pk2(o.z, o.w); ((v2u*)drow)[lane + 64 * j] = w; }
        else ((f32x4*)drow)[lane + 64 * j] = o; }
}
template <bool TO_BF16>
__device__ __forceinline__ void rms_row_lite(const float* xr, const float* g, void* drow, int lane) {
    float ss = 0.f;
#pragma nounroll
    for (int j0 = 0; j0 < 16; j0 += 4) { f32x4 v[4];
#pragma unroll
        for (int j = 0; j < 4; ++j) v[j] = ((const f32x4*)xr)[lane + 64 * (j0 + j)];
#pragma unroll
        for (int j = 0; j < 4; ++j) ss += (v[j].x * v[j].x + v[j].y * v[j].y) + (v[j].z * v[j].z + v[j].w * v[j].w); }
    ss = wave_sum(ss);
    const float r = 1.0f / sqrtf(ss * (1.0f / DM) + EPS);
#pragma nounroll
    for (int j0 = 0; j0 < 16; j0 += 4) { f32x4 v[4];
#pragma unroll
        for (int j = 0; j < 4; ++j) v[j] = __builtin_nontemporal_load((const f32x4*)xr + lane + 64 * (j0 + j));
#pragma unroll
        for (int j = 0; j < 4; ++j) { const f32x4 gv = ((const f32x4*)g)[lane + 64 * (j0 + j)]; const f32x4 o = v[j] * r * gv;
            if constexpr (TO_BF16) { v2u w; w.x = pk2(o.x, o.y); w.y = pk2(o.z, o.w); ((v2u*)drow)[lane + 64 * (j0 + j)] = w; }
            else ((f32x4*)drow)[lane + 64 * (j0 + j)] = o; } }
}
template <bool TO_BF16>
__device__ __forceinline__ void rms_row2(const float* xa, const float* xb, const float* g, void* da, void* db, int lane) {
    f32x4 va[16], vb[16]; float sa = 0.f, sb = 0.f;
#pragma unroll
    for (int j = 0; j < 16; ++j) va[j] = __builtin_nontemporal_load((const f32x4*)xa + lane + 64 * j);
#pragma unroll
    for (int j = 0; j < 16; ++j) vb[j] = __builtin_nontemporal_load((const f32x4*)xb + lane + 64 * j);
#pragma unroll
    for (int j = 0; j < 16; ++j) sa += (va[j].x * va[j].x + va[j].y * va[j].y) + (va[j].z * va[j].z + va[j].w * va[j].w);
#pragma unroll
    for (int j = 0; j < 16; ++j) sb += (vb[j].x * vb[j].x + vb[j].y * vb[j].y) + (vb[j].z * vb[j].z + vb[j].w * vb[j].w);
    sa = wave_sum(sa); sb = wave_sum(sb);
    const float ra = 1.0f / sqrtf(sa * (1.0f / DM) + EPS), rb = 1.0f / sqrtf(sb * (1.0f / DM) + EPS);
#pragma unroll
    for (int j = 0; j < 16; ++j) { const f32x4 gv = ((const f32x4*)g)[lane + 64 * j]; const f32x4 oa = va[j] * ra * gv, ob = vb[j] * rb * gv;
        if constexpr (TO_BF16) { v2u w; w.x = pk2(oa.x, oa.y); w.y = pk2(oa.z, oa.w); ((v2u*)da)[lane + 64 * j] = w; v2u u; u.x = pk2(ob.x, ob.y); u.y = pk2(ob.z, ob.w); ((v2u*)db)[lane + 64 * j] = u; }
        else { ((f32x4*)da)[lane + 64 * j] = oa; ((f32x4*)db)[lane + 64 * j] = ob; } }
}
template <bool TO_BF16>
__device__ __forceinline__ void phase_rmsnorm_half(const Ctx& C, const float* src, const float* g, void* dst, int nrows = TOK_P) {
    for (int row = C.gw; row < nrows; row += C.NGW) { void* drow; if constexpr (TO_BF16) drow = (bf16*)dst + (size_t)row * DM; else drow = (float*)dst + (size_t)row * DM; rms_row<TO_BF16>(src + (size_t)row * DM, g, drow, C.lane); }
}
template <bool TO_BF16, int RPS>
struct SlotNormOrder : pg8::StaticOrder {
    const float* src; const float* g; void* dst; int nrows, gw, ngw, lane; mutable int k; int delay; mutable int seen;
    __device__ __forceinline__ void* drow_of(int row) const { if constexpr (TO_BF16) return (bf16*)dst + (size_t)row * DM; else return (float*)dst + (size_t)row * DM; }
    __device__ __forceinline__ void slot() const {
#pragma nounroll
        for (int q = 0; q < RPS; q += 2) { const int row = gw + ngw * (k * RPS + q), row2 = row + ngw; if (row >= nrows) break;
            int ln = lane; asm volatile("" : "+v"(ln));
            if (RPS > 1 && q + 1 < RPS && row2 < nrows) rms_row2<TO_BF16>(src + (size_t)row * DM, src + (size_t)row2 * DM, g, drow_of(row), drow_of(row2), ln);
            else rms_row<TO_BF16>(src + (size_t)row * DM, g, drow_of(row), ln); }
        ++k;
    }
    __device__ __forceinline__ void done(const pg8::Unit&) const { if (seen++ >= delay) slot(); }
    __device__ __forceinline__ void flush() const { while (gw + ngw * (k * RPS) < nrows) slot(); }
};
__device__ __forceinline__ void phase_prep(const Ctx& C, int l) {
    bf16* proj = (bf16*)(C.ws + WS_PROJ);
    const float* cosA = (const float*)(C.ws + WS_ROPE); const float* sinA = cosA + 4096 * 16; const float* cosX = sinA + 4096 * 16; const float* sinX = cosX + 64 * 32;
    const float* qkg = C.a->in[I_QKG] + l * 256;
    {
        const int d1 = C.lane < 32 ? C.lane : C.lane + 32, d2 = d1 + 32; const float gq1 = qkg[d1], gq2 = qkg[d2], gk1 = qkg[128 + d1], gk2 = qkg[128 + d2];
        for (int row = C.gw; row < NTOK; row += C.NGW) {
            const int t = seq_pos(row); bf16* pr = proj + (size_t)row * NPROJ;
            float a1[4], a2[4], ca[4], sa[4], b1[10], b2[10];
#pragma unroll
            for (int k = 0; k < 4; ++k) { const int idx = 64 * k + C.lane, hh = idx >> 4, i = idx & 15; const int col = (hh < 8 ? C_AQ + hh * 128 : C_AK + (hh - 8) * 128) + i;
                a1[k] = bf2f(pr[col]); a2[k] = bf2f(pr[col + 16]); ca[k] = cosA[t * 16 + i]; sa[k] = sinA[t * 16 + i]; }
#pragma unroll
            for (int hh = 0; hh < 10; ++hh) { const int base = hh < 8 ? C_BQ + hh * 128 : C_BK + (hh - 8) * 128; b1[hh] = bf2f(pr[base + d1]); b2[hh] = bf2f(pr[base + d2]); }
            const float c = C.lane < 32 ? cosX[(t >> 6) * 32 + C.lane] : cosX[(t & 63) * 32 + C.lane - 32];
            const float s = C.lane < 32 ? sinX[(t >> 6) * 32 + C.lane] : sinX[(t & 63) * 32 + C.lane - 32];
#pragma unroll
            for (int k = 0; k < 4; ++k) { const int idx = 64 * k + C.lane, hh = idx >> 4, i = idx & 15; const int col = (hh < 8 ? C_AQ + hh * 128 : C_AK + (hh - 8) * 128) + i;
                pr[col] = (bf16)f2bf(a1[k] * ca[k] - a2[k] * sa[k]); pr[col + 16] = (bf16)f2bf(a2[k] * ca[k] + a1[k] * sa[k]); }
#pragma unroll
            for (int hh = 0; hh < 10; ++hh) { const int base = hh < 8 ? C_BQ + hh * 128 : C_BK + (hh - 8) * 128;
                const float ss = wave_sum(b1[hh] * b1[hh] + b2[hh] * b2[hh]); const float r = 1.0f / sqrtf(ss * (1.0f / 128.0f) + EPS);
                const float x1 = b1[hh] * r * (hh < 8 ? gq1 : gk1), x2 = b2[hh] * r * (hh < 8 ? gq2 : gk2);
                pr[base + d1] = (bf16)f2bf(x1 * c - x2 * s); pr[base + d2] = (bf16)f2bf(x2 * c + x1 * s); }
        }
    }
    {
        LAS float* tile = (LAS float*)C.lds + C.wave * (64 * 65);
        const float* cw = C.a->in[I_HCW] + l * 3 * 3072; const float* cb = C.a->in[I_HCB] + l * 3072; bf16* uct = (bf16*)(C.ws + WS_UCT);
        for (int it = C.gw; it < (NTOK / 64) * 48; it += C.NGW) {
            const int tb = it / 48, cbk = it % 48, cg = cbk * 64 + C.lane; const int row0 = tb * 64, t0 = seq_pos(row0), L = row0 < TOK_P ? L_P : L_S;
            const float w0 = cw[cg], w1 = cw[3072 + cg], w2 = cw[2 * 3072 + cg], bb = cb[cg];
            const bf16* p = proj + (size_t)row0 * NPROJ + C_CU + cg;
            unsigned short u[66];
#pragma unroll
            for (int j = 0; j < 64; ++j) u[j + 1] = p[(size_t)j * NPROJ];
            u[0] = t0 > 0 ? p[-(ptrdiff_t)NPROJ] : (unsigned short)0; u[65] = t0 + 64 < L ? p[(size_t)64 * NPROJ] : (unsigned short)0;
#pragma unroll
            for (int j = 0; j < 64; ++j) tile[C.lane * 65 + j] = bb + bf2f(u[j]) * w0 + bf2f(u[j + 1]) * w1 + bf2f(u[j + 2]) * w2;
            LDS_WAIT(); asm volatile("" ::: "memory");
#pragma unroll
            for (int k = 0; k < 8; ++k) { const int id = C.lane + 64 * k, ch = id >> 3, part = id & 7; const LAS float* s = tile + ch * 65 + part * 8;
                v4u o; o.x = pk2(s[0], s[1]); o.y = pk2(s[2], s[3]); o.z = pk2(s[4], s[5]); o.w = pk2(s[6], s[7]);
                *(v4u*)(uct + (size_t)(cbk * 64 + ch) * NTOK + row0 + part * 8) = o; }
            LDS_WAIT(); asm volatile("" ::: "memory");
        }
        __syncthreads();
    }
    {
        const float* gates = (const float*)(C.ws + WS_GATES); const float* gb = C.a->in[I_MLGB] + l * 16; float* gc = (float*)(C.ws + WS_GCUM);
        LAS float* tot = (LAS float*)C.lds;
        for (int it = C.bid; it < 12 * 4 * 2; it += C.G) {
            const int dir = it & 1, h = (it >> 1) & 3, sq = it >> 3; const int L = sq < B_P ? L_P : L_S; const int row0 = sq < B_P ? sq * L_P : TOK_P + (sq - B_P) * L_S;
            const float bi = gb[(2 * dir) * 4 + h], bf_ = gb[(2 * dir + 1) * 4 + h]; const int nch = L / 512;
            float xs[8], gis[8]; float carry = 0.f;
            __syncthreads();
#pragma unroll
            for (int c = 0; c < 8; ++c) if (c < nch) {
                const int sidx = (C.wave * nch + c) * 64 + C.lane; const int tl = dir == 0 ? sidx : L - 1 - sidx; const int row = row0 + tl;
                gis[c] = gates[(size_t)row * 16 + (2 * dir) * 4 + h] + bi; const float gf = gates[(size_t)row * 16 + (2 * dir + 1) * 4 + h] + bf_;
                float x = fminf(gf, 0.f) - log1pf(__expf(-fabsf(gf)));
#pragma unroll
                for (int o = 1; o < 64; o <<= 1) { const float y = __shfl_up(x, o); if (C.lane >= o) x += y; }
                x += carry; carry = __shfl(x, 63); xs[c] = x;
            }
            if (C.lane == 0) tot[C.wave] = carry;
            __syncthreads();
            float pre = 0.f;
            for (int w = 0; w < C.wave; ++w) pre += tot[w];
#pragma unroll
            for (int c = 0; c < 8; ++c) if (c < nch) {
                const int sidx = (C.wave * nch + c) * 64 + C.lane; const int tl = dir == 0 ? sidx : L - 1 - sidx; const int row = row0 + tl;
                gc[(size_t)((2 * dir) * 4 + h) * NTOK + row] = xs[c] + pre; gc[(size_t)((2 * dir + 1) * 4 + h) * NTOK + row] = gis[c];
            }
        }
        __syncthreads();
    }
}
namespace att {
using bf16x8 = __attribute__((ext_vector_type(8))) short;
using s16x4  = __attribute__((ext_vector_type(4))) short;
using f32x16 = __attribute__((ext_vector_type(16))) float;
using u32x4  = __attribute__((ext_vector_type(4))) unsigned;
constexpr int   D = 128, NW = 8, QBLK = 32, KVBLK = 64;
constexpr float SCALE = 0.088388347648318440f;
constexpr float THR = 8.f;
constexpr size_t SHM_V = KVBLK * D * 2, SHM_K = KVBLK * D * 2, SHM_ATTN = 2 * SHM_V + 2 * SHM_K + NW * 64 * 4;
#define KSWZ(row, colB) ((row) * 256 + ((colB) ^ (((row) & 7) << 4)))
#define SBAR() __builtin_amdgcn_sched_barrier(0)
__device__ __forceinline__ int crow(int r, int hi) { return (r & 3) + 8 * (r >> 2) + 4 * hi; }
__device__ __forceinline__ unsigned cvtpk(float lo, float hi) { unsigned r; asm volatile("v_cvt_pk_bf16_f32 %0, %1, %2" : "=v"(r) : "v"(lo), "v"(hi)); return r; }
__device__ __forceinline__ void partialSM(f32x16& p0, f32x16& p1, float& m_reg, float& mn, float& alpha) {
  constexpr float C = SCALE * 1.4426950408889634f;
  float pmax = p0[0]; for (int r = 1; r < 16; ++r) pmax = fmaxf(pmax, p0[r]); for (int r = 0; r < 16; ++r) pmax = fmaxf(pmax, p1[r]);
  { auto rr = __builtin_amdgcn_permlane32_swap(__float_as_uint(pmax), __float_as_uint(pmax), false, false);
    pmax = fmaxf(__uint_as_float(rr[0]), __uint_as_float(rr[1])); }
  if (__builtin_expect(__all(pmax - m_reg <= THR / SCALE), 1)) { mn = m_reg; alpha = 1.f; }
  else { mn = fmaxf(m_reg, pmax); alpha = __builtin_amdgcn_exp2f((m_reg - mn) * C); m_reg = mn; }
  float mnC = -mn * C;
  for (int r = 0; r < 16; ++r) p0[r] = fmaf(p0[r], C, mnC); for (int r = 0; r < 16; ++r) p1[r] = fmaf(p1[r], C, mnC);
  for (int r = 0; r < 16; ++r) p0[r] = __builtin_amdgcn_exp2f(p0[r]);
}
__device__ __forceinline__ void finishSM(f32x16& p0, f32x16& p1, float alpha, float& l_reg, bf16x8& pa0, bf16x8& pa1, bf16x8& pa2, bf16x8& pa3) {
  for (int r = 0; r < 16; ++r) p1[r] = __builtin_amdgcn_exp2f(p1[r]);
  float ps = 0; for (int r = 0; r < 16; ++r) ps += p0[r]; for (int r = 0; r < 16; ++r) ps += p1[r];
  { auto rr = __builtin_amdgcn_permlane32_swap(__float_as_uint(ps), __float_as_uint(ps), false, false);
    ps = __uint_as_float(rr[0]) + __uint_as_float(rr[1]); }
  l_reg = l_reg * alpha + ps;
#define PK4(P, BASE, OUT) do { unsigned a0 = cvtpk(P[BASE + 0], P[BASE + 1]), a1 = cvtpk(P[BASE + 2], P[BASE + 3]);   \
    unsigned b0 = cvtpk(P[BASE + 4], P[BASE + 5]), b1 = cvtpk(P[BASE + 6], P[BASE + 7]);                              \
    auto r0 = __builtin_amdgcn_permlane32_swap(a0, b0, false, false); auto r1 = __builtin_amdgcn_permlane32_swap(a1, b1, false, false); \
    u32x4 w = {r0[0], r1[0], r0[1], r1[1]}; OUT = *reinterpret_cast<bf16x8*>(&w); } while (0)
  PK4(p0, 0, pa0); PK4(p0, 8, pa1); PK4(p1, 0, pa2); PK4(p1, 8, pa3);
#undef PK4
}
__device__ __forceinline__ void qkt(f32x16& p0, f32x16& p1, const unsigned short* Ks, const bf16x8* qr, int r32, int hi) {
  p0 = f32x16{}; p1 = f32x16{};
  for (int d0 = 0; d0 < 8; ++d0) { int cb = (d0 * 16 + hi * 8) * 2;
    bf16x8 b0 = *reinterpret_cast<const bf16x8*>((const char*)Ks + KSWZ(r32, cb));
    bf16x8 b1 = *reinterpret_cast<const bf16x8*>((const char*)Ks + KSWZ(32 + r32, cb));
    p0 = __builtin_amdgcn_mfma_f32_32x32x16_bf16(b0, qr[d0], p0, 0, 0, 0);
    p1 = __builtin_amdgcn_mfma_f32_32x32x16_bf16(b1, qr[d0], p1, 0, 0, 0); }
}
__device__ __forceinline__ int v_st(int k, int c) { const int kk = (k & ~0xC) | ((k & 4) << 1) | ((k & 8) >> 1); return ((kk >> 3) * 4 + (c >> 5)) * 512 + ((kk & 7) * 32 + (c & 31)) * 2; }
__device__ __forceinline__ int v_rd_base(int lane) { return ((lane & 3) << 3) | (((lane >> 2) & 3) << 6) | (((lane >> 4) & 1) << 5) | (((lane >> 5) & 1) << 8); }
constexpr int v_rd_off(int d0, int ks, int half) { return d0 * 512 + ks * 4096 + half * 2048; }
template <int OFF> __device__ __forceinline__ s16x4 tr_read(int vb) {
  s16x4 r; asm volatile("ds_read_b64_tr_b16 %0, %1 offset:%2" : "=&v"(r) : "v"(vb), "i"(OFF) : "memory"); return r;
}
template <int D0> __device__ __forceinline__ void pv_one(f32x16& od, int vb, bf16x8 pa0, bf16x8 pa1, bf16x8 pa2, bf16x8 pa3) {
  const s16x4 l0 = tr_read<v_rd_off(D0, 0, 0)>(vb), h0 = tr_read<v_rd_off(D0, 0, 1)>(vb), l1 = tr_read<v_rd_off(D0, 1, 0)>(vb), h1 = tr_read<v_rd_off(D0, 1, 1)>(vb);
  const s16x4 l2 = tr_read<v_rd_off(D0, 2, 0)>(vb), h2 = tr_read<v_rd_off(D0, 2, 1)>(vb), l3 = tr_read<v_rd_off(D0, 3, 0)>(vb), h3 = tr_read<v_rd_off(D0, 3, 1)>(vb);
  asm volatile("s_waitcnt lgkmcnt(0)" ::: "memory"); SBAR();
#define PK(L, H) (bf16x8){L[0], L[1], L[2], L[3], H[0], H[1], H[2], H[3]}
  od = __builtin_amdgcn_mfma_f32_32x32x16_bf16(pa0, PK(l0, h0), od, 0, 0, 0);
  od = __builtin_amdgcn_mfma_f32_32x32x16_bf16(pa1, PK(l1, h1), od, 0, 0, 0);
  od = __builtin_amdgcn_mfma_f32_32x32x16_bf16(pa2, PK(l2, h2), od, 0, 0, 0);
  od = __builtin_amdgcn_mfma_f32_32x32x16_bf16(pa3, PK(l3, h3), od, 0, 0, 0);
#undef PK
}
__device__ __forceinline__ void pv_d0(f32x16* o, int vb, bf16x8 pa0, bf16x8 pa1, bf16x8 pa2, bf16x8 pa3) {
  pv_one<0>(o[0], vb, pa0, pa1, pa2, pa3); pv_one<1>(o[1], vb, pa0, pa1, pa2, pa3); pv_one<2>(o[2], vb, pa0, pa1, pa2, pa3); pv_one<3>(o[3], vb, pa0, pa1, pa2, pa3);
}
__device__ __forceinline__ void dil_bias(f32x16& p0, f32x16& p1, int dbase, int hi) {
  constexpr float IC = 1.0f / (SCALE * 1.4426950408889634f);
  const int d0 = dbase + 4 * hi;
#pragma unroll
  for (int r = 0; r < 16; ++r) {
#pragma unroll
    for (int half = 0; half < 2; ++half) {
      const int dl = d0 + (r & 3) + 8 * (r >> 2) + 32 * half; const int ad = dl < 0 ? -dl : dl;
      const float f1 = ad <= 64 ? 1.f : 0.f, f2 = (((dl & 3) == 0) & (ad <= 256)) ? 1.f : 0.f, f3 = (((dl & 15) == 0) & (ad <= 1024)) ? 1.f : 0.f;
      const float b = IC * __builtin_amdgcn_logf(f1 + f2 + f3);
      if (half == 0) p0[r] += b; else p1[r] += b;
    }
  }
}
template <int DK> __device__ __forceinline__ void qkt_dk(f32x16& p0, f32x16& p1, const char* Ks, const bf16x8* qr, int r32, int hi) {
  p0 = f32x16{}; p1 = f32x16{};
#pragma unroll
  for (int d0 = 0; d0 < DK / 16; ++d0) { const int cb = (d0 * 16 + hi * 8) * 2;
    bf16x8 b0 = *reinterpret_cast<const bf16x8*>(Ks + r32 * (DK * 2) + (cb ^ ((r32 & 7) << 4)));
    bf16x8 b1 = *reinterpret_cast<const bf16x8*>(Ks + (32 + r32) * (DK * 2) + (cb ^ ((r32 & 7) << 4)));
    p0 = __builtin_amdgcn_mfma_f32_32x32x16_bf16(b0, qr[d0], p0, 0, 0, 0);
    p1 = __builtin_amdgcn_mfma_f32_32x32x16_bf16(b1, qr[d0], p1, 0, 0, 0); }
}
__device__ __forceinline__ float pack_p(const f32x16& p0, const f32x16& p1, bf16x8& pa0, bf16x8& pa1, bf16x8& pa2, bf16x8& pa3) {
  float ps = 0; for (int r = 0; r < 16; ++r) ps += p0[r]; for (int r = 0; r < 16; ++r) ps += p1[r];
  { auto rr = __builtin_amdgcn_permlane32_swap(__float_as_uint(ps), __float_as_uint(ps), false, false);
    ps = __uint_as_float(rr[0]) + __uint_as_float(rr[1]); }
#define PK4(P, BASE, OUT) do { unsigned a0 = cvtpk(P[BASE + 0], P[BASE + 1]), a1 = cvtpk(P[BASE + 2], P[BASE + 3]);   \
    unsigned b0 = cvtpk(P[BASE + 4], P[BASE + 5]), b1 = cvtpk(P[BASE + 6], P[BASE + 7]);                              \
    auto r0 = __builtin_amdgcn_permlane32_swap(a0, b0, false, false); auto r1 = __builtin_amdgcn_permlane32_swap(a1, b1, false, false); \
    u32x4 w = {r0[0], r1[0], r0[1], r1[1]}; OUT = *reinterpret_cast<bf16x8*>(&w); } while (0)
  PK4(p0, 0, pa0); PK4(p0, 8, pa1); PK4(p1, 0, pa2); PK4(p1, 8, pa3);
#undef PK4
  return ps;
}
__device__ __forceinline__ void store_o_tile(const f32x16* o, const float* rli, unsigned short* Ow, int LDO, __attribute__((address_space(3))) unsigned char* ldsl, int wid, int lane) {
  typedef __attribute__((address_space(3))) unsigned short LUS; typedef __attribute__((address_space(3))) u32x4 LU4;
  constexpr int RP = 272;
  const int r32 = lane & 31, hi = lane >> 5;
  unsigned wb = (unsigned)(uintptr_t)ldsl + (unsigned)(wid * (32 * RP) + 4 * hi * RP + r32 * 2), rb = (unsigned)(uintptr_t)ldsl + (unsigned)(wid * (32 * RP) + (lane >> 4) * RP + (lane & 15) * 16);
  asm volatile("" : "+v"(wb), "+v"(rb));
#pragma unroll
  for (int r = 0; r < 16; ++r)
#pragma unroll
    for (int d0 = 0; d0 < 4; ++d0) *(LUS*)(uintptr_t)(wb + (unsigned)(((r & 3) + 8 * (r >> 2)) * RP + d0 * 64)) = (unsigned short)f2bf(o[d0][r] * rli[r]);
  asm volatile("s_waitcnt lgkmcnt(0)" ::: "memory");
  unsigned short* gp = Ow + (long)(lane >> 4) * LDO + (lane & 15) * 8;
#pragma unroll
  for (int k = 0; k < 8; ++k) { const u32x4 w = *(const LU4*)(uintptr_t)(rb + (unsigned)(4 * k * RP)); *reinterpret_cast<u32x4*>(gp + (long)(4 * k) * LDO) = w; }
}
#define WAITBAR(n) do { asm volatile("s_waitcnt vmcnt(" #n ") lgkmcnt(0)" ::: "memory"); __builtin_amdgcn_s_barrier(); asm volatile("" ::: "memory"); } while (0)
template <int MODE, int DK, int LDQ, int LDK, int LDV>
__device__ __forceinline__ void flash_body(const unsigned short* __restrict__ Qb, const unsigned short* __restrict__ Kh, const unsigned short* __restrict__ Vh, int NT, int dk0,
                                           const float* gq, const float* gkc, const float* gkl, int dir, const unsigned short* CT, const float* nst, float gref, unsigned short* Ob, int LDO, __attribute__((address_space(3))) unsigned char* ldsl, int tid) {
  typedef __attribute__((address_space(3))) unsigned LU;
  constexpr int SHM_KD = KVBLK * DK * 2, CPR = DK / 8, KROWS = 512 / CPR, KP = 64 / KROWS, NVB = DK == 128 ? 3 : 2;
  char* lds = (char*)ldsl;
  const int wid = __builtin_amdgcn_readfirstlane(tid >> 6), lane = tid & 63, r32 = lane & 31, hi = lane >> 5;
  char* K_lds = lds + NVB * SHM_V;
  float* ws = (float*)(lds + NVB * SHM_V + 3 * SHM_KD) + wid * 64; float* li_l = ws; float* al_l = ws + 32;
  float* cs_l = (float*)(lds + NVB * SHM_V + 3 * SHM_KD + NW * 256);
  float m_reg = -1e30f, l_reg = 0; f32x16 o[4] = {}; bf16x8 qr[DK / 16];
  const unsigned short* Qw = Qb + (long)(wid * QBLK + r32) * LDQ + hi * 8;
#pragma unroll
  for (int d0 = 0; d0 < DK / 16; ++d0) qr[d0] = *reinterpret_cast<const bf16x8*>(Qw + d0 * 16);
  const int vb0 = (int)(uintptr_t)ldsl + v_rd_base(lane);
  const int dbase0 = dk0 - (wid * QBLK + r32);
  const int krow = tid / CPR, kch = (tid % CPR) ^ (krow & 7);
  const unsigned voffk = (unsigned)(krow * LDK) * 2u + (unsigned)kch * 16u;
  const int vkk = (tid >> 7) * 8 + ((tid >> 2) & 7), vk = (vkk & ~0xC) | ((vkk & 4) << 1) | ((vkk & 8) >> 1), vc = ((tid >> 5) & 3) * 32 + (tid & 3) * 8;
  const unsigned voffv = (unsigned)(vk * LDV + vc) * 2u;
  const float gql = (MODE == 1) ? gq[wid * QBLK + r32] : 0.f;
  const char* kp = (const char*)Kh; const char* vp = (const char*)Vh;
  int ks = 0, vs = 0;
  LU* const kl0 = (LU*)(ldsl + NVB * SHM_V + wid * 1024); LU* const vl0 = (LU*)(ldsl + wid * 1024);
#define STAGE_K() do { _Pragma("unroll") for (int i_ = 0; i_ < KP; ++i_) __builtin_amdgcn_global_load_lds((const unsigned*)(kp + voffk + (unsigned)(i_ * KROWS) * (LDK * 2u)), kl0 + (ks * SHM_KD + i_ * 8192) / 4, 16, 0, 0); \
    kp += KVBLK * LDK * 2; ks = ks == 2 ? 0 : ks + 1; } while (0)
#define STAGE_V() do { _Pragma("unroll") for (int i_ = 0; i_ < 2; ++i_) __builtin_amdgcn_global_load_lds((const unsigned*)(vp + voffv + (unsigned)(i_ * 32) * (LDV * 2u)), vl0 + (vs * SHM_V + i_ * 8192) / 4, 16, 0, 0); \
    vp += KVBLK * LDV * 2; vs = vs == NVB - 1 ? 0 : vs + 1; } while (0)
  bf16x8 pa0, pa1, pa2, pa3; f32x16 p0, p1; float cst = 0.f;
  float b16[8];
#pragma unroll
  for (int i = 0; i < 8; ++i) b16[i] = (MODE == 2 && ((dbase0 + 4 * hi + (i & 3) + 8 * (i >> 2)) & 15) == 0) ? 0.f : -__builtin_inff();
  if (MODE == 1 && tid < 64) cs_l[tid] = gkc[tid] - gkl[tid];
  STAGE_V(); STAGE_K();
  if (MODE == 1 && CT != nullptr) {
    const float sc = __builtin_amdgcn_exp2f((gql - gref) * 1.4426950408889634f); float dn = 0.f;
    const unsigned ctoff = (unsigned)(r32 * 256 + hi * 8) * 2u, noff = (unsigned)hi * 32u; const char* ctb = (const char*)CT; const char* nb = (const char*)nst;
    asm volatile("" : "+s"(ctb), "+s"(nb));
#pragma unroll
    for (int d0 = 0; d0 < DK / 16; ++d0) {
      const u32x4 qw = *reinterpret_cast<const u32x4*>(&qr[d0]); const unsigned qa[4] = {qw.x, qw.y, qw.z, qw.w};
      const f32x4 n0 = *(const f32x4*)(nb + noff + d0 * 64), n1 = *(const f32x4*)(nb + noff + d0 * 64 + 16); const float nn[8] = {n0.x, n0.y, n0.z, n0.w, n1.x, n1.y, n1.z, n1.w};
      unsigned qo[4];
#pragma unroll
      for (int k = 0; k < 4; ++k) { const float a = __builtin_bit_cast(float, qa[k] << 16) * sc, b = __builtin_bit_cast(float, qa[k] & 0xffff0000u) * sc; dn += a * nn[2 * k] + b * nn[2 * k + 1]; qo[k] = cvtpk(a, b); }
      const u32x4 qsw = {qo[0], qo[1], qo[2], qo[3]}; const bf16x8 qs = *reinterpret_cast<const bf16x8*>(&qsw);
#pragma unroll
      for (int eb = 0; eb < 4; ++eb) { const bf16x8 cb = *reinterpret_cast<const bf16x8*>(ctb + ctoff + (eb * 32 * 256 + d0 * 16) * 2);
        o[eb] = __builtin_amdgcn_mfma_f32_32x32x16_bf16(qs, cb, o[eb], 0, 0, 0); }
    }
    { auto rr = __builtin_amdgcn_permlane32_swap(__float_as_uint(dn), __float_as_uint(dn), false, false); dn = __uint_as_float(rr[0]) + __uint_as_float(rr[1]); }
    l_reg += dn;
  }
  if (NVB == 3) { STAGE_V(); STAGE_K(); if (KP == 2) WAITBAR(4); else WAITBAR(6); }
  else { STAGE_K(); if (KP == 2) WAITBAR(2); else WAITBAR(4); }
  int kc = 0, vcur = 0;
#pragma nounroll
  for (int j = 0; j < NT; ++j) {
    if (MODE == 1 && tid < 64 && j + 1 < NT) cst = gkc[(j + 1) * KVBLK + tid] - gkl[(j + 1) * KVBLK + tid];
    const bool more = j + 2 < NT;
    if (NVB == 3) { if (more) { STAGE_V(); STAGE_K(); } }
    else { if (j + 1 < NT) STAGE_V(); if (more) STAGE_K(); }
    SBAR(); qkt_dk<DK>(p0, p1, K_lds + kc * SHM_KD, qr, r32, hi);
    if (MODE == 1) {
      const int b = j & 1;
      const int dbase = dbase0 + 64 * j;
      const int wmin = dk0 + 64 * j - wid * QBLK - 31, wmax = dk0 + 64 * j + 63 - wid * QBLK;
      const bool need_mask = dir == 0 ? (wmax > 0) : (wmin < 0);
      const float* cs = cs_l + b * 64 + 4 * hi;
#pragma unroll
      for (int g = 0; g < 4; ++g) { const f32x4 c0 = *(const f32x4*)(cs + 8 * g), c1 = *(const f32x4*)(cs + 32 + 8 * g);
#pragma unroll
        for (int i = 0; i < 4; ++i) { const int r = 4 * g + i;
          p0[r] *= __builtin_amdgcn_exp2f((gql - c0[i]) * 1.4426950408889634f - 4.0f); p1[r] *= __builtin_amdgcn_exp2f((gql - c1[i]) * 1.4426950408889634f - 4.0f); } }
      if (need_mask) {
#pragma unroll
        for (int r = 0; r < 16; ++r) { const int d0_ = dbase + (r & 3) + 8 * (r >> 2) + 4 * hi, d1_ = d0_ + 32;
          const bool ok0 = dir == 0 ? (d0_ <= 0) : (d0_ >= 0), ok1 = dir == 0 ? (d1_ <= 0) : (d1_ >= 0);
          p0[r] = ok0 ? p0[r] : 0.f; p1[r] = ok1 ? p1[r] : 0.f; }
      }
      l_reg += pack_p(p0, p1, pa0, pa1, pa2, pa3);
    } else {
      if (MODE == 2) {
        const int wmin = dk0 + 64 * j - wid * QBLK - 31, wmax = dk0 + 64 * j + 63 - wid * QBLK;
        if ((wmin > 256 && wmax <= 1024) || (wmax < -256 && wmin >= -1024)) {
#pragma unroll
          for (int r = 0; r < 16; ++r) { const float b = b16[(r & 3) + 4 * ((r >> 2) & 1)]; p0[r] += b; p1[r] += b; }
        } else dil_bias(p0, p1, dbase0 + 64 * j, hi);
      }
      float mn, alpha; partialSM(p0, p1, m_reg, mn, alpha);
      if (__any(alpha < 1.f)) { if (hi == 0) al_l[r32] = alpha; asm volatile("s_waitcnt lgkmcnt(0)" ::: "memory");
        for (int d = 0; d < 4; ++d) for (int r = 0; r < 16; ++r) o[d][r] *= al_l[crow(r, hi)]; }
      finishSM(p0, p1, alpha, l_reg, pa0, pa1, pa2, pa3);
    }
    SBAR();
    pv_d0(o, vb0 + vcur * (int)SHM_V, pa0, pa1, pa2, pa3);
    kc = kc == 2 ? 0 : kc + 1; vcur = vcur == NVB - 1 ? 0 : vcur + 1;
    if (MODE == 1) { if (more) { if (KP == 2) asm volatile("s_waitcnt vmcnt(2)" ::: "memory"); else asm volatile("s_waitcnt vmcnt(4)" ::: "memory"); } else asm volatile("s_waitcnt vmcnt(0)" ::: "memory");
      if (tid < 64 && j + 1 < NT) cs_l[((j + 1) & 1) * 64 + tid] = cst; }
    if (more) { if (NVB == 3) { if (KP == 2) WAITBAR(4); else WAITBAR(6); } else { if (KP == 2) WAITBAR(2); else WAITBAR(4); } }
    else WAITBAR(0);
  }
  if (hi == 0) li_l[r32] = l_reg; asm volatile("s_waitcnt lgkmcnt(0)" ::: "memory");
  float rli[16];
#pragma unroll
  for (int r = 0; r < 16; ++r) { const float lv = li_l[crow(r, hi)]; rli[r] = (MODE == 1) ? 1.0f / fmaxf(fabsf(lv), 1.0f) : __builtin_amdgcn_rcpf(lv); }
  store_o_tile(o, rli, Ob + (long)(wid * QBLK) * LDO, LDO, ldsl, wid, lane);
  __syncthreads();
#undef STAGE_K
#undef STAGE_V
}
template <int MODE, int LDQ, int LDK, int LDV>
__device__ __forceinline__ void flash_body3(const unsigned short* __restrict__ Qb, const unsigned short* __restrict__ Kh, const unsigned short* __restrict__ Vh, int NT, int dk0,
                                            unsigned short* Ob, int LDO, __attribute__((address_space(3))) unsigned char* ldsl, int tid) {
  typedef __attribute__((address_space(3))) unsigned LU;
  constexpr int DK = 128, SHM_KD = KVBLK * DK * 2, CPR = DK / 8;
  char* lds = (char*)ldsl;
  const int wid = __builtin_amdgcn_readfirstlane(tid >> 6), lane = tid & 63, r32 = lane & 31, hi = lane >> 5;
  char* K_lds = lds + 4 * SHM_V;
  float* ws = (float*)(lds + 4 * SHM_V + 4 * SHM_KD) + wid * 64; float* li_l = ws; float* al_l = ws + 32;
  float m_reg = -1e30f, l_reg = 0; f32x16 o[4] = {}; bf16x8 qr[8];
  const unsigned short* Qw = Qb + (long)(wid * QBLK + r32) * LDQ + hi * 8;
#pragma unroll
  for (int d0 = 0; d0 < 8; ++d0) qr[d0] = *reinterpret_cast<const bf16x8*>(Qw + d0 * 16);
  const int vb0 = (int)(uintptr_t)ldsl + v_rd_base(lane);
  const int dbase0 = dk0 - (wid * QBLK + r32);
  const int krow = tid / CPR, kch = (tid % CPR) ^ (krow & 7);
  const unsigned voffk = (unsigned)(krow * LDK) * 2u + (unsigned)kch * 16u;
  const int vkk = (tid >> 7) * 8 + ((tid >> 2) & 7), vk = (vkk & ~0xC) | ((vkk & 4) << 1) | ((vkk & 8) >> 1), vc = ((tid >> 5) & 3) * 32 + (tid & 3) * 8;
  const unsigned voffv = (unsigned)(vk * LDV + vc) * 2u;
  float b16[8];
#pragma unroll
  for (int i = 0; i < 8; ++i) b16[i] = (MODE == 2 && ((dbase0 + 4 * hi + (i & 3) + 8 * (i >> 2)) & 15) == 0) ? 0.f : -__builtin_inff();
  const char* kp = (const char*)Kh; const char* vp = (const char*)Vh; int ks = 0, vs = 0;
  LU* const kl0 = (LU*)(ldsl + 4 * SHM_V + wid * 1024); LU* const vl0 = (LU*)(ldsl + wid * 1024);
#define STAGE_K() do { _Pragma("unroll") for (int i_ = 0; i_ < 2; ++i_) __builtin_amdgcn_global_load_lds((const unsigned*)(kp + voffk + (unsigned)(i_ * 32) * (LDK * 2u)), kl0 + (ks * SHM_KD + i_ * 8192) / 4, 16, 0, 0); \
    kp += KVBLK * LDK * 2; ks = (ks + 1) & 3; } while (0)
#define STAGE_V() do { _Pragma("unroll") for (int i_ = 0; i_ < 2; ++i_) __builtin_amdgcn_global_load_lds((const unsigned*)(vp + voffv + (unsigned)(i_ * 32) * (LDV * 2u)), vl0 + (vs * SHM_V + i_ * 8192) / 4, 16, 0, 0); \
    vp += KVBLK * LDV * 2; vs = (vs + 1) & 3; } while (0)
#define RESC(a) do { if (__any((a) < 1.f)) { if (hi == 0) al_l[r32] = (a); asm volatile("s_waitcnt lgkmcnt(0)" ::: "memory"); \
    for (int d = 0; d < 4; ++d) for (int r = 0; r < 16; ++r) o[d][r] *= al_l[crow(r, hi)]; } } while (0)
#define BIAS(P0, P1, t) do { if (MODE == 2) { const int wmin_ = dk0 + 64 * (t) - wid * QBLK - 31, wmax_ = dk0 + 64 * (t) + 63 - wid * QBLK; \
    if ((wmin_ > 256 && wmax_ <= 1024) || (wmax_ < -256 && wmin_ >= -1024)) { _Pragma("unroll") for (int r_ = 0; r_ < 16; ++r_) { const float b_ = b16[(r_ & 3) + 4 * ((r_ >> 2) & 1)]; P0[r_] += b_; P1[r_] += b_; } } \
    else dil_bias(P0, P1, dbase0 + 64 * (t), hi); } } while (0)
  f32x16 pA0, pA1, pB0, pB1; float mnA, mnB, alA, alB; bf16x8 pa0, pa1, pa2, pa3;
  STAGE_K(); STAGE_K(); STAGE_K(); STAGE_V(); STAGE_V();
  WAITBAR(0);
  qkt_dk<DK>(pA0, pA1, K_lds, qr, r32, hi); BIAS(pA0, pA1, 0); partialSM(pA0, pA1, m_reg, mnA, alA);
  asm volatile("s_waitcnt lgkmcnt(0)" ::: "memory"); __builtin_amdgcn_s_barrier(); asm volatile("" ::: "memory");
  int kn = 1, vcur = 0;
  for (int j = 0; j < NT; j += 2) {
    if (j + 3 < NT) STAGE_K(); if (j + 4 < NT) STAGE_K(); if (j + 2 < NT) STAGE_V(); if (j + 3 < NT) STAGE_V();
    SBAR(); qkt_dk<DK>(pB0, pB1, K_lds + kn * SHM_KD, qr, r32, hi); kn = (kn + 1) & 3;
    finishSM(pA0, pA1, alA, l_reg, pa0, pa1, pa2, pa3); SBAR();
    pv_d0(o, vb0 + vcur * (int)SHM_V, pa0, pa1, pa2, pa3); vcur = (vcur + 1) & 3;
    BIAS(pB0, pB1, j + 1); partialSM(pB0, pB1, m_reg, mnB, alB); RESC(alB);
    const bool m2 = j + 2 < NT;
    SBAR(); if (m2) { qkt_dk<DK>(pA0, pA1, K_lds + kn * SHM_KD, qr, r32, hi); kn = (kn + 1) & 3; }
    finishSM(pB0, pB1, alB, l_reg, pa0, pa1, pa2, pa3); SBAR();
    pv_d0(o, vb0 + vcur * (int)SHM_V, pa0, pa1, pa2, pa3); vcur = (vcur + 1) & 3;
    if (m2) { BIAS(pA0, pA1, j + 2); partialSM(pA0, pA1, m_reg, mnA, alA); RESC(alA); }
    WAITBAR(0);
  }
  if (hi == 0) li_l[r32] = l_reg; asm volatile("s_waitcnt lgkmcnt(0)" ::: "memory");
  float rli[16];
#pragma unroll
  for (int r = 0; r < 16; ++r) rli[r] = __builtin_amdgcn_rcpf(li_l[crow(r, hi)]);
  store_o_tile(o, rli, Ob + (long)(wid * QBLK) * LDO, LDO, ldsl, wid, lane);
  __syncthreads();
#undef STAGE_K
#undef STAGE_V
#undef RESC
#undef BIAS
}
template <int MODE, int LDQ, int LDK, int LDV>
__device__ __forceinline__ void flash_body2(const unsigned short* __restrict__ Qb, const unsigned short* __restrict__ Kh, const unsigned short* __restrict__ Vh, int NT, int dk0,
                                            unsigned short* Ob, int LDO, __attribute__((address_space(3))) unsigned char* ldsl, int tid) {
  typedef __attribute__((address_space(3))) unsigned LU;
  constexpr int DK = 128, SHM_KD = KVBLK * DK * 2, CPR = DK / 8;
  char* lds = (char*)ldsl;
  const int wid = __builtin_amdgcn_readfirstlane(tid >> 6), lane = tid & 63, r32 = lane & 31, hi = lane >> 5;
  char* K_lds = lds + 3 * SHM_V;
  float* ws = (float*)(lds + 3 * SHM_V + 3 * SHM_KD) + wid * 64; float* li_l = ws; float* al_l = ws + 32;
  float m_reg = -1e30f, l_reg = 0; f32x16 o[4] = {}; bf16x8 qr[8];
  const unsigned short* Qw = Qb + (long)(wid * QBLK + r32) * LDQ + hi * 8;
#pragma unroll
  for (int d0 = 0; d0 < 8; ++d0) qr[d0] = *reinterpret_cast<const bf16x8*>(Qw + d0 * 16);
  const int vb0 = (int)(uintptr_t)ldsl + v_rd_base(lane);
  const int dbase0 = dk0 - (wid * QBLK + r32);
  const int krow = tid / CPR, kch = (tid % CPR) ^ (krow & 7);
  const unsigned voffk = (unsigned)(krow * LDK) * 2u + (unsigned)kch * 16u;
  const int vkk = (tid >> 7) * 8 + ((tid >> 2) & 7), vk = (vkk & ~0xC) | ((vkk & 4) << 1) | ((vkk & 8) >> 1), vc = ((tid >> 5) & 3) * 32 + (tid & 3) * 8;
  const unsigned voffv = (unsigned)(vk * LDV + vc) * 2u;
  const char* kp = (const char*)Kh; const char* vp = (const char*)Vh; int ks = 0, vs = 0;
  LU* const kl0 = (LU*)(ldsl + 3 * SHM_V + wid * 1024); LU* const vl0 = (LU*)(ldsl + wid * 1024);
#define STAGE_K() do { _Pragma("unroll") for (int i_ = 0; i_ < 2; ++i_) __builtin_amdgcn_global_load_lds((const unsigned*)(kp + voffk + (unsigned)(i_ * 32) * (LDK * 2u)), kl0 + (ks * SHM_KD + i_ * 8192) / 4, 16, 0, 0); \
    kp += KVBLK * LDK * 2; ks = ks == 2 ? 0 : ks + 1; } while (0)
#define STAGE_V() do { _Pragma("unroll") for (int i_ = 0; i_ < 2; ++i_) __builtin_amdgcn_global_load_lds((const unsigned*)(vp + voffv + (unsigned)(i_ * 32) * (LDV * 2u)), vl0 + (vs * SHM_V + i_ * 8192) / 4, 16, 0, 0); \
    vp += KVBLK * LDV * 2; vs = vs == 2 ? 0 : vs + 1; } while (0)
#define RESC(a) do { if (__any((a) < 1.f)) { if (hi == 0) al_l[r32] = (a); asm volatile("s_waitcnt lgkmcnt(0)" ::: "memory"); \
    for (int d = 0; d < 4; ++d) for (int r = 0; r < 16; ++r) o[d][r] *= al_l[crow(r, hi)]; } } while (0)
#define BIAS(P0, P1, t) do { if (MODE == 2) dil_bias(P0, P1, dbase0 + 64 * (t), hi); } while (0)
  f32x16 pA0, pA1, pB0, pB1; float mnA, mnB, alA, alB; bf16x8 pa0, pa1, pa2, pa3;
  STAGE_K(); STAGE_V(); STAGE_K(); STAGE_K(); STAGE_V();
  WAITBAR(4);
  qkt_dk<DK>(pA0, pA1, K_lds, qr, r32, hi); BIAS(pA0, pA1, 0); partialSM(pA0, pA1, m_reg, mnA, alA);
  asm volatile("s_waitcnt lgkmcnt(0)" ::: "memory"); __builtin_amdgcn_s_barrier(); asm volatile("" ::: "memory");
  int kn = 1, vcur = 0;
  for (int j = 0; j < NT; j += 2) {
    const bool m3 = j + 3 < NT, m2 = j + 2 < NT;
    if (m3) STAGE_K(); if (m2) STAGE_V();
    SBAR(); qkt_dk<DK>(pB0, pB1, K_lds + kn * SHM_KD, qr, r32, hi); kn = kn == 2 ? 0 : kn + 1;
    finishSM(pA0, pA1, alA, l_reg, pa0, pa1, pa2, pa3); SBAR();
    pv_d0(o, vb0 + vcur * (int)SHM_V, pa0, pa1, pa2, pa3); vcur = vcur == 2 ? 0 : vcur + 1;
    BIAS(pB0, pB1, j + 1); partialSM(pB0, pB1, m_reg, mnB, alB); RESC(alB);
    if (m3) WAITBAR(4); else if (m2) WAITBAR(2); else WAITBAR(0);
    const bool n3 = j + 4 < NT, n2 = j + 3 < NT;
    if (n3) STAGE_K(); if (n2) STAGE_V();
    SBAR(); if (m2) { qkt_dk<DK>(pA0, pA1, K_lds + kn * SHM_KD, qr, r32, hi); kn = kn == 2 ? 0 : kn + 1; }
    finishSM(pB0, pB1, alB, l_reg, pa0, pa1, pa2, pa3); SBAR();
    pv_d0(o, vb0 + vcur * (int)SHM_V, pa0, pa1, pa2, pa3); vcur = vcur == 2 ? 0 : vcur + 1;
    if (m2) { BIAS(pA0, pA1, j + 2); partialSM(pA0, pA1, m_reg, mnA, alA); RESC(alA); }
    if (n3) WAITBAR(4); else if (n2) WAITBAR(2); else WAITBAR(0);
  }
  if (hi == 0) li_l[r32] = l_reg; asm volatile("s_waitcnt lgkmcnt(0)" ::: "memory");
  float rli[16];
#pragma unroll
  for (int r = 0; r < 16; ++r) rli[r] = __builtin_amdgcn_rcpf(li_l[crow(r, hi)]);
  store_o_tile(o, rli, Ob + (long)(wid * QBLK) * LDO, LDO, ldsl, wid, lane);
  __syncthreads();
#undef STAGE_K
#undef STAGE_V
#undef RESC
#undef BIAS
}
#undef WAITBAR
#undef KSWZ
#undef SBAR
}
__device__ __forceinline__ int ml_state_index(int sq, int h, int dir, int c) { return sq < B_P ? ((sq * 4 + h) * 2 + dir) * 8 + c : 512 + (((sq - B_P) * 4 + h) * 2 + dir) * 16 + c; }
__device__ __forceinline__ void prep_mlstm_states(const Ctx& C, int l) {
    using att::bf16x8; using att::s16x4; using att::f32x16;
    const bf16* proj = (const bf16*)(C.ws + WS_PROJ); const float* gates = (const float*)(C.ws + WS_GATES); const float* gb = C.a->in[I_MLGB] + l * 16;
    bf16* cst = (bf16*)(C.ws + WS_CST); float* nstb = (float*)(C.ws + WS_NST);
    char* ldsg = (char*)C.lds; LAS float* wts = (LAS float*)(C.lds + 49152); LAS float* tot = wts + 256;
    const int wid = C.wave, lane = C.lane, r32 = lane & 31, hi = lane >> 5;
    const int vbK = (int)(uintptr_t)C.lds + (wid >> 2) * 16384 + (wid & 3) * 512 + att::v_rd_base(lane);
    const int vbV = (int)(uintptr_t)C.lds + 32768 + att::v_rd_base(lane);
    for (int it = C.bid; it < 192; it += C.G) {
        const int eh = it & 1, dir = (it >> 1) & 1, h = (it >> 2) & 3, sq = it >> 4;
        const int L = sq < B_P ? L_P : L_S, row0 = sq < B_P ? sq * L_P : TOK_P + (sq - B_P) * L_S, nc = L / 256;
        const float bi = gb[(2 * dir) * 4 + h], bf_ = gb[(2 * dir + 1) * 4 + h];
        f32x16 acc[4] = {}; f32x16 nacc = {};
        for (int ci = 0; ci < nc; ++ci) {
            const int c = dir == 0 ? ci : nc - 1 - ci; const int st = ml_state_index(sq, h, dir, c);
            { bf16* ct = cst + (size_t)st * 65536 + (size_t)(eh * 128) * 256;
#pragma unroll
              for (int eb = 0; eb < 4; ++eb)
#pragma unroll
                for (int g = 0; g < 4; ++g) { v2u w; w.x = pk2(acc[eb][4 * g], acc[eb][4 * g + 1]); w.y = pk2(acc[eb][4 * g + 2], acc[eb][4 * g + 3]);
                    *(v2u*)(ct + (size_t)(eb * 32 + r32) * 256 + wid * 32 + 8 * g + 4 * hi) = w; }
              if (eh == 0 && r32 == 0) { float* np = nstb + (size_t)st * 256 + wid * 32;
#pragma unroll
                for (int r = 0; r < 16; ++r) np[(r & 3) + 8 * (r >> 2) + 4 * hi] = nacc[r]; } }
            if (ci == nc - 1) break;
            __syncthreads();
            float T;
            { float x = 0.f, gi = 0.f;
              if (C.tid < 256) { const int tl = dir == 0 ? C.tid : 255 - C.tid; const size_t row = (size_t)row0 + 256 * c + tl;
                  gi = gates[row * 16 + (2 * dir) * 4 + h] + bi; const float gf = gates[row * 16 + (2 * dir + 1) * 4 + h] + bf_;
                  x = fminf(gf, 0.f) - log1pf(__expf(-fabsf(gf))); }
              const float lf = x;
#pragma unroll
              for (int o = 1; o < 64; o <<= 1) { const float y = __shfl_up(x, o); if (lane >= o) x += y; }
              if (C.tid < 256 && lane == 63) tot[wid] = x;
              __syncthreads();
              float pre = 0.f; for (int w = 0; w < 4; ++w) { const float tw = tot[w]; if (w < wid) pre += tw; }
              T = tot[0] + tot[1] + tot[2] + tot[3];
              if (C.tid < 256) { const float incl = x + pre; const int tl = dir == 0 ? C.tid : 255 - C.tid;
                  wts[tl] = __expf(T - incl + gi) * 0.0625f; (void)lf; }
            }
            __syncthreads();
            { const float aT = __expf(T);
#pragma unroll
              for (int eb = 0; eb < 4; ++eb) acc[eb] = acc[eb] * aT;
              nacc = nacc * aT; }
            const bf16* kb = proj + (size_t)(row0 + 256 * c) * NPROJ + C_DK + h * 256; const bf16* vb = proj + (size_t)(row0 + 256 * c) * NPROJ + C_DV + h * 256 + eh * 128;
            v4u kreg[4], vreg[2];
#define ST_LOAD(kt_) do { _Pragma("unroll") for (int i = 0; i < 4; ++i) { const int id = C.tid + 512 * i, row = id >> 5, c16 = id & 31; kreg[i] = *(const v4u*)(kb + (size_t)(64 * (kt_) + row) * NPROJ + c16 * 8); } \
    _Pragma("unroll") for (int i = 0; i < 2; ++i) { const int id = C.tid + 512 * i, row = id >> 4, c16 = id & 15; vreg[i] = *(const v4u*)(vb + (size_t)(64 * (kt_) + row) * NPROJ + c16 * 8); } } while (0)
            ST_LOAD(0);
            for (int kt = 0; kt < 4; ++kt) {
#pragma unroll
                for (int i = 0; i < 4; ++i) { const int id = C.tid + 512 * i, row = id >> 5, c16 = id & 31; const float w = wts[64 * kt + row]; const unsigned kw[4] = {kreg[i].x, kreg[i].y, kreg[i].z, kreg[i].w}; v4u o;
                    o.x = pk2(bflo(kw[0]) * w, bfhi(kw[0]) * w); o.y = pk2(bflo(kw[1]) * w, bfhi(kw[1]) * w); o.z = pk2(bflo(kw[2]) * w, bfhi(kw[2]) * w); o.w = pk2(bflo(kw[3]) * w, bfhi(kw[3]) * w);
                    *(v4u*)(ldsg + (c16 >> 4) * 16384 + att::v_st(row, (c16 & 15) * 8)) = o; }
#pragma unroll
                for (int i = 0; i < 2; ++i) { const int id = C.tid + 512 * i, row = id >> 4, c16 = id & 15; *(v4u*)(ldsg + 32768 + att::v_st(row, c16 * 8)) = vreg[i]; }
                if (kt + 1 < 4) ST_LOAD(kt + 1);
                __syncthreads();
#pragma unroll
                for (int ks = 0; ks < 4; ++ks) {
                    s16x4 al, ah;
                    if (ks == 0) { al = att::tr_read<att::v_rd_off(0, 0, 0)>(vbK); ah = att::tr_read<att::v_rd_off(0, 0, 1)>(vbK); }
                    else if (ks == 1) { al = att::tr_read<att::v_rd_off(0, 1, 0)>(vbK); ah = att::tr_read<att::v_rd_off(0, 1, 1)>(vbK); }
                    else if (ks == 2) { al = att::tr_read<att::v_rd_off(0, 2, 0)>(vbK); ah = att::tr_read<att::v_rd_off(0, 2, 1)>(vbK); }
                    else { al = att::tr_read<att::v_rd_off(0, 3, 0)>(vbK); ah = att::tr_read<att::v_rd_off(0, 3, 1)>(vbK); }
                    s16x4 bl[4], bh[4];
#define RDB(EB) do { if (ks == 0) { bl[EB] = att::tr_read<att::v_rd_off(EB, 0, 0)>(vbV); bh[EB] = att::tr_read<att::v_rd_off(EB, 0, 1)>(vbV); } \
                     else if (ks == 1) { bl[EB] = att::tr_read<att::v_rd_off(EB, 1, 0)>(vbV); bh[EB] = att::tr_read<att::v_rd_off(EB, 1, 1)>(vbV); } \
                     else if (ks == 2) { bl[EB] = att::tr_read<att::v_rd_off(EB, 2, 0)>(vbV); bh[EB] = att::tr_read<att::v_rd_off(EB, 2, 1)>(vbV); } \
                     else { bl[EB] = att::tr_read<att::v_rd_off(EB, 3, 0)>(vbV); bh[EB] = att::tr_read<att::v_rd_off(EB, 3, 1)>(vbV); } } while (0)
                    RDB(0); RDB(1); RDB(2); RDB(3);
#undef RDB
                    asm volatile("s_waitcnt lgkmcnt(0)" ::: "memory"); __builtin_amdgcn_sched_barrier(0);
                    const bf16x8 a = (bf16x8){al[0], al[1], al[2], al[3], ah[0], ah[1], ah[2], ah[3]};
                    const bf16x8 ones = (bf16x8){0x3f80, 0x3f80, 0x3f80, 0x3f80, 0x3f80, 0x3f80, 0x3f80, 0x3f80};
#pragma unroll
                    for (int eb = 0; eb < 4; ++eb) { const bf16x8 b = (bf16x8){bl[eb][0], bl[eb][1], bl[eb][2], bl[eb][3], bh[eb][0], bh[eb][1], bh[eb][2], bh[eb][3]};
                        acc[eb] = __builtin_amdgcn_mfma_f32_32x32x16_bf16(a, b, acc[eb], 0, 0, 0); }
                    nacc = __builtin_amdgcn_mfma_f32_32x32x16_bf16(a, ones, nacc, 0, 0, 0);
                }
                __syncthreads();
            }
#undef ST_LOAD
        }
    }
    __syncthreads();
}
namespace hy {
typedef float f32x2 __attribute__((ext_vector_type(2)));
typedef __attribute__((address_space(3))) f32x2 LF2;
__device__ __forceinline__ int phys(int i) { return i + (i >> 4); }
__device__ constexpr float ROT_C[8] = {1.0f, 0.9238795325112867f, 0.7071067811865476f, 0.3826834323650898f, 0.0f, -0.3826834323650898f, -0.7071067811865476f, -0.9238795325112867f};
__device__ constexpr float ROT_S[8] = {0.0f, 0.3826834323650898f, 0.7071067811865476f, 0.9238795325112867f, 1.0f, 0.9238795325112867f, 0.7071067811865476f, 0.3826834323650898f};
template <int K, bool INV> __device__ __forceinline__ void fft_pass(LF2* X, int logN, int s, int tid) {
    constexpr int R = 1 << K; const int lq = logN - s - K, q = 1 << lq; const float rms = 1.0f / (float)(q << K);
    for (int g = tid; g < (1 << (logN - K)); g += NTHR) {
        const int p = g & (q - 1), i0 = ((g >> lq) << (lq + K)) + p;
        f32x2 v[R];
#pragma unroll
        for (int e = 0; e < R; ++e) v[e] = X[phys(i0 + e * q)];
        float wc[K], wsn[K];
        { const float f = (float)p * rms; wc[0] = __builtin_amdgcn_cosf(f); wsn[0] = __builtin_amdgcn_sinf(f);
#pragma unroll
          for (int j = 1; j < K; ++j) { wc[j] = wc[j - 1] * wc[j - 1] - wsn[j - 1] * wsn[j - 1]; wsn[j] = 2.0f * wc[j - 1] * wsn[j - 1]; } }
#pragma unroll
        for (int jj = 0; jj < K; ++jj) { const int j = INV ? K - 1 - jj : jj; const int dist = R >> (j + 1);
#pragma unroll
            for (int e = 0; e < R; ++e) if (((e / dist) & 1) == 0) { const int a = e, b = e + dist; const int t8 = (a % dist) * (8 / dist);
                const float cr = ROT_C[t8], sr = ROT_S[t8]; const float c = wc[j] * cr - wsn[j] * sr, sn = wsn[j] * cr + wc[j] * sr;
                if (!INV) { const f32x2 t = v[a] - v[b]; v[a] = v[a] + v[b]; v[b] = (f32x2){t.x * c + t.y * sn, t.y * c - t.x * sn}; }
                else { const f32x2 t = (f32x2){v[b].x * c - v[b].y * sn, v[b].y * c + v[b].x * sn}; v[b] = v[a] - t; v[a] = v[a] + t; } }
        }
#pragma unroll
        for (int e = 0; e < R; ++e) X[phys(i0 + e * q)] = v[e];
    }
}
__device__ __forceinline__ void fft_fwd(LF2* X, int logN, int tid) {
    int s; if (logN == 13) { fft_pass<4, false>(X, logN, 0, tid); s = 4; } else { fft_pass<3, false>(X, logN, 0, tid); s = 3; }
    __syncthreads();
    for (; s < logN; s += 3) { fft_pass<3, false>(X, logN, s, tid); __syncthreads(); }
}
__device__ __forceinline__ void fft_inv(LF2* X, int logN, int tid) {
    const int s0 = logN == 13 ? 4 : 3;
    for (int s = logN - 3; s >= s0; s -= 3) { fft_pass<3, true>(X, logN, s, tid); __syncthreads(); }
    if (logN == 13) fft_pass<4, true>(X, logN, 0, tid); else fft_pass<3, true>(X, logN, 0, tid);
    __syncthreads();
}
template <int LOGN>
__device__ __forceinline__ void hyena_fft_unit_t(const Ctx& C, int l, int c) {
    constexpr int N = 1 << LOGN, L = N / 2, NB = LOGN == 13 ? B_S : B_P, row0 = LOGN == 13 ? TOK_P : 0, XB = (N + N / 16) * 8, NH = N / NTHR;
    LF2* X0 = (LF2*)C.lds; LF2* X1 = (LF2*)(C.lds + XB);
    bf16* uct = (bf16*)(C.ws + WS_UCT); const float* hfil = (const float*)(C.ws + WS_HFIL) + (LOGN == 13 ? (size_t)2048 * L_P : 0); const float* skip = C.a->in[I_HSKIP] + l * 2048;
    const float rn = 1.0f / (float)N;
    f32x2* hsp = (f32x2*)(C.ws + WS_HSP + (size_t)C.bid * 131072);
    { const float* h0 = hfil + (size_t)c * L; const float* h1 = hfil + (size_t)(1024 + c) * L;
      __syncthreads();
      for (int n = C.tid; n < N; n += NTHR) X0[phys(n)] = n < L ? (f32x2){h0[n], h1[n]} : (f32x2){0.f, 0.f};
      __syncthreads();
      fft_fwd(X0, LOGN, C.tid);
      const float hr = 0.5f * rn;
#pragma unroll 2
      for (int p = C.tid; p < N; p += NTHR) { const int kn = (int)(__builtin_bitreverse32((unsigned)p) >> (32 - LOGN)), p2 = (int)(__builtin_bitreverse32((unsigned)((N - kn) & (N - 1))) >> (32 - LOGN));
          const f32x2 z1 = X0[phys(p)], z2 = X0[phys(p2)];
          hsp[p] = (f32x2){(z1.x + z2.x) * hr, (z1.y - z2.y) * hr}; hsp[8192 + p] = (f32x2){(z1.y + z2.y) * hr, (z2.x - z1.x) * hr}; } }
    for (int o = 0; o < 2; ++o) {
        const float sk = skip[o * 1024 + c];
        f32x2 hf[NH];
#pragma unroll
        for (int k = 0; k < NH; ++k) hf[k] = hsp[o * 8192 + C.tid + NTHR * k];
        bf16* src = uct + (size_t)c * NTOK + row0; const bf16* gate = uct + (size_t)((o + 1) * 1024 + c) * NTOK + row0; bf16* dst = o == 0 ? src : uct + (size_t)(1024 + c) * NTOK + row0;
        for (int pp = 0; pp < NB / 4; ++pp) {
            __syncthreads();
            const int n0 = 8 * C.tid; const bool act = n0 < L;
            v4u sa[2], sb[2], qa[2], qb[2];
#pragma unroll
            for (int w = 0; w < 2; ++w) { const int t1 = (4 * pp + 2 * w) * L, t2 = t1 + L; if (act) { sa[w] = *(const v4u*)(src + t1 + n0); sb[w] = *(const v4u*)(src + t2 + n0); } }
#pragma unroll
            for (int w = 0; w < 2; ++w) { const int t1 = (4 * pp + 2 * w) * L, t2 = t1 + L; if (act) { qa[w] = *(const v4u*)(gate + t1 + n0); qb[w] = *(const v4u*)(gate + t2 + n0); } }
#pragma unroll
            for (int w = 0; w < 2; ++w) { LF2* X = w ? X1 : X0;
                for (int n8 = C.tid; n8 < N / 8; n8 += NTHR) { const int n = 8 * n8;
                    if (n < L) { const unsigned aw[4] = {sa[w].x, sa[w].y, sa[w].z, sa[w].w}, bw[4] = {sb[w].x, sb[w].y, sb[w].z, sb[w].w};
#pragma unroll
                        for (int k = 0; k < 4; ++k) { X[phys(n + 2 * k)] = (f32x2){bflo(aw[k]), bflo(bw[k])}; X[phys(n + 2 * k + 1)] = (f32x2){bfhi(aw[k]), bfhi(bw[k])}; } }
                    else {
#pragma unroll
                        for (int k = 0; k < 8; ++k) X[phys(n + k)] = (f32x2){0.f, 0.f}; } } }
            __syncthreads();
            { int s; if (LOGN == 13) { fft_pass<4, false>(X0, LOGN, 0, C.tid); fft_pass<4, false>(X1, LOGN, 0, C.tid); s = 4; } else { fft_pass<3, false>(X0, LOGN, 0, C.tid); fft_pass<3, false>(X1, LOGN, 0, C.tid); s = 3; }
              __syncthreads();
              for (; s < LOGN; s += 3) { fft_pass<3, false>(X0, LOGN, s, C.tid); fft_pass<3, false>(X1, LOGN, s, C.tid); __syncthreads(); } }
#pragma unroll
            for (int k = 0; k < NH; ++k) { const int i = phys(C.tid + NTHR * k); const f32x2 b = hf[k]; const f32x2 a0 = X0[i], a1 = X1[i];
                X0[i] = (f32x2){a0.x * b.x - a0.y * b.y, a0.x * b.y + a0.y * b.x}; X1[i] = (f32x2){a1.x * b.x - a1.y * b.y, a1.x * b.y + a1.y * b.x}; }
            __syncthreads();
            { const int s0 = LOGN == 13 ? 4 : 3;
              for (int s = LOGN - 3; s >= s0; s -= 3) { fft_pass<3, true>(X0, LOGN, s, C.tid); fft_pass<3, true>(X1, LOGN, s, C.tid); __syncthreads(); }
              if (LOGN == 13) { fft_pass<4, true>(X0, LOGN, 0, C.tid); fft_pass<4, true>(X1, LOGN, 0, C.tid); } else { fft_pass<3, true>(X0, LOGN, 0, C.tid); fft_pass<3, true>(X1, LOGN, 0, C.tid); }
              __syncthreads(); }
#pragma unroll
            for (int w = 0; w < 2; ++w) { const LF2* X = w ? X1 : X0; const int t1 = (4 * pp + 2 * w) * L, t2 = t1 + L;
                if (act) { const int t = n0;
                    const v4u ua = sa[w], ub = sb[w], ga = qa[w], gb = qb[w];
                    const unsigned uaw[4] = {ua.x, ua.y, ua.z, ua.w}, ubw[4] = {ub.x, ub.y, ub.z, ub.w}, gaw[4] = {ga.x, ga.y, ga.z, ga.w}, gbw[4] = {gb.x, gb.y, gb.z, gb.w}; unsigned ra[4], rb[4];
#pragma unroll
                    for (int k = 0; k < 4; ++k) { const f32x2 y0 = X[phys(t + L / 2 + 2 * k)], y1 = X[phys(t + L / 2 + 2 * k + 1)];
                        ra[k] = pk2(bflo(gaw[k]) * (y0.x + sk * bflo(uaw[k])), bfhi(gaw[k]) * (y1.x + sk * bfhi(uaw[k])));
                        rb[k] = pk2(bflo(gbw[k]) * (y0.y + sk * bflo(ubw[k])), bfhi(gbw[k]) * (y1.y + sk * bfhi(ubw[k]))); }
                    *(v4u*)(dst + t1 + t) = (v4u){ra[0], ra[1], ra[2], ra[3]}; *(v4u*)(dst + t2 + t) = (v4u){rb[0], rb[1], rb[2], rb[3]}; } }
        }
    }
    __syncthreads();
}
__device__ __forceinline__ void hyena_fft_unit(const Ctx& C, int l, int c, int grp) { if (grp) hyena_fft_unit_t<13>(C, l, c); else hyena_fft_unit_t<12>(C, l, c); }
}
template <int DK, int DV, int KT, int MODE>
__device__ __forceinline__ void valu_attn_item(const Ctx& C, const bf16* Qp, int ldq, const bf16* Kp, int ldk, const bf16* Vp, int ldv, int q0, int kt_lo, int kt_hi, float qscale,
                                               const float* gcum, const float* gli, int dir, bf16* outb, float* outf, int ldo) {
    constexpr int QD = DK / 4, VD = DV / 4;
    LAS float* Ks = (LAS float*)C.lds; LAS float* Vs = Ks + KT * DK; LAS float* Gs = Vs + KT * DV;
    const int qi = C.tid >> 2, part = C.tid & 3, tq = q0 + qi;
    float q[QD], o[VD];
    { const bf16* qp = Qp + (size_t)tq * ldq + part * QD;
#pragma unroll
      for (int j = 0; j < QD; j += 8) { const v4u w = *(const v4u*)(qp + j);
          q[j] = bflo(w.x) * qscale; q[j + 1] = bfhi(w.x) * qscale; q[j + 2] = bflo(w.y) * qscale; q[j + 3] = bfhi(w.y) * qscale; q[j + 4] = bflo(w.z) * qscale; q[j + 5] = bfhi(w.z) * qscale; q[j + 6] = bflo(w.w) * qscale; q[j + 7] = bfhi(w.w) * qscale; } }
#pragma unroll
    for (int j = 0; j < VD; ++j) o[j] = 0.f;
    float m = -1e30f, lsum = 0.f; const float gq = (MODE == 1) ? gcum[tq] : 0.f;
    for (int kt = kt_lo; kt < kt_hi; ++kt) {
        __syncthreads();
        for (int idx = C.tid; idx < KT * DK / 8; idx += NTHR) { const int s = idx / (DK / 8), c8 = idx % (DK / 8); const v4u w = *(const v4u*)(Kp + (size_t)(kt * KT + s) * ldk + c8 * 8);
            LAS f32x4* d = (LAS f32x4*)(Ks + s * DK + c8 * 8); d[0] = (f32x4){bflo(w.x), bfhi(w.x), bflo(w.y), bfhi(w.y)}; d[1] = (f32x4){bflo(w.z), bfhi(w.z), bflo(w.w), bfhi(w.w)}; }
        for (int idx = C.tid; idx < KT * DV / 8; idx += NTHR) { const int s = idx / (DV / 8), c8 = idx % (DV / 8); const v4u w = *(const v4u*)(Vp + (size_t)(kt * KT + s) * ldv + c8 * 8);
            LAS f32x4* d = (LAS f32x4*)(Vs + s * DV + c8 * 8); d[0] = (f32x4){bflo(w.x), bfhi(w.x), bflo(w.y), bfhi(w.y)}; d[1] = (f32x4){bflo(w.z), bfhi(w.z), bflo(w.w), bfhi(w.w)}; }
        if (MODE == 1 && C.tid < KT) { Gs[2 * C.tid] = gcum[kt * KT + C.tid]; Gs[2 * C.tid + 1] = gli[kt * KT + C.tid]; }
        __syncthreads();
        for (int s = 0; s < KT; ++s) {
            const LAS f32x4* kr = (const LAS f32x4*)(Ks + s * DK + part * QD); float dot = 0.f;
#pragma unroll
            for (int j = 0; j < QD / 4; ++j) { const f32x4 kv = kr[j]; dot += (q[4 * j] * kv.x + q[4 * j + 1] * kv.y) + (q[4 * j + 2] * kv.z + q[4 * j + 3] * kv.w); }
            dot += __shfl_xor(dot, 1); dot += __shfl_xor(dot, 2);
            const int ks = kt * KT + s; float p;
            if (MODE == 1) { const bool ok = dir == 0 ? (ks <= tq) : (ks >= tq); p = ok ? dot * __expf(gq - Gs[2 * s] + Gs[2 * s + 1]) : 0.f; lsum += p; }
            else {
                float mult = 1.f;
                if (MODE == 2) { const int dl = ks - tq, ad = dl < 0 ? -dl : dl; mult = (ad <= 64 ? 1.f : 0.f) + (((dl & 3) == 0 && ad <= 256) ? 1.f : 0.f) + (((dl & 15) == 0 && ad <= 1024) ? 1.f : 0.f); }
                if (mult > 0.f) {
                    if (dot > m) { const float al = __expf(m - dot); lsum *= al;
#pragma unroll
                        for (int j = 0; j < VD; ++j) o[j] *= al;
                        m = dot; }
                    p = mult * __expf(dot - m); lsum += p;
                } else p = 0.f;
            }
            const LAS f32x4* vr = (const LAS f32x4*)(Vs + s * DV + part * VD);
#pragma unroll
            for (int j = 0; j < VD / 4; ++j) { const f32x4 vv = vr[j]; o[4 * j] += p * vv.x; o[4 * j + 1] += p * vv.y; o[4 * j + 2] += p * vv.z; o[4 * j + 3] += p * vv.w; }
        }
    }
    const float inv = (MODE == 1) ? 1.0f / fmaxf(fabsf(lsum), 1.0f) : 1.0f / lsum;
    if (MODE == 1) { float* op = outf + (size_t)tq * ldo + part * VD;
#pragma unroll
        for (int j = 0; j < VD; j += 4) *(f32x4*)(op + j) = (f32x4){o[j] * inv, o[j + 1] * inv, o[j + 2] * inv, o[j + 3] * inv}; }
    else { bf16* op = outb + (size_t)tq * ldo + part * VD;
#pragma unroll
        for (int j = 0; j < VD; j += 8) { v4u w; w.x = pk2(o[j] * inv, o[j + 1] * inv); w.y = pk2(o[j + 2] * inv, o[j + 3] * inv); w.z = pk2(o[j + 4] * inv, o[j + 5] * inv); w.w = pk2(o[j + 6] * inv, o[j + 7] * inv); *(v4u*)(op + j) = w; } }
}
__device__ __forceinline__ void hyena_direct_item(const Ctx& C, int l, int c, int row0, int L) {
    LAS float* su = (LAS float*)C.lds;
    LAS float* sz = su + 4096;
    LAS float* sh = sz + 4096;
    const bf16* uct = (const bf16*)(C.ws + WS_UCT); const float* hf = (const float*)(C.ws + WS_HFIL) + (L == L_S ? (size_t)2048 * L_P : 0);
    const float* skip = C.a->in[I_HSKIP] + l * 2048; bf16* y = (bf16*)(C.ws + WS_HA);
    const bf16* vch = uct + (size_t)c * NTOK + row0; const bf16* x1ch = uct + (size_t)(1024 + c) * NTOK + row0; const bf16* x2ch = uct + (size_t)(2048 + c) * NTOK + row0;
    __syncthreads();
    for (int t = C.tid; t < L; t += NTHR) su[t] = bf2f(vch[t]);
    for (int o = 0; o < 2; ++o) {
        const float* h = hf + (size_t)(o * 1024 + c) * L; const float sk = skip[o * 1024 + c];
        for (int i = C.tid; i < 2 * L; i += NTHR) { const int n = i - L / 2; sh[i] = (n >= 0 && n < L) ? h[n] : 0.f; }
        __syncthreads();
        const LAS float* in = o == 0 ? su : sz;
        if (C.tid < L / 8) {
            const int t0 = 8 * C.tid; float acc[8];
#pragma unroll
            for (int j = 0; j < 8; ++j) acc[j] = 0.f;
            for (int s8 = 0; s8 < L; s8 += 8) {
                const f32x4 ua = *(const LAS f32x4*)(in + s8), ub = *(const LAS f32x4*)(in + s8 + 4); const float uu[8] = {ua.x, ua.y, ua.z, ua.w, ub.x, ub.y, ub.z, ub.w};
                const LAS f32x4* hp = (const LAS f32x4*)(sh + (t0 - s8 + L - 8)); const f32x4 h0 = hp[0], h1 = hp[1], h2 = hp[2], h3 = hp[3];
                const float hh[16] = {h0.x, h0.y, h0.z, h0.w, h1.x, h1.y, h1.z, h1.w, h2.x, h2.y, h2.z, h2.w, h3.x, h3.y, h3.z, h3.w};
#pragma unroll
                for (int j = 0; j < 8; ++j)
#pragma unroll
                    for (int jj = 0; jj < 8; ++jj) acc[j] += uu[jj] * hh[8 + j - jj];
            }
            if (o == 0) {
#pragma unroll
                for (int j = 0; j < 8; ++j) { const int t = t0 + j; sz[t] = bf2f(x1ch[t]) * (acc[j] + sk * su[t]); }
            } else {
#pragma unroll
                for (int j = 0; j < 8; ++j) { const int t = t0 + j; y[(size_t)(row0 + t) * DM + 2048 + c] = (bf16)f2bf(bf2f(x2ch[t]) * (acc[j] + sk * sz[t])); }
            }
        }
        __syncthreads();
    }
}
__device__ __forceinline__ void c_transpose_chunk(const Ctx& C, int k) {
    LAS unsigned short* tile = (LAS unsigned short*)C.lds + C.wave * (64 * 72);
    const bf16* uct = (const bf16*)(C.ws + WS_UCT) + (size_t)1024 * NTOK; bf16* yy = (bf16*)(C.ws + WS_HA);
    { const int it = C.gw + k * C.NGW; if (it >= (NTOK / 64) * 16) return;
        const int tb = it >> 4, cbk = it & 15;
#pragma unroll
        for (int k = 0; k < 8; ++k) { const int id = C.lane + 64 * k, chw = id >> 3, part = id & 7; const v4u w = *(const v4u*)(uct + (size_t)(cbk * 64 + chw) * NTOK + tb * 64 + part * 8);
            *(LAS v4u*)(tile + chw * 72 + part * 8) = w; }
        LDS_WAIT(); asm volatile("" ::: "memory");
#pragma unroll
        for (int k = 0; k < 8; ++k) { const int id = C.lane + 64 * k, tok = id >> 3, cp = id & 7; unsigned short e[8];
#pragma unroll
            for (int j = 0; j < 8; ++j) e[j] = tile[(cp * 8 + j) * 72 + tok];
            v4u w; w.x = e[0] | ((unsigned)e[1] << 16); w.y = e[2] | ((unsigned)e[3] << 16); w.z = e[4] | ((unsigned)e[5] << 16); w.w = e[6] | ((unsigned)e[7] << 16);
            *(v4u*)(yy + (size_t)(tb * 64 + tok) * DM + 2048 + cbk * 64 + cp * 8) = w; }
        LDS_WAIT(); asm volatile("" ::: "memory");
    }
}
__device__ __forceinline__ void post_head(const Ctx& C, int l, int rb, int h) {
    const bf16* proj = (const bf16*)(C.ws + WS_PROJ); bf16* y = (bf16*)(C.ws + WS_HA); const bf16* dh = (const bf16*)(C.ws + WS_DH);
    const int col = h * 256 + 4 * C.lane; const f32x4 gv = *(const f32x4*)(C.a->in[I_MLNG] + l * 1024 + col);
#pragma nounroll
    for (int i = 0; i < 32; i += 4) {
        v2u a[4], b[4], o[4];
#pragma unroll
        for (int u = 0; u < 4; ++u) { const size_t row = (size_t)(rb + C.wave + 8 * (i + u));
            a[u] = *(const v2u*)(dh + row * 1024 + col); b[u] = *(const v2u*)(dh + (size_t)NTOK * 1024 + row * 1024 + col); o[u] = *(const v2u*)(proj + row * NPROJ + C_DO + col); }
#pragma unroll
        for (int u = 0; u < 4; ++u) { const size_t row = (size_t)(rb + C.wave + 8 * (i + u));
            const float h0 = bflo(a[u].x) + bflo(b[u].x), h1 = bfhi(a[u].x) + bfhi(b[u].x), h2 = bflo(a[u].y) + bflo(b[u].y), h3 = bfhi(a[u].y) + bfhi(b[u].y);
            const float ss = wave_sum((h0 * h0 + h1 * h1) + (h2 * h2 + h3 * h3));
            const float r = 1.0f / sqrtf(ss * (1.0f / 256.0f) + EPS);
            const float y0 = h0 * r * gv.x / (1.0f + __expf(-bflo(o[u].x))), y1 = h1 * r * gv.y / (1.0f + __expf(-bfhi(o[u].x))), y2 = h2 * r * gv.z / (1.0f + __expf(-bflo(o[u].y))), y3 = h3 * r * gv.w / (1.0f + __expf(-bfhi(o[u].y)));
            v2u w; w.x = pk2(y0, y1); w.y = pk2(y2, y3); *(v2u*)(y + row * DM + 3072 + col) = w; }
    }
}
__device__ __forceinline__ void phase_mix_d(const Ctx& C, int l) {
    const bf16* proj = (const bf16*)(C.ws + WS_PROJ); const float* gc = (const float*)(C.ws + WS_GCUM); bf16* dh = (bf16*)(C.ws + WS_DH);
    const bf16* cst = (const bf16*)(C.ws + WS_CST); const float* nstb = (const float*)(C.ws + WS_NST);
    LAS unsigned char* ldsg = C.lds;
    const int vcu = (C.G & 7) == 0 ? (C.bid & 7) * (C.G >> 3) + (C.bid >> 3) : C.bid;
    const int NI = ((NTOK / 64) * 16 + C.NGW - 1) / C.NGW; int kt = 0;
    for (int it2 = vcu; it2 < 512; it2 += C.G) {
        int sq, h, qb;
        { const int it = 2 * it2; if (it < 512) { sq = B_P + (it >> 7); h = (it >> 5) & 3; qb = (it >> 1) & 15; } else { const int r = it - 512; sq = r >> 6; h = (r >> 4) & 3; qb = (r >> 1) & 7; } }
        const int L = sq < B_P ? L_P : L_S, row0 = sq < B_P ? sq * L_P : TOK_P + (sq - B_P) * L_S, nc = L / 256; const bf16* base = proj + (size_t)row0 * NPROJ; const int q0 = qb * 256;
        for (int eh = 0; eh < 2; ++eh) {
            const bf16* Qb = base + (size_t)q0 * NPROJ + C_DQ + h * 256; const bf16* Kb = base + (size_t)q0 * NPROJ + C_DK + h * 256; const bf16* Vb = base + (size_t)q0 * NPROJ + C_DV + h * 256 + eh * 128;
            bf16* of = dh + (size_t)(row0 + q0) * 1024 + h * 256 + eh * 128;
            for (int dir = 0; dir < 2; ++dir) {
                const float* gcs = gc + (size_t)((2 * dir) * 4 + h) * NTOK + row0; const float* gls = gc + (size_t)((2 * dir + 1) * 4 + h) * NTOK + row0;
                const bool inter = dir == 0 ? (qb > 0) : (qb < nc - 1); const float gref = inter ? (dir == 0 ? gcs[q0 - 1] : gcs[q0 + 256]) : 0.f;
                const int st = ml_state_index(sq, h, dir, qb);
                att::flash_body<1, 256, NPROJ, NPROJ, NPROJ>(Qb, Kb, Vb, 4, 0, gcs + q0, gcs + q0, gls + q0, dir, inter ? cst + (size_t)st * 65536 + (size_t)(eh * 128) * 256 : nullptr, nstb + (size_t)st * 256, gref,
                                                             of + (size_t)dir * NTOK * 1024, 1024, ldsg, opaque_tid());
            }
            if (kt < NI) { const Ctx C2 = make_ctx(C.lds); c_transpose_chunk(C2, kt); ++kt; __syncthreads(); }
        }
        { const Ctx C2 = make_ctx(C.lds); post_head(C2, l, row0 + q0, h); }
    }
    for (; kt < NI; ++kt) { const Ctx C2 = make_ctx(C.lds); c_transpose_chunk(C2, kt); }
}
__device__ __forceinline__ void unit_decode(int u, int& sq, int& h, int& qb) { if (u < 512) { const int r = u; sq = B_P + (r >> 7); h = (r >> 4) & 7; qb = r & 15; } else { const int r = u - 512; sq = r >> 6; h = (r >> 3) & 7; qb = r & 7; } }
__device__ __forceinline__ void phase_mix_b(const Ctx& C, int l) {
    const bf16* proj = (const bf16*)(C.ws + WS_PROJ); bf16* y = (bf16*)(C.ws + WS_HA); LAS unsigned char* ldsg = C.lds;
    const int vcu = (C.G & 7) == 0 ? (C.bid & 7) * (C.G >> 3) + (C.bid >> 3) : C.bid;
    for (int it = vcu; it < 1024; it += C.G) {
        int sq, h, qb; unit_decode(it, sq, h, qb);
        const int L = sq < B_P ? L_P : L_S, row0 = sq < B_P ? sq * L_P : TOK_P + (sq - B_P) * L_S; const bf16* base = proj + (size_t)row0 * NPROJ; const int q0 = qb * 256;
        att::flash_body3<0, NPROJ, NPROJ, NPROJ>(base + (size_t)q0 * NPROJ + C_BQ + h * 128, base + C_BK + (h >> 2) * 128, base + C_BV + (h >> 2) * 128, L / 64, 0, y + (size_t)(row0 + q0) * DM + 1024 + h * 128, DM, ldsg, C.tid);
    }
}
__device__ __forceinline__ void phase_mix_a(const Ctx& C, int l) {
    const bf16* proj = (const bf16*)(C.ws + WS_PROJ); bf16* y = (bf16*)(C.ws + WS_HA); LAS unsigned char* ldsg = C.lds;
    const int vcu = (C.G & 7) == 0 ? (C.bid & 7) * (C.G >> 3) + (C.bid >> 3) : C.bid;
    for (int it = vcu; it < 1024; it += C.G) {
        int sq, h, qb; unit_decode(it, sq, h, qb);
        const int L = sq < B_P ? L_P : L_S, row0 = sq < B_P ? sq * L_P : TOK_P + (sq - B_P) * L_S; const bf16* base = proj + (size_t)row0 * NPROJ; const int q0 = qb * 256;
        const int klo = q0 - 1024 < 0 ? 0 : q0 - 1024, khi = q0 + 256 + 1024 > L ? L : q0 + 256 + 1024;
        att::flash_body3<2, NPROJ, NPROJ, NPROJ>(base + (size_t)q0 * NPROJ + C_AQ + h * 128, base + (size_t)klo * NPROJ + C_AK + h * 128, base + (size_t)klo * NPROJ + C_AV + h * 128, (khi - klo) / 64, klo - q0,
                                                     y + (size_t)(row0 + q0) * DM + h * 128, DM, ldsg, C.tid);
    }
}
__device__ __forceinline__ void phase_mix_c(const Ctx& C, int l) {
    unsigned* ctr = (unsigned*)(C.ws + WS_CTL) + CW_QUEUE + 64 * l; volatile LAS unsigned* slot = (volatile LAS unsigned*)(C.lds + LDSCTL_OFF + 64);
    for (;;) {
        __syncthreads();
        if (C.tid == 0) *slot = __hip_atomic_fetch_add(ctr, 1u, __ATOMIC_RELAXED, __HIP_MEMORY_SCOPE_AGENT);
        __syncthreads();
        const int it = (int)*slot;
        constexpr int NS_REST = (CV_ALL - CV_IN) / 64, NS_IN = CV_IN / 64;
        const int NC = NS_REST + (l == 0 ? NS_IN : 0), NT = 2048 + NC;
        if (it >= NT) break;
        const int cb = (it * NC) / NT, ca = ((it + 1) * NC) / NT, fi = it - cb;
        if (ca == cb) { const Ctx C2 = make_ctx(C.lds); hy::hyena_fft_unit(C2, l, fi & 1023, fi < 1024 ? 1 : 0); }
        else if (cb < NS_REST) { const Ctx C2 = make_ctx(C.lds); convert_super_item(C2, l, CV_IN + 64 * cb); }
        else { const Ctx C2 = make_ctx(C.lds); convert_super_item(C2, 1, 64 * (cb - NS_REST)); }
    }
    __syncthreads();
}
constexpr int NPH = 9, NPHASES = 2 * NPH + 1;
constexpr int R3 = 24576, R1 = NTOK - R3;
#define IN(k) ph_in(k)
#define SEAM(k) do { if (IN(k) && IN((k) + 1)) { XcdBarrier b_; b_.bar = (unsigned*)(ldargs()->ws + WS_CTL) + CW_BAR; b_.x = xb_xcc_id(); b_.st = MISC + 8; xcd_barrier(b_); } } while (0)
template <int l> __device__ __forceinline__ void layer_body(LAS unsigned char* lds, volatile LAS unsigned* MISC) {
        const int pb = l * NPH;
        if (IN(pb + 0)) {
            const Ctx C = make_ctx(lds); CArgs& args = *C.a; bf16* hA = (bf16*)(C.ws + WS_HA); float* out = args.out;
            if (l == 0) phase_convert_weights(C, 0, 0, CV_IN);
            if (l == 0) phase_rope_tables(C);
            phase_hyena_filters(C, l);
            if (l == 0) phase_rmsnorm_half<true>(C, args.in[I_XP], args.in[I_N1G], hA);
            (void)out;
        }
        SEAM(pb + 0);
        if (IN(pb + 1)) {
            const Ctx C = make_ctx(lds);
            {
                CArgs& args = *C.a; const float* nsrc = l == 0 ? args.in[I_XS] : args.out + (size_t)R3 * DM;
                pg8::Gemm g{(const bf16*)(C.ws + WS_HA), (const bf16*)(C.ws + WS_WIN), TOK_P, NPROJ, DM};
                SlotNormOrder<true, 2> S; S.init(TOK_P, NPROJ, C.G, C.bid); S.src = nsrc; S.g = args.in[I_N1G] + l * DM; S.dst = (bf16*)(C.ws + WS_HA) + (size_t)(l == 0 ? TOK_P : R3) * DM; S.nrows = l == 0 ? TOK_P : R1; S.gw = C.gw; S.ngw = C.NGW; S.lane = C.lane; S.k = 0; S.seen = 0; S.delay = (((C.bid & 7) * 3) >> 3) * 4;
                pg8::EpiProj E{(bf16*)(C.ws + WS_PROJ), NPROJ, (float*)(C.ws + WS_GATES), C_DG / 256};
                pg8::gemm_phase<pg8::EpiProj, SlotNormOrder<true, 2>, PG8_ALIGN, PG8_SP2>(lds, g, S, E);
                S.flush();
            }
            { XcdBarrier b_; b_.bar = (unsigned*)(ldargs()->ws + WS_CTL) + CW_BAR; b_.x = xb_xcc_id(); b_.st = MISC + 8; xcd_barrier(b_); }
            {   const Ctx C1 = make_ctx(lds); const size_t r0 = (size_t)TOK_P;
                pg8::Gemm g{(const bf16*)(C1.ws + WS_HA) + r0 * DM, (const bf16*)(C1.ws + WS_WIN), TOK_P, NPROJ, DM}; pg8::StaticOrder S; S.init(TOK_P, NPROJ, C1.G, C1.bid);
                pg8::EpiProj E{(bf16*)(C1.ws + WS_PROJ) + r0 * NPROJ, NPROJ, (float*)(C1.ws + WS_GATES) + r0 * 16, C_DG / 256};
                pg8::gemm_phase<pg8::EpiProj, pg8::StaticOrder, PG8_ALIGN, PG8_SP2>(lds, g, S, E);
            }
        }
        SEAM(pb + 1);
        if (IN(pb + 2)) { const Ctx C = make_ctx(lds); phase_prep(C, l); }
        SEAM(pb + 2);
        if (IN(pb + 3)) {
            { const Ctx C = make_ctx(lds); prep_mlstm_states(C, l); } { const Ctx C = make_ctx(lds); phase_mix_b(C, l); } { const Ctx C = make_ctx(lds); phase_mix_a(C, l); } { const Ctx C = make_ctx(lds); phase_mix_c(C, l); }
            { XcdBarrier b_; b_.bar = (unsigned*)(ldargs()->ws + WS_CTL) + CW_BAR; b_.x = xb_xcc_id(); b_.st = MISC + 8; xcd_barrier(b_); }
            { const Ctx C = make_ctx(lds); phase_mix_d(C, l); }
        }
        SEAM(pb + 3);
        if (IN(pb + 5)) {
            {   const Ctx C = make_ctx(lds); CArgs& args = *C.a; float* out = args.out;
                pg8::Gemm g{(const bf16*)(C.ws + WS_HA), (const bf16*)(C.ws + WS_WOUT), R3, DM, DM}; pg8::StaticOrder S; S.init(R3, DM, C.G, C.bid);
                pg8::EpiResid E{l == 0 ? args.in[I_XP] : out, l == 0 ? args.in[I_XS] : out + (size_t)TOK_P * DM, TOK_P, out, DM};
                pg8::gemm_phase<pg8::EpiResid, pg8::StaticOrder, PG8_ALIGN, PG8_SP2>(lds, g, S, E);
            }
            { XcdBarrier b_; b_.bar = (unsigned*)(ldargs()->ws + WS_CTL) + CW_BAR; b_.x = xb_xcc_id(); b_.st = MISC + 8; xcd_barrier(b_); }
            {
                const Ctx C = make_ctx(lds); CArgs& args = *C.a; float* out = args.out; const size_t r0 = (size_t)R3;
                pg8::Gemm g{(const bf16*)(C.ws + WS_HA) + r0 * DM, (const bf16*)(C.ws + WS_WOUT), R1, DM, DM};
                SlotNormOrder<true, 12> S; S.init(R1, DM, C.G, C.bid); S.src = out; S.g = args.in[I_N2G] + l * DM; S.dst = (bf16*)(C.ws + WS_HA); S.nrows = R3; S.gw = C.gw; S.ngw = C.NGW; S.lane = C.lane; S.k = 0; S.seen = 0; S.delay = (((C.bid & 7) * 3) >> 3) == 2 ? 1 : 0;
                if ((((C.bid & 7) * 3) >> 3) == 0) S.flush();
                const float* base = l == 0 ? args.in[I_XS] + (size_t)(R3 - TOK_P) * DM : out + r0 * DM;
                pg8::EpiResid E{base, base, R1, out + r0 * DM, DM};
                pg8::gemm_phase<pg8::EpiResid, SlotNormOrder<true, 12>, PG8_ALIGN, PG8_SP2>(lds, g, S, E);
                S.flush();
            }
        }
        SEAM(pb + 5);
        if (IN(pb + 6)) { const Ctx C = make_ctx(lds); CArgs& args = *C.a; float* out = args.out;
            phase_rmsnorm_half<true>(C, out + (size_t)R3 * DM, args.in[I_N2G] + l * DM, (bf16*)(C.ws + WS_HA) + (size_t)R3 * DM, R1); }
        SEAM(pb + 6);
        if (IN(pb + 7)) {
            const Ctx C = make_ctx(lds);
            pg8::Gemm g{(const bf16*)(C.ws + WS_HA), (const bf16*)(C.ws + WS_WGU), NTOK, NGU, DM}; pg8::StaticOrder S; S.init(NTOK, NGU, C.G, C.bid);
            pg8::EpiGateUp E{(bf16*)(C.ws + WS_PROJ), FF};
            pg8::gemm_phase<pg8::EpiGateUp, pg8::StaticOrder, PG8_ALIGN, PG8_SP2>(lds, g, S, E);
        }
        SEAM(pb + 7);
        if (IN(pb + 8)) {
            {   const Ctx C = make_ctx(lds); float* out = C.a->out;
                pg8::Gemm g{(const bf16*)(C.ws + WS_PROJ), (const bf16*)(C.ws + WS_WDN), R3, DM, FF}; pg8::StaticOrder S; S.init(R3, DM, C.G, C.bid);
                pg8::EpiResid E{out, out, R3, out, DM};
                pg8::gemm_phase<pg8::EpiResid, pg8::StaticOrder, PG8_ALIGN, PG8_SP2>(lds, g, S, E);
            }
            { XcdBarrier b_; b_.bar = (unsigned*)(ldargs()->ws + WS_CTL) + CW_BAR; b_.x = xb_xcc_id(); b_.st = MISC + 8; xcd_barrier(b_); }
            {
                const Ctx C = make_ctx(lds); CArgs& args = *C.a; float* out = args.out; const size_t r0 = (size_t)R3;
                pg8::Gemm g{(const bf16*)(C.ws + WS_PROJ) + r0 * FF, (const bf16*)(C.ws + WS_WDN), R1, DM, FF};
                pg8::EpiResid E{out + r0 * DM, out + r0 * DM, R1, out + r0 * DM, DM};
                SlotNormOrder<l == 0, 12> S; S.init(R1, DM, C.G, C.bid); S.src = out; S.g = l == 0 ? args.in[I_N1G] + DM : args.in[I_FG]; S.dst = l == 0 ? (void*)(C.ws + WS_HA) : (void*)out; S.nrows = R3; S.gw = C.gw; S.ngw = C.NGW; S.lane = C.lane; S.k = 0; S.seen = 0; S.delay = (((C.bid & 7) * 3) >> 3) == 2 ? 1 : 0;
                if ((((C.bid & 7) * 3) >> 3) == 0) S.flush();
                pg8::gemm_phase<pg8::EpiResid, SlotNormOrder<l == 0, 12>, PG8_ALIGN, PG8_SP2>(lds, g, S, E); S.flush();
            }
        }
        SEAM(pb + 8);
    }
__global__ void __launch_bounds__(NTHR, 2) fwd_kernel(Args args_by_value) {
    extern __shared__ __attribute__((aligned(16))) unsigned char lds_raw[];
    LAS unsigned char* lds = (LAS unsigned char*)lds_raw;
    for (int u = threadIdx.x; u < (LDS_BYTES - LDSCTL_OFF) / 4; u += NTHR) ((LAS unsigned*)(lds + LDSCTL_OFF))[u] = 0u;
    __syncthreads();
    volatile LAS unsigned* MISC = (volatile LAS unsigned*)(lds + MISC_OFF);
    (void)xcd_barrier_post((unsigned*)(ldargs()->ws + WS_CTL) + CW_BAR, MISC + 8);
    layer_body<0>(lds, MISC);
    layer_body<1>(lds, MISC);
    if (IN(2 * NPH)) { const Ctx C = make_ctx(lds); float* out = C.a->out + (size_t)R3 * DM; phase_rmsnorm_half<false>(C, out, C.a->in[I_FG], out, R1); }
#undef IN
#undef SEAM
}

#ifndef MK_PER_PHASE
#define MK_PER_PHASE 0
#endif
extern "C" void kernel_launch(void* const* d_in, const int* in_sizes, int n_in, void* d_out, int out_size, void* d_ws, size_t ws_size, hipStream_t stream) {
    static int grid = 0;
    if (grid == 0) {
        if (n_in != 24 || out_size != NTOK * DM || ws_size < WS_END) { fprintf(stderr, "kernel_launch: unexpected shapes: n_in %d out %d ws %zu (need %zu)\n", n_in, out_size, ws_size, (size_t)WS_END); grid = -1; return; }
        int dev = 0, cus = 0, per_cu = 0;
        if (hipGetDevice(&dev) != hipSuccess || hipDeviceGetAttribute(&cus, hipDeviceAttributeMultiprocessorCount, dev) != hipSuccess) { grid = -1; return; }
        if (hipFuncSetAttribute((const void*)fwd_kernel, hipFuncAttributeMaxDynamicSharedMemorySize, LDS_BYTES) != hipSuccess) { fprintf(stderr, "kernel_launch: hipFuncSetAttribute failed\n"); grid = -1; return; }
        if (hipOccupancyMaxActiveBlocksPerMultiprocessor(&per_cu, (const void*)fwd_kernel, NTHR, LDS_BYTES) != hipSuccess || per_cu < 1) fprintf(stderr, "kernel_launch: occupancy query reports %d\n", per_cu);
        (void)hipGetLastError();
        grid = cus;
    }
    if (grid < 0) return;
    (void)hipMemsetAsync((char*)d_ws + WS_CTL, 0, CTL_ZERO_BYTES, stream);
    Args a{};
    for (int i = 0; i < 24; ++i) a.in[i] = (const float*)d_in[i];
    a.out = (float*)d_out; a.ws = (unsigned char*)d_ws;
#if MK_PER_PHASE
    for (int k = 0; k < NPHASES; ++k) { a.ph_lo = k; a.ph_hi = k + 1; hipLaunchKernelGGL(fwd_kernel, dim3(grid), dim3(NTHR), LDS_BYTES, stream, a); }
#else
    a.ph_lo = 0; a.ph_hi = NPHASES;
    hipLaunchKernelGGL(fwd_kernel, dim3(grid), dim3(NTHR), LDS_BYTES, stream, a);
#endif
    const hipError_t le = hipPeekAtLastError();
    if (le != hipSuccess) fprintf(stderr, "kernel_launch: launch failed: %s\n", hipGetErrorName(le));
}
```
